# Optimizing an MI355X kernel written in HIP

```python
import numpy as np
import jax
import jax.numpy as jnp
from jax import lax

D_MODEL = 2048
BATCH = 4
SEQ = 4096
DEPTH = 2

GRID_W = 64
CTX_LEN = 256
ADA_CHUNKS = 6
NORM_EPS = 1e-6
NEG_INF = -1e30

D_RNN = D_MODEL // 2
LRU_BLOCKS = 8
LRU_BW = D_RNN // LRU_BLOCKS
CONV_W = 4
LRU_C = 8.0

MLA_HEADS = 8
MLA_NOPE = 128
MLA_ROPE = 64
MLA_QK = MLA_NOPE + MLA_ROPE
MLA_V = 128
Q_RANK = 512
KV_RANK = 512
ROPE_THETA = 10000.0
ATTN_BLOCK = 128
AB_IN = 2 * D_RNN + Q_RANK + KV_RANK + MLA_ROPE
AB_OUT = D_RNN + MLA_HEADS * MLA_V

NA_HEAD_DIM = 128
NA_HEADS = D_MODEL // NA_HEAD_DIM
NA_ROWS = 8
NA_COLS = 16
Q_COL_BLOCK = 16
KEY_COL_BLOCK = 32

N_EXPERTS = 16
N_GROUPS = 4
EXPERTS_PER_GROUP = N_EXPERTS // N_GROUPS
TOP_K = 2
D_EXPERT = 1408
D_SHARED = 1408

N_AB = (DEPTH + 1) // 2
N_NA = DEPTH // 2

kernel_name = "hybrid_rglru_mla_natten_moe_trunk"


def rms_norm(x, g):
    x32 = x.astype(jnp.float32)
    y = x32 * lax.rsqrt(jnp.mean(x32 * x32, axis=-1, keepdims=True) + NORM_EPS)
    return (y * g.astype(jnp.float32)).astype(x.dtype)


def modulate(x, g, shift, scale):
    return rms_norm(x, g) * (1 + scale) + shift


def rotate_axis(x, ang):
    cos = jnp.cos(ang)[None, :, None, :].astype(x.dtype)
    sin = jnp.sin(ang)[None, :, None, :].astype(x.dtype)
    x1, x2 = jnp.split(x, 2, axis=-1)
    return jnp.concatenate([x1 * cos - x2 * sin, x1 * sin + x2 * cos], axis=-1)


def rope_2d(x, n_rot, pos_row, pos_col):
    half = n_rot // 2
    inv_freq = ROPE_THETA ** (-jnp.arange(0, half, 2, dtype=jnp.float32) / half)
    ang_row = pos_row.astype(jnp.float32)[:, None] * inv_freq
    ang_col = pos_col.astype(jnp.float32)[:, None] * inv_freq
    x_pass, x_row, x_col = x[..., :-n_rot], x[..., -n_rot:-half], x[..., -half:]
    return jnp.concatenate([x_pass, rotate_axis(x_row, ang_row), rotate_axis(x_col, ang_col)], axis=-1)


def dense_attend(q, k, v, scale):
    s = jnp.einsum('bqhd,bkhd->bhqk', q, k).astype(jnp.float32) * scale
    p = jax.nn.softmax(s, axis=-1).astype(v.dtype)
    return jnp.einsum('bhqk,bkhd->bqhd', p, v)


def blocked_attend(q, k, v, scale):
    B, L, H, dq = q.shape
    qb = q.reshape(B, L // ATTN_BLOCK, ATTN_BLOCK, H, dq).transpose(1, 0, 2, 3, 4)
    out = lax.map(lambda qi: dense_attend(qi, k, v, scale), qb)
    return out.transpose(1, 0, 2, 3, 4).reshape(B, L, H, v.shape[-1])


def centred_depthwise_conv(x, w, b):
    left = CONV_W // 2
    right = CONV_W - 1 - left
    T = x.shape[1]
    xp = jnp.pad(x, ((0, 0), (left, right), (0, 0)))
    return sum(xp[:, j:j + T] * w[j] for j in range(CONV_W)) + b


def lru_coeffs(x, w_a, b_a, w_i, b_i, lam):
    B, T, _ = x.shape
    xb = x.reshape(B, T, LRU_BLOCKS, LRU_BW)
    r = jax.nn.sigmoid((jnp.einsum('btnk,nkj->btnj', xb, w_a).reshape(B, T, D_RNN) + b_a).astype(jnp.float32))
    i = jax.nn.sigmoid((jnp.einsum('btnk,nkj->btnj', xb, w_i).reshape(B, T, D_RNN) + b_i).astype(jnp.float32))
    log_a = -LRU_C * r * jax.nn.softplus(-lam.astype(jnp.float32))
    a = jnp.exp(log_a)
    b = jnp.sqrt(-jnp.expm1(2 * log_a)) * i * x.astype(jnp.float32)
    return a, b


def linear_scan(a, b, h0, reverse):
    def combine(e1, e2):
        a1, b1 = e1
        a2, b2 = e2
        return a1 * a2, a2 * b1 + b2
    a_cum, h = lax.associative_scan(combine, (a, b), axis=1, reverse=reverse)
    if h0 is not None:
        h = h + a_cum * h0[:, None, :]
    return h


def ab_mixer(hc, h, w_in, w_out, conv_w, conv_b, w_a, b_a, w_i, b_i, lam,
             q_norm_g, w_uq, kv_norm_g, w_ukv, q_head_g, k_head_g, with_ctx_out):
    B, S, _ = hc.shape
    L = h.shape[1]
    T = S + L
    u = jnp.concatenate([hc, h], axis=1) @ w_in
    o1, o2 = D_RNN, 2 * D_RNN
    o3, o4 = o2 + Q_RANK, o2 + Q_RANK + KV_RANK
    u_x, u_gate, u_cq, u_ckv, u_kr = u[..., :o1], u[..., o1:o2], u[..., o2:o3], u[..., o3:o4], u[..., o4:]

    xconv = jnp.concatenate([centred_depthwise_conv(u_x[:, :S], conv_w, conv_b),
                             centred_depthwise_conv(u_x[:, S:], conv_w, conv_b)], axis=1)
    a_f, b_f = lru_coeffs(xconv, w_a[0], b_a[0], w_i[0], b_i[0], lam[0])
    a_b, b_b = lru_coeffs(xconv, w_a[1], b_a[1], w_i[1], b_i[1], lam[1])
    hc_f = linear_scan(a_f[:, :S], b_f[:, :S], None, False)
    hc_b = linear_scan(a_b[:, :S], b_b[:, :S], None, True)
    hl_f = linear_scan(a_f[:, S:], b_f[:, S:], hc_f[:, -1], False)
    hl_b = linear_scan(a_b[:, S:], b_b[:, S:], hc_b[:, 0], True)
    gate = jax.nn.gelu(u_gate)
    rnn_l = (hl_f + hl_b).astype(h.dtype) * gate[:, S:]

    q = (rms_norm(u_cq, q_norm_g) @ w_uq).reshape(B, T, MLA_HEADS, MLA_QK)
    kv = (rms_norm(u_ckv, kv_norm_g) @ w_ukv).reshape(B, T, MLA_HEADS, MLA_NOPE + MLA_V)
    k_nope, v = kv[..., :MLA_NOPE], kv[..., MLA_NOPE:]
    k_rope = jnp.broadcast_to(u_kr[:, :, None, :], (B, T, MLA_HEADS, MLA_ROPE))
    k = jnp.concatenate([k_nope, k_rope], axis=-1)
    q = rms_norm(q, q_head_g)
    k = rms_norm(k, k_head_g)
    t = jnp.arange(L)
    pos_row, pos_col = t // GRID_W, t % GRID_W
    q_l = rope_2d(q[:, S:], MLA_ROPE, pos_row, pos_col)
    k_l = rope_2d(k[:, S:], MLA_ROPE, pos_row, pos_col)
    k_all = jnp.concatenate([k[:, :S], k_l], axis=1)
    scale = MLA_QK ** -0.5
    att_l = blocked_attend(q_l, k_all, v, scale)
    y_l = jnp.concatenate([rnn_l, att_l.reshape(B, L, MLA_HEADS * MLA_V)], axis=-1) @ w_out
    if not with_ctx_out:
        return None, y_l
    rnn_c = (hc_f + hc_b).astype(hc.dtype) * gate[:, :S]
    att_c = dense_attend(q[:, :S], k[:, :S], v[:, :S], scale)
    y_c = jnp.concatenate([rnn_c, att_c.reshape(B, S, MLA_HEADS * MLA_V)], axis=-1) @ w_out
    return y_c, y_l


def neighbourhood_attend(q, k, v, k_ctx, v_ctx, rpb, scale):
    B, L, H, dh = q.shape
    rows = L // GRID_W
    kr = min(NA_ROWS, rows)
    n_cb = GRID_W // Q_COL_BLOCK
    cols = np.arange(GRID_W)
    q_cols = cols.reshape(n_cb, Q_COL_BLOCK)
    q_col_start = np.clip(cols - NA_COLS // 2, 0, GRID_W - NA_COLS).reshape(n_cb, Q_COL_BLOCK)
    blk_start = np.clip(np.arange(n_cb) * Q_COL_BLOCK - NA_COLS // 2, 0, GRID_W - KEY_COL_BLOCK)
    key_cols = blk_start[:, None] + np.arange(KEY_COL_BLOCK)[None, :]
    kc_b = key_cols[:, None, :]
    col_ok = (kc_b >= q_col_start[..., None]) & (kc_b < q_col_start[..., None] + NA_COLS)
    dcol_idx = np.clip(kc_b - q_cols[..., None] + NA_COLS - 1, 0, 2 * NA_COLS - 2)
    rpb_cols = rpb[:, :, dcol_idx]
    kg = k.reshape(B, rows, GRID_W, H, dh)
    vg = v.reshape(B, rows, GRID_W, H, dh)
    qg = q.reshape(B, rows, n_cb, Q_COL_BLOCK, H, dh).transpose(1, 0, 2, 3, 4, 5)
    n_loc = kr * KEY_COL_BLOCK

    def one_row(args):
        r, q_row = args
        r0 = jnp.clip(r - kr // 2, 0, rows - kr)
        k_blk = lax.dynamic_slice_in_dim(kg, r0, kr, axis=1)[:, :, key_cols]
        v_blk = lax.dynamic_slice_in_dim(vg, r0, kr, axis=1)[:, :, key_cols]
        drow_idx = r0 - r + jnp.arange(kr) + NA_ROWS - 1
        bias = rpb_cols[:, drow_idx].transpose(0, 2, 3, 1, 4)
        s_loc = jnp.einsum('bnqhd,bknjhd->bhnqkj', q_row, k_blk).astype(jnp.float32) * scale + bias.astype(jnp.float32)
        s_loc = jnp.where(col_ok[:, :, None, :], s_loc, NEG_INF)
        s_ctx = jnp.einsum('bnqhd,bshd->bhnqs', q_row, k_ctx).astype(jnp.float32) * scale
        s = jnp.concatenate([s_loc.reshape(B, H, n_cb, Q_COL_BLOCK, n_loc), s_ctx], axis=-1)
        p = jax.nn.softmax(s, axis=-1).astype(v.dtype)
        p_loc = p[..., :n_loc].reshape(B, H, n_cb, Q_COL_BLOCK, kr, KEY_COL_BLOCK)
        return (jnp.einsum('bhnqkj,bknjhd->bnqhd', p_loc, v_blk)
                + jnp.einsum('bhnqs,bshd->bnqhd', p[..., n_loc:], v_ctx))

    out = lax.map(one_row, (jnp.arange(rows), qg))
    return out.transpose(1, 0, 2, 3, 4, 5).reshape(B, L, H, dh)


def na_mixer(hc, h, w_qkv, w_out, q_head_g, k_head_g, rpb, with_ctx_out):
    B, S, _ = hc.shape
    L = h.shape[1]
    u = (jnp.concatenate([hc, h], axis=1) @ w_qkv).reshape(B, S + L, 3, NA_HEADS, NA_HEAD_DIM)
    q = rms_norm(u[:, :, 0], q_head_g)
    k = rms_norm(u[:, :, 1], k_head_g)
    v = u[:, :, 2]
    scale = NA_HEAD_DIM ** -0.5
    att_l = neighbourhood_attend(q[:, S:], k[:, S:], v[:, S:], k[:, :S], v[:, :S], rpb, scale)
    y_l = att_l.reshape(B, L, D_MODEL) @ w_out
    if not with_ctx_out:
        return None, y_l
    y_c = dense_attend(q[:, :S], k[:, :S], v[:, :S], scale).reshape(B, S, D_MODEL) @ w_out
    return y_c, y_l


def swiglu(h, w_gate, w_up, w_down):
    return (jax.nn.silu(h @ w_gate) * (h @ w_up)) @ w_down


def grouped_moe(h, router_w, router_b, w_gate, w_up, w_down, ws_gate, ws_up, ws_down):
    shape = h.shape
    hf = h.reshape(-1, D_MODEL)
    n = hf.shape[0]
    scores = jax.nn.sigmoid((hf @ router_w).astype(jnp.float32))
    sel = scores + router_b.astype(jnp.float32)
    group_score = lax.top_k(sel.reshape(n, N_GROUPS, EXPERTS_PER_GROUP), TOP_K)[0].sum(-1)
    best = jnp.argmax(group_score, axis=-1)
    in_group = (jnp.arange(N_EXPERTS)[None, :] // EXPERTS_PER_GROUP) == best[:, None]
    _, idx = lax.top_k(jnp.where(in_group, sel, NEG_INF), TOP_K)
    w = jnp.take_along_axis(scores, idx, axis=-1)
    w = w / jnp.sum(w, axis=-1, keepdims=True)
    combine = jnp.sum(jax.nn.one_hot(idx, N_EXPERTS, dtype=jnp.float32) * w[..., None], axis=1).astype(h.dtype)
    y = swiglu(hf, ws_gate, ws_up, ws_down)
    for e in range(N_EXPERTS):
        y = y + combine[:, e:e + 1] * swiglu(hf, w_gate[e], w_up[e], w_down[e])
    return y.reshape(shape)


def setup_inputs(seed: int = 0) -> dict:
    key = jax.random.key(seed)
    ks = iter(jax.random.split(key, 64))
    f32 = jnp.float32

    def nrm(shape, scale):
        return jax.random.normal(next(ks), shape, f32) * scale

    def gain(shape):
        return 1.0 + nrm(shape, 0.05)

    a8 = jax.random.uniform(next(ks), (N_AB, 2, D_RNN), f32, minval=0.9, maxval=0.999)
    a_base = a8 ** (1.0 / LRU_C)
    lam = jnp.log(a_base) - jnp.log1p(-a_base)
    return {
        "x": nrm((BATCH, SEQ, D_MODEL), 1.0),
        "c": nrm((BATCH, D_MODEL), 1.0),
        "ctx": nrm((BATCH, CTX_LEN, D_MODEL), 1.0),
        "c_ctx": nrm((D_MODEL,), 1.0),
        "ada_w": nrm((DEPTH, D_MODEL, ADA_CHUNKS * D_MODEL), 0.5 * D_MODEL ** -0.5),
        "ada_b": nrm((DEPTH, ADA_CHUNKS * D_MODEL), 0.02),
        "norm_mix_g": gain((DEPTH, D_MODEL)),
        "norm_ffn_g": gain((DEPTH, D_MODEL)),
        "ab_w_in": nrm((N_AB, D_MODEL, AB_IN), D_MODEL ** -0.5),
        "ab_w_out": nrm((N_AB, AB_OUT, D_MODEL), AB_OUT ** -0.5),
        "lru_conv_w": nrm((N_AB, CONV_W, D_RNN), CONV_W ** -0.5),
        "lru_conv_b": nrm((N_AB, D_RNN), 0.02),
        "lru_w_a": nrm((N_AB, 2, LRU_BLOCKS, LRU_BW, LRU_BW), LRU_BW ** -0.5),
        "lru_b_a": nrm((N_AB, 2, D_RNN), 0.1),
        "lru_w_i": nrm((N_AB, 2, LRU_BLOCKS, LRU_BW, LRU_BW), LRU_BW ** -0.5),
        "lru_b_i": nrm((N_AB, 2, D_RNN), 0.1),
        "lru_lambda": lam,
        "mla_q_norm_g": gain((N_AB, Q_RANK)),
        "mla_w_uq": nrm((N_AB, Q_RANK, MLA_HEADS * MLA_QK), Q_RANK ** -0.5),
        "mla_kv_norm_g": gain((N_AB, KV_RANK)),
        "mla_w_ukv": nrm((N_AB, KV_RANK, MLA_HEADS * (MLA_NOPE + MLA_V)), KV_RANK ** -0.5),
        "mla_q_head_g": gain((N_AB, MLA_QK)),
        "mla_k_head_g": gain((N_AB, MLA_QK)),
        "na_w_qkv": nrm((N_NA, D_MODEL, 3 * D_MODEL), D_MODEL ** -0.5),
        "na_w_out": nrm((N_NA, D_MODEL, D_MODEL), D_MODEL ** -0.5),
        "na_q_head_g": gain((N_NA, NA_HEAD_DIM)),
        "na_k_head_g": gain((N_NA, NA_HEAD_DIM)),
        "na_rpb": nrm((N_NA, NA_HEADS, 2 * NA_ROWS - 1, 2 * NA_COLS - 1), 0.5),
        "router_w": nrm((D_MODEL, N_EXPERTS), D_MODEL ** -0.5),
        "router_b": nrm((N_EXPERTS,), 0.01),
        "moe_w_gate": nrm((DEPTH, N_EXPERTS, D_MODEL, D_EXPERT), D_MODEL ** -0.5),
        "moe_w_up": nrm((DEPTH, N_EXPERTS, D_MODEL, D_EXPERT), D_MODEL ** -0.5),
        "moe_w_down": nrm((DEPTH, N_EXPERTS, D_EXPERT, D_MODEL), D_EXPERT ** -0.5),
        "moe_ws_gate": nrm((DEPTH, D_MODEL, D_SHARED), D_MODEL ** -0.5),
        "moe_ws_up": nrm((DEPTH, D_MODEL, D_SHARED), D_MODEL ** -0.5),
        "moe_ws_down": nrm((DEPTH, D_SHARED, D_MODEL), D_SHARED ** -0.5),
    }


def reference(x, c, ctx, c_ctx, ada_w, ada_b, norm_mix_g, norm_ffn_g,
              ab_w_in, ab_w_out, lru_conv_w, lru_conv_b, lru_w_a, lru_b_a, lru_w_i, lru_b_i, lru_lambda,
              mla_q_norm_g, mla_w_uq, mla_kv_norm_g, mla_w_ukv, mla_q_head_g, mla_k_head_g,
              na_w_qkv, na_w_out, na_q_head_g, na_k_head_g, na_rpb,
              router_w, router_b, moe_w_gate, moe_w_up, moe_w_down, moe_ws_gate, moe_ws_up, moe_ws_down):
    S = ctx.shape[1]
    xc = ctx
    silu_c = jax.nn.silu(c)
    silu_cc = jax.nn.silu(c_ctx)
    for i in range(DEPTH):
        last = i == DEPTH - 1
        j = i // 2
        mod_l = jnp.split((silu_c @ ada_w[i] + ada_b[i])[:, None, :], ADA_CHUNKS, axis=-1)
        mod_c = jnp.split(silu_cc @ ada_w[i] + ada_b[i], ADA_CHUNKS, axis=-1)
        h = modulate(x, norm_mix_g[i], mod_l[0], mod_l[1])
        hc = modulate(xc, norm_mix_g[i], mod_c[0], mod_c[1])
        if i % 2 == 0:
            y_c, y = ab_mixer(hc, h, ab_w_in[j], ab_w_out[j], lru_conv_w[j], lru_conv_b[j],
                              lru_w_a[j], lru_b_a[j], lru_w_i[j], lru_b_i[j], lru_lambda[j],
                              mla_q_norm_g[j], mla_w_uq[j], mla_kv_norm_g[j], mla_w_ukv[j],
                              mla_q_head_g[j], mla_k_head_g[j], not last)
        else:
            y_c, y = na_mixer(hc, h, na_w_qkv[j], na_w_out[j], na_q_head_g[j], na_k_head_g[j],
                              na_rpb[j], not last)
        x = x + mod_l[2] * y
        h2 = modulate(x, norm_ffn_g[i], mod_l[3], mod_l[4])
        if last:
            x = x + mod_l[5] * grouped_moe(h2, router_w, router_b, moe_w_gate[i], moe_w_up[i], moe_w_down[i],
                                           moe_ws_gate[i], moe_ws_up[i], moe_ws_down[i])
        else:
            xc = xc + mod_c[2] * y_c
            h2c = modulate(xc, norm_ffn_g[i], mod_c[3], mod_c[4])
            f = grouped_moe(jnp.concatenate([h2c, h2], axis=1), router_w, router_b, moe_w_gate[i], moe_w_up[i],
                            moe_w_down[i], moe_ws_gate[i], moe_ws_up[i], moe_ws_down[i])
            xc = xc + mod_c[5] * f[:, :S]
            x = x + mod_l[5] * f[:, S:]
    return x
```

```cpp
#include <hip/hip_runtime.h>
#include <cstdio>
#include <cstdint>

#ifndef MK_N_LAUNCHES
#define MK_N_LAUNCHES 0
#endif

#define GAS __attribute__((address_space(1)))
#define LAS __attribute__((address_space(3)))
typedef unsigned short bf16;
typedef short bf16x8 __attribute__((ext_vector_type(8)));
typedef short s16x4 __attribute__((ext_vector_type(4)));
typedef float f32x2 __attribute__((ext_vector_type(2)));
typedef float f32x4 __attribute__((ext_vector_type(4)));
typedef float f32x16 __attribute__((ext_vector_type(16)));
typedef unsigned u32x2 __attribute__((ext_vector_type(2)));
typedef unsigned u32x4 __attribute__((ext_vector_type(4)));
#define LDS_WAIT() asm volatile("s_waitcnt lgkmcnt(0)" ::: "memory")
#define VM_WAIT() asm volatile("s_waitcnt vmcnt(0)" ::: "memory")
#define RLX_AGENT __ATOMIC_RELAXED, __HIP_MEMORY_SCOPE_AGENT

constexpr int DM = 2048, NB = 4, SEQ = 4096, CTXL = 256, GW = 64;
constexpr int NCTX = NB * CTXL, NLAT = NB * SEQ, NTOK = NCTX + NLAT;
constexpr int DRNN = 1024, QRK = 512, KVRK = 512, MROPE = 64, MNOPE = 128, MQK = 192, MV = 128, MH = 8;
constexpr int ABIN = 3136, ABINP = 3328;
constexpr int NAH = 16, NAD = 128;
constexpr int NE = 16, DE = 1408, NG = 4;
constexpr int NCHUNK = 68;
constexpr float EPS = 1e-6f;
constexpr float LOG2E = 1.4426950408889634f;
constexpr int MAXSLOT = 56320;

constexpr size_t al256(size_t x) { return (x + 255) / 256 * 256; }
constexpr size_t WS_CTL = 0, CTL_BYTES = 1u << 20;
constexpr int CW_TMO = 0, CW_BAR = 4096, CW_CNT = 16384;
constexpr size_t WS_MODP = CTL_BYTES;
constexpr size_t WS_MOD = WS_MODP + al256((size_t)8 * 2 * 5 * 12288 * 4);
constexpr size_t WS_ROPE = WS_MOD + al256((size_t)2 * 5 * 12288 * 4);
constexpr size_t WS_AGG = WS_ROPE + al256(64 * 16 * 8);
constexpr size_t WS_CARRY = WS_AGG + al256((size_t)2 * 4 * NCHUNK * 1024 * 8);
constexpr size_t WS_TOKE = WS_CARRY + al256((size_t)2 * 4 * NCHUNK * 1024 * 4);
constexpr size_t WS_TOKW = WS_TOKE + al256((size_t)NTOK * 8);
constexpr size_t WS_TOKP = WS_TOKW + al256((size_t)NTOK * 8);
constexpr size_t WS_TOKS = WS_TOKP + al256((size_t)NTOK * 8);
constexpr size_t WS_SLOTTOK = WS_TOKS + al256((size_t)NTOK * 8);
constexpr size_t WS_WIN = al256(WS_SLOTTOK + (size_t)MAXSLOT * 4);
constexpr size_t WS_WOUT0 = WS_WIN + (size_t)ABINP * DM * 2;
constexpr size_t WS_WUQ = WS_WOUT0 + (size_t)DM * DM * 2;
constexpr size_t WS_WUKV = WS_WUQ + (size_t)1536 * 512 * 2;
constexpr size_t WS_WG = WS_WUKV + (size_t)2048 * 512 * 2;
constexpr size_t WS_WQKV = WS_WG + (size_t)4 * 8 * 128 * 128 * 2;
constexpr size_t WS_WOUT1 = WS_WQKV + (size_t)6144 * DM * 2;
constexpr size_t W1_E = (size_t)2816 * DM * 2, W2_E = (size_t)DM * DE * 2;
constexpr size_t WS_W1 = WS_WOUT1 + (size_t)DM * DM * 2;
constexpr size_t WS_W2 = WS_W1 + 2 * 17 * W1_E;
constexpr size_t WS_XA = WS_W2 + 2 * 17 * W2_E;
constexpr size_t XBYTES = (size_t)NTOK * DM * 4;
constexpr size_t WS_XB = WS_XA + XBYTES;
constexpr size_t WS_H = WS_XB + XBYTES;
constexpr size_t WS_D = WS_H + (size_t)NTOK * DM * 2;
constexpr size_t WS_U = WS_D;
constexpr size_t WS_AB = WS_U + al256((size_t)NTOK * ABIN * 2);
constexpr size_t ABSZ = (size_t)NTOK * DRNN * 4;
constexpr size_t WS_CQN = WS_AB + 4 * ABSZ;
constexpr size_t WS_CKVN = WS_CQN + (size_t)NTOK * 512 * 2;
constexpr size_t WS_YC = WS_CKVN + (size_t)NTOK * 512 * 2;
constexpr size_t WS_D_END0 = WS_YC + (size_t)NTOK * DM * 2;
constexpr size_t WS_QRAW = WS_XA;
constexpr size_t WS_KVRAW = WS_QRAW + al256((size_t)NTOK * 1536 * 2);
constexpr size_t WS_QF = WS_XB;
constexpr size_t WS_KF = WS_QF + al256((size_t)NTOK * 1536 * 2);
static_assert(WS_KVRAW + (size_t)NTOK * 2048 * 2 <= WS_XB && WS_KF + (size_t)NTOK * 1536 * 2 <= WS_H, "mixer overlays");
constexpr size_t WS_ACT = WS_D;
constexpr size_t WS_Y = WS_ACT + al256((size_t)MAXSLOT * DE * 2);
constexpr size_t WS_D_END1 = WS_Y + (size_t)MAXSLOT * DM * 2;
constexpr size_t WS_QKV = WS_D;
constexpr size_t WS_ATT2 = WS_QKV + (size_t)NTOK * 6144 * 2;
constexpr size_t WS_D_END2 = WS_ATT2 + (size_t)NTOK * DM * 2;
constexpr size_t WS_END = (WS_D_END0 > WS_D_END1 ? (WS_D_END0 > WS_D_END2 ? WS_D_END0 : WS_D_END2) : (WS_D_END1 > WS_D_END2 ? WS_D_END1 : WS_D_END2));

constexpr int RING_BYTES = 131072;
constexpr int MISC_OFF = RING_BYTES;
constexpr int LDS_BYTES = 147456;
constexpr int NWAVES = 8, NTHR = 512;

__device__ __forceinline__ unsigned f2bf(float f) { unsigned u = __builtin_bit_cast(unsigned, f); return (u + 0x7fffu + ((u >> 16) & 1u)) >> 16; }
__device__ __forceinline__ unsigned pk2(float lo, float hi) { return f2bf(lo) | (f2bf(hi) << 16); }
__device__ __forceinline__ float bf2f(unsigned short b) { return __builtin_bit_cast(float, (unsigned)b << 16); }
__device__ __forceinline__ float bflo(unsigned w) { return __builtin_bit_cast(float, w << 16); }
__device__ __forceinline__ float bfhi(unsigned w) { return __builtin_bit_cast(float, w & 0xffff0000u); }
__device__ __forceinline__ unsigned cvt_pk_bf16(float lo, float hi) { unsigned r; asm volatile("v_cvt_pk_bf16_f32 %0, %1, %2" : "=v"(r) : "v"(lo), "v"(hi)); return r; }
__device__ __forceinline__ float wave_sum(float v) {
#pragma unroll
    for (int o = 1; o < 64; o <<= 1) v += __shfl_xor(v, o);
    return v;
}
__device__ __forceinline__ float sigmoidf_(float x) { return 1.0f / (1.0f + __expf(-x)); }
__device__ __forceinline__ float gelu_tanh(float x) { const float u = 0.7978845608028654f * (x + 0.044715f * x * x * x); const float th = 1.0f - 2.0f / (1.0f + __expf(2.0f * u)); return 0.5f * x * (1.0f + th); }
__device__ __forceinline__ int vec_of_row(int row) { return row < NCTX ? 4 : (row - NCTX) / SEQ; }

#define XB_TMO      128
#define XB_XCNT(j)  (256  + 64 * (j))
#define XB_XSUB(j)  (1280 + 64 * (j))
#define XB_XGEN(j)  (2304 + 64 * (j))
#define XB_TOP      3328
#define XB_TOPGEN   3392
#define XCD_BAR_WORDS 3456
#define XB_SPIN_CAP (1u << 18)
__device__ __forceinline__ unsigned xb_ld(unsigned* p)              { return __hip_atomic_load(p, __ATOMIC_RELAXED, __HIP_MEMORY_SCOPE_AGENT); }
__device__ __forceinline__ unsigned xb_add(unsigned* p, unsigned v) { return __hip_atomic_fetch_add(p, v, __ATOMIC_RELAXED, __HIP_MEMORY_SCOPE_AGENT); }
__device__ __forceinline__ unsigned xb_xcc_id() { return (unsigned)__builtin_amdgcn_s_getreg((3 << 11) | 20) & 0xFu; }
#define XB_SPIN(cond, bar) do { unsigned _sp = 0; while (cond) { __builtin_amdgcn_s_sleep(1); \
    if ((++_sp & 255u) == 0u) { if (xb_ld(&(bar)[XB_TMO])) break; if (_sp > XB_SPIN_CAP) { atomicAdd(&(bar)[XB_TMO], 1u); break; } } } } while (0)
struct XcdBarrier { unsigned* bar; unsigned x; volatile LAS unsigned* st; };
__device__ __forceinline__ XcdBarrier xcd_barrier_post(unsigned* bar, volatile LAS unsigned* st) {
    XcdBarrier b; b.bar = bar; b.x = xb_xcc_id(); b.st = st;
    if (threadIdx.x == 0) (void)xb_add(&bar[XB_XCNT(b.x)], 1u);
    return b;
}
__device__ __forceinline__ void xcd_barrier_complete(unsigned* bar, unsigned x, unsigned& nloc, unsigned& nx) {
    const unsigned G = gridDim.x * gridDim.y * gridDim.z;
    unsigned sum, cnt, mine, sp = 0u;
    for (;;) {
        sum = 0u; cnt = 0u; mine = 0u;
#pragma unroll
        for (unsigned j = 0; j < 16; ++j) { const unsigned c = xb_ld(&bar[XB_XCNT(j)]); sum += c; cnt += (c > 0u) ? 1u : 0u; mine = (j == x) ? c : mine; }
        if (sum == G) break;
        __builtin_amdgcn_s_sleep(1);
        if ((++sp & 255u) == 0u) { if (xb_ld(&bar[XB_TMO])) break; if (sp > XB_SPIN_CAP) { atomicAdd(&bar[XB_TMO], 1u); break; } }
    }
    nloc = mine > 0u ? mine : 1u; nx = cnt > 0u ? cnt : 1u;
}
__device__ __forceinline__ void xcd_barrier(const XcdBarrier& b) {
    asm volatile("s_waitcnt vmcnt(0)" ::: "memory");
    __syncthreads();
    if (threadIdx.x == 0) {
        unsigned* bar = b.bar;
        __builtin_amdgcn_s_waitcnt(0);
        unsigned nloc = b.st[0], nx = b.st[1];
        if (nloc == 0u) { xcd_barrier_complete(bar, b.x, nloc, nx); b.st[0] = nloc; b.st[1] = nx; }
        const unsigned old = xb_add(&bar[XB_XSUB(b.x)], 1u);
        const unsigned gen = old / nloc;
        if (old + 1u == (gen + 1u) * nloc) {
            __builtin_amdgcn_fence(__ATOMIC_RELEASE, "agent");
            asm volatile("s_waitcnt vmcnt(0)" ::: "memory");
            const unsigned og = xb_add(&bar[XB_TOP], 1u);
            const unsigned tg = og / nx;
            if (og + 1u == (tg + 1u) * nx) xb_add(&bar[XB_TOPGEN], 1u);
            else XB_SPIN(xb_ld(&bar[XB_TOPGEN]) == tg, bar);
            __builtin_amdgcn_fence(__ATOMIC_ACQUIRE, "agent");
            xb_add(&bar[XB_XGEN(b.x)], 1u);
            asm volatile("s_waitcnt vmcnt(0)" ::: "memory");
        } else {
            XB_SPIN(xb_ld(&bar[XB_XGEN(b.x)]) == gen, bar);
            __builtin_amdgcn_fence(__ATOMIC_ACQUIRE, "agent");
            asm volatile("s_waitcnt vmcnt(0)" ::: "memory");
        }
    }
    __syncthreads();
}

namespace pg8 {
constexpr int BM = 256, BK = 64, HALF = 128, HTB = HALF * BK * 2, STAGE_BYTES = 8 * HTB, NXCD = 8, WGM = 8;
__device__ __forceinline__ int lds_byte(int r, int c) { const int st = (r >> 4) * 2 + (c >> 5), rr = r & 15, cc = c & 31, ob = rr * 64 + cc * 2; return st * 1024 + (ob ^ (((ob >> 9) & 1) << 5)); }
__device__ __forceinline__ void stage_rc(int b, int& R, int& C) { const int st = b / 1024, sb = b % 1024, swz = sb ^ (((sb >> 9) & 1) << 5); R = (st >> 1) * 16 + swz / 64; C = (st & 1) * 32 + (swz % 64) / 2; }
__device__ __forceinline__ int perm32(int rho) { const int n = rho >> 4, i = rho & 15; return 8 * (i >> 2) + 4 * n + (i & 3); }

struct Unit {
    const char* ap;
    const char* bp;
    const int* rowmap;
    int arow0;
    int pm, pn, grp;
};
struct TileOrder {
    int nM, nN, nwg, G, c;
    __device__ __forceinline__ void init(int nM_, int nN_, int G_, int c_) { nM = nM_; nN = nN_; nwg = nM * nN; G = G_; c = c_; }
    __device__ __forceinline__ bool tile(int i, int& pm, int& pn) const {
        const long L = (long)i * G + c; if (L >= nwg) return false;
        int wgid = (int)L; { const int q = nwg / NXCD, r = nwg % NXCD, xcd = wgid % NXCD, off = wgid / NXCD; wgid = (xcd < r ? xcd * (q + 1) : r * (q + 1) + (xcd - r) * q) + off; }
        const int nig = WGM * nN, gid = wgid / nig, fm = gid * WGM, gsz = (nM - fm) < WGM ? (nM - fm) : WGM;
        pm = fm + ((wgid % nig) % gsz); pn = (wgid % nig) / gsz; return true;
    }
};
struct DenseSched {
    TileOrder T; const char* A; const char* Bt; size_t tstepB; int row0;
    __device__ __forceinline__ bool next(int i, Unit& u) const {
        int pm, pn; if (!T.tile(i, pm, pn)) return false;
        u.ap = A; u.bp = Bt + (size_t)pn * tstepB; u.rowmap = nullptr; u.arow0 = row0 + pm * BM; u.pm = pm; u.pn = pn; u.grp = 0; return true;
    }
};
struct MoeSched {
    TileOrder T; const char* A; const char* Bt; size_t tstepB, estride; const int* rowmap; const volatile LAS int* tile_e;
    __device__ __forceinline__ bool next(int i, Unit& u) const {
        int pm, pn; if (!T.tile(i, pm, pn)) return false;
        const int e = __builtin_amdgcn_readfirstlane(tile_e[pm]);
        u.ap = A; u.bp = Bt + (size_t)e * estride + (size_t)pn * tstepB; u.rowmap = rowmap; u.arow0 = pm * BM; u.pm = pm; u.pn = pn; u.grp = e; return true;
    }
};

template <class Epi, class Sched>
__device__ __forceinline__ void gemm_phase(LAS unsigned char* lds, const int K, const Sched& S, const Epi& E) {
    const int tid = threadIdx.x, wid = __builtin_amdgcn_readfirstlane(tid >> 6), lane = tid & 63, wr = wid >> 2, wc = wid & 3, fr = lane & 15, fq = lane >> 4;
    const int nt = K / BK;
    int sR[2]; unsigned sC2[2], voffB[2];
#pragma unroll
    for (int i = 0; i < 2; ++i) { int R, C; stage_rc(tid * 16 + i * 8192, R, C); const int Rb = Epi::PERM ? ((R & ~31) + perm32(R & 31)) : R;
        sR[i] = R; sC2[i] = (unsigned)C * 2u; voffB[i] = (unsigned)(Rb * K + C) * 2u; }
    const size_t kstep = (size_t)(BK * 2);
    const size_t hstepB = (size_t)HALF * K * 2;
    const unsigned rowB = (unsigned)K * 2u;
    const unsigned ldsw = (unsigned)wid * 1024u;
    const int aoff = lds_byte(wr * 64 + fr, fq * 8), boff = lds_byte(wc * 32 + fr, fq * 8);
#define PG8_SA(b, h) (((b) * 2 + (h)) * HTB)
#define PG8_SB(b, h) ((4 + (b) * 2 + (h)) * HTB)
#define PG8_STAGE(bufoff, gbase, voff) do { _Pragma("unroll") for (int _i = 0; _i < 2; ++_i) \
        __builtin_amdgcn_global_load_lds((const unsigned*)((const char*)(gbase) + (voff)[_i]), (LAS unsigned*)(lds + (bufoff) + ldsw + _i * 8192), 16, 0, 0); } while (0)
#define PG8_LDA(dst, b, h) do { _Pragma("unroll") for (int m = 0; m < 4; ++m) _Pragma("unroll") for (int k = 0; k < 2; ++k) dst[m][k] = *(const LAS bf16x8*)(lds + PG8_SA(b, h) + aoff + m * 2048 + k * 1024); } while (0)
#define PG8_LDB(dst, b, h) do { _Pragma("unroll") for (int n = 0; n < 2; ++n) _Pragma("unroll") for (int k = 0; k < 2; ++k) dst[n][k] = *(const LAS bf16x8*)(lds + PG8_SB(b, h) + boff + n * 2048 + k * 1024); } while (0)
#define PG8_MMA(ai, bj, At, Bt) do { __builtin_amdgcn_s_setprio(1); _Pragma("unroll") for (int m = 0; m < 4; ++m) _Pragma("unroll") for (int n = 0; n < 2; ++n) _Pragma("unroll") for (int k = 0; k < 2; ++k) \
        acc[ai][bj][m][n] = __builtin_amdgcn_mfma_f32_16x16x32_bf16(Bt[n][k], At[m][k], acc[ai][bj][m][n], 0, 0, 0); __builtin_amdgcn_s_setprio(0); } while (0)
#define PG8_WAIT_V(n) asm volatile("s_waitcnt vmcnt(" #n ")" ::: "memory")
#define PG8_WAIT_L(n) asm volatile("s_waitcnt lgkmcnt(" #n ")" ::: "memory")
#define PG8_BAR __builtin_amdgcn_s_barrier()
#define PG8_SCHED __builtin_amdgcn_sched_barrier(0)
#define PG8_MKOFF(u, o0, o1) do { _Pragma("unroll") for (int _i = 0; _i < 2; ++_i) { const int _r0 = (u).arow0 + sR[_i], _r1 = _r0 + HALF; \
        const int _g0 = (u).rowmap ? (u).rowmap[_r0] : _r0, _g1 = (u).rowmap ? (u).rowmap[_r1] : _r1; \
        o0[_i] = (unsigned)_g0 * rowB + sC2[_i]; o1[_i] = (unsigned)_g1 * rowB + sC2[_i]; } } while (0)
    Unit cur, nxt; int ui = 0;
    if (!S.next(0, cur)) return;
    f32x4 acc[2][2][4][2];
#pragma unroll
    for (int a = 0; a < 2; ++a)
#pragma unroll
        for (int b = 0; b < 2; ++b)
#pragma unroll
            for (int m = 0; m < 4; ++m)
#pragma unroll
                for (int n = 0; n < 2; ++n) acc[a][b][m][n] = (f32x4){0.f, 0.f, 0.f, 0.f};
    bf16x8 At[4][2], B0[2][2], B1[2][2];
    unsigned oc0[2], oc1[2], on0[2], on1[2];
    PG8_MKOFF(cur, oc0, oc1);
    on0[0] = oc0[0]; on0[1] = oc0[1]; on1[0] = oc1[0]; on1[1] = oc1[1];
    const char* cA = cur.ap; const char* cB = cur.bp;
    PG8_STAGE(PG8_SB(0, 0), cB, voffB); PG8_STAGE(PG8_SB(0, 1), cB + hstepB, voffB); PG8_STAGE(PG8_SA(0, 0), cA, oc0); PG8_STAGE(PG8_SA(0, 1), cA, oc1);
    if (wr == 1) PG8_BAR;
    PG8_WAIT_V(2); PG8_BAR;
    PG8_STAGE(PG8_SB(1, 0), cB + kstep, voffB); PG8_STAGE(PG8_SA(1, 0), cA + kstep, oc0); PG8_STAGE(PG8_SB(1, 1), cB + hstepB + kstep, voffB);
    PG8_WAIT_V(6); PG8_BAR;
    for (;;) {
        const bool has_next = S.next(ui + 1, nxt);
        const char* nA = has_next ? nxt.ap : cA; const char* nB = has_next ? nxt.bp : cB;
        for (int t = 0; t < nt; t += 2) {
            const bool last = (t == nt - 2);
            if (last && has_next) { PG8_MKOFF(nxt, on0, on1); }
            const char* a1 = cA + (size_t)(t + 1) * kstep;
            const char* a2 = last ? nA : cA + (size_t)(t + 2) * kstep; const char* b2 = last ? nB : cB + (size_t)(t + 2) * kstep;
            const char* a3 = a2 + kstep; const char* b3 = b2 + kstep;
            unsigned o20[2], o21[2];
            o20[0] = last ? on0[0] : oc0[0]; o20[1] = last ? on0[1] : oc0[1]; o21[0] = last ? on1[0] : oc1[0]; o21[1] = last ? on1[1] : oc1[1];
            PG8_LDB(B0, 0, 0); PG8_LDB(B1, 0, 1); PG8_SCHED; PG8_LDA(At, 0, 0); PG8_STAGE(PG8_SA(1, 1), a1, oc1);
            PG8_WAIT_V(8); PG8_WAIT_L(0); PG8_BAR; PG8_MMA(0, 0, At, B0); PG8_MMA(0, 1, At, B1); PG8_BAR; PG8_SCHED;
            PG8_LDA(At, 0, 1); PG8_STAGE(PG8_SB(0, 0), b2, voffB); PG8_STAGE(PG8_SB(0, 1), b2 + hstepB, voffB); PG8_STAGE(PG8_SA(0, 0), a2, o20);
            PG8_WAIT_V(8); PG8_WAIT_L(0); PG8_BAR; PG8_MMA(1, 0, At, B0); PG8_MMA(1, 1, At, B1); PG8_BAR; PG8_SCHED;
            PG8_LDB(B0, 1, 0); PG8_LDB(B1, 1, 1); PG8_SCHED; PG8_LDA(At, 1, 0); PG8_STAGE(PG8_SA(0, 1), a2, o21);
            PG8_WAIT_V(8); PG8_WAIT_L(0); PG8_BAR; PG8_MMA(0, 0, At, B0); PG8_MMA(0, 1, At, B1); PG8_BAR; PG8_SCHED;
            PG8_LDA(At, 1, 1); PG8_STAGE(PG8_SB(1, 0), b3, voffB); PG8_STAGE(PG8_SB(1, 1), b3 + hstepB, voffB); PG8_STAGE(PG8_SA(1, 0), a3, o20);
            PG8_WAIT_V(8); PG8_WAIT_L(0); PG8_BAR; PG8_MMA(1, 0, At, B0); PG8_MMA(1, 1, At, B1); PG8_BAR; PG8_SCHED;
        }
        if (wr == 0) PG8_BAR;
        E(acc, cur, wr, wc, fr, fq);
        if (!has_next) break;
#pragma unroll
        for (int a = 0; a < 2; ++a)
#pragma unroll
            for (int b = 0; b < 2; ++b)
#pragma unroll
                for (int m = 0; m < 4; ++m)
#pragma unroll
                    for (int n = 0; n < 2; ++n) acc[a][b][m][n] = (f32x4){0.f, 0.f, 0.f, 0.f};
        cur = nxt; cA = nA; cB = nB; ++ui;
        oc0[0] = on0[0]; oc0[1] = on0[1]; oc1[0] = on1[0]; oc1[1] = on1[1];
        if (wr == 1) PG8_BAR;
    }
    PG8_WAIT_V(0);
    PG8_BAR;
#undef PG8_SA
#undef PG8_SB
#undef PG8_STAGE
#undef PG8_LDA
#undef PG8_LDB
#undef PG8_MMA
#undef PG8_WAIT_V
#undef PG8_WAIT_L
#undef PG8_BAR
#undef PG8_SCHED
#undef PG8_MKOFF
}
}

struct Params { const float* in[36]; float* out; unsigned char* ws; int ph_lo, ph_hi; };
enum { I_X = 0, I_C, I_CTX, I_CCTX, I_ADAW, I_ADAB, I_NMIXG, I_NFFNG, I_ABWIN, I_ABWOUT, I_CONVW, I_CONVB, I_LWA, I_LBA, I_LWI, I_LBI, I_LAM,
       I_QNG, I_WUQ, I_KVNG, I_WUKV, I_QHG, I_KHG, I_NAWQKV, I_NAWOUT, I_NAQHG, I_NAKHG, I_RPB, I_RW, I_RB, I_MWG, I_MWU, I_MWD, I_MSG, I_MSU, I_MSD };

using pg8::Unit;
struct EpiU {
    static constexpr bool PERM = true;
    bf16* U;
    __device__ __forceinline__ void operator()(const f32x4 (&acc)[2][2][4][2], const Unit& u, int wr, int wc, int fr, int fq) const {
        const int row0 = u.pm * 256 + wr * 64 + fr, col0 = u.pn * 256 + wc * 32 + 8 * fq;
        const bool gel = (u.pn >= 4 && u.pn < 8);
#pragma unroll
        for (int ai = 0; ai < 2; ++ai)
#pragma unroll
            for (int m = 0; m < 4; ++m) { bf16* rowp = U + (size_t)(row0 + ai * 128 + m * 16) * ABIN + col0;
#pragma unroll
                for (int bj = 0; bj < 2; ++bj) { if (col0 + bj * 128 >= ABIN) continue;
                    f32x4 v0 = acc[ai][bj][m][0], v1 = acc[ai][bj][m][1];
                    if (gel) {
#pragma unroll
                        for (int j = 0; j < 4; ++j) { v0[j] = gelu_tanh(v0[j]); v1[j] = gelu_tanh(v1[j]); } }
                    u32x4 w; w.x = cvt_pk_bf16(v0[0], v0[1]); w.y = cvt_pk_bf16(v0[2], v0[3]); w.z = cvt_pk_bf16(v1[0], v1[1]); w.w = cvt_pk_bf16(v1[2], v1[3]);
                    *(u32x4*)(rowp + bj * 128) = w; } }
    }
};
struct EpiBf {
    static constexpr bool PERM = true;
    bf16* O; int ldc;
    __device__ __forceinline__ void operator()(const f32x4 (&acc)[2][2][4][2], const Unit& u, int wr, int wc, int fr, int fq) const {
        const int row0 = u.pm * 256 + wr * 64 + fr, col0 = u.pn * 256 + wc * 32 + 8 * fq;
#pragma unroll
        for (int ai = 0; ai < 2; ++ai)
#pragma unroll
            for (int m = 0; m < 4; ++m) { bf16* rowp = O + (size_t)(row0 + ai * 128 + m * 16) * ldc + col0;
#pragma unroll
                for (int bj = 0; bj < 2; ++bj) { const f32x4 v0 = acc[ai][bj][m][0], v1 = acc[ai][bj][m][1];
                    u32x4 w; w.x = cvt_pk_bf16(v0[0], v0[1]); w.y = cvt_pk_bf16(v0[2], v0[3]); w.z = cvt_pk_bf16(v1[0], v1[1]); w.w = cvt_pk_bf16(v1[2], v1[3]);
                    *(u32x4*)(rowp + bj * 128) = w; } }
    }
};
struct EpiRes {
    static constexpr bool PERM = false;
    const float* xin_ctx; const float* xin_lat;
    float* xout; const float* gate; int row0;
    __device__ __forceinline__ void operator()(const f32x4 (&acc)[2][2][4][2], const Unit& u, int wr, int wc, int fr, int fq) const {
        const int r0 = row0 + u.pm * 256 + wr * 64 + fr, col0 = u.pn * 256 + wc * 32 + 4 * fq;
        const int v = vec_of_row(row0 + u.pm * 256);
        f32x4 g[2][2];
#pragma unroll
        for (int bj = 0; bj < 2; ++bj)
#pragma unroll
            for (int n = 0; n < 2; ++n) g[bj][n] = *(const f32x4*)(gate + (size_t)v * 12288 + col0 + bj * 128 + n * 16);
#pragma unroll
        for (int ai = 0; ai < 2; ++ai)
#pragma unroll
            for (int m = 0; m < 4; ++m) { const int row = r0 + ai * 128 + m * 16;
                const float* xi = (row < NCTX ? xin_ctx + (size_t)row * DM : xin_lat + (size_t)(row - NCTX) * DM) + col0; float* xo = xout + (size_t)row * DM + col0;
#pragma unroll
                for (int bj = 0; bj < 2; ++bj)
#pragma unroll
                    for (int n = 0; n < 2; ++n) { const f32x4 xv = *(const f32x4*)(xi + bj * 128 + n * 16); *(f32x4*)(xo + bj * 128 + n * 16) = xv + g[bj][n] * acc[ai][bj][m][n]; } }
    }
};
struct EpiSwiglu {
    static constexpr bool PERM = true;
    bf16* ACT;
    __device__ __forceinline__ void operator()(const f32x4 (&acc)[2][2][4][2], const Unit& u, int wr, int wc, int fr, int fq) const {
        const int row0 = u.pm * 256 + wr * 64 + fr, col0 = u.pn * 128 + wc * 32 + 8 * fq;
#pragma unroll
        for (int ai = 0; ai < 2; ++ai)
#pragma unroll
            for (int m = 0; m < 4; ++m) { bf16* rowp = ACT + (size_t)(row0 + ai * 128 + m * 16) * DE + col0;
                float o[8];
#pragma unroll
                for (int n = 0; n < 2; ++n)
#pragma unroll
                    for (int j = 0; j < 4; ++j) { const float gv = acc[ai][0][m][n][j], uv = acc[ai][1][m][n][j]; o[n * 4 + j] = gv / (1.0f + __expf(-gv)) * uv; }
                u32x4 w; w.x = cvt_pk_bf16(o[0], o[1]); w.y = cvt_pk_bf16(o[2], o[3]); w.z = cvt_pk_bf16(o[4], o[5]); w.w = cvt_pk_bf16(o[6], o[7]);
                *(u32x4*)rowp = w; }
    }
};

struct Frame {
    LAS unsigned char* lds; volatile LAS unsigned* MISC; unsigned* ctl; unsigned char* ws;
    int tid, lane, wave, vcu, G;
};

__device__ __forceinline__ void xpose_item(const float* W, int ldw, bf16* WT, int ldt, int k0, int n0, int drow0, LAS float* scr, int lane) {
#pragma unroll 8
    for (int i = 0; i < 32; ++i) { const int kk = 2 * i + (lane >> 5); scr[kk * 33 + (lane & 31)] = W[(size_t)(k0 + kk) * ldw + n0 + (lane & 31)]; }
    LDS_WAIT(); asm volatile("" ::: "memory");
    const int c = lane & 7;
#pragma unroll
    for (int j = 0; j < 4; ++j) { const int n = (lane >> 3) + 8 * j; const LAS float* s = scr + (8 * c) * 33 + n;
        u32x4 o; o.x = pk2(s[0 * 33], s[1 * 33]); o.y = pk2(s[2 * 33], s[3 * 33]); o.z = pk2(s[4 * 33], s[5 * 33]); o.w = pk2(s[6 * 33], s[7 * 33]);
        *(u32x4*)(WT + (size_t)(drow0 + n) * ldt + k0 + 8 * c) = o; }
    LDS_WAIT(); asm volatile("" ::: "memory");
}
__device__ __forceinline__ void xpose_job(const float* W, int K, int N, bf16* WT, int r, LAS float* scr, int lane) {
    const int nblk = N / 32, kb = r / nblk, nb = r % nblk;
    xpose_item(W, N, WT, K, 64 * kb, 32 * nb, 32 * nb, scr, lane);
}
__device__ __forceinline__ void p0_prologue(Frame& F, const Params& p) {
    unsigned char* ws = F.ws;
    LAS float* sil = (LAS float*)(F.lds + 69632);
    for (int i = F.tid; i < 5 * DM; i += NTHR) { const int v = i / DM, k = i % DM; const float x = v < 4 ? p.in[I_C][v * DM + k] : p.in[I_CCTX][k]; sil[i] = x / (1.0f + __expf(-x)); }
    { const int gt = blockIdx.x * NTHR + F.tid;
      if (gt < 1024) { const int pos = gt >> 4, i = gt & 15; const float inv = powf(10000.0f, -(float)(2 * i) / 32.0f); const float ang = (float)pos * inv;
          ((f32x2*)(ws + WS_ROPE))[gt] = (f32x2){cosf(ang), sinf(ang)}; } }
    { u32x4* z = (u32x4*)(ws + WS_WIN + (size_t)ABIN * DM * 2); const int n16 = (ABINP - ABIN) * DM * 2 / 16;
      for (int i = blockIdx.x * NTHR + F.tid; i < n16; i += F.G * NTHR) z[i] = (u32x4){0u, 0u, 0u, 0u}; }
    __syncthreads();
    if (F.wave < 3) {
        for (int item = blockIdx.x * 3 + F.wave; item < 768; item += F.G * 3) {
            const int l = item / 384, rem = item % 384, cg = rem >> 3, kc = rem & 7;
            const float* wp = p.in[I_ADAW] + ((size_t)l * DM + kc * 256) * 12288 + cg * 256 + F.lane * 4;
            f32x4 a0 = {0.f, 0.f, 0.f, 0.f}, a1 = a0, a2 = a0, a3 = a0, a4 = a0;
#pragma unroll 8
            for (int kk = 0; kk < 256; ++kk) { const f32x4 w = *(const f32x4*)(wp + (size_t)kk * 12288); const int k = kc * 256 + kk;
                a0 += w * sil[k]; a1 += w * sil[DM + k]; a2 += w * sil[2 * DM + k]; a3 += w * sil[3 * DM + k]; a4 += w * sil[4 * DM + k]; }
            float* o = (float*)(ws + WS_MODP) + ((size_t)(kc * 2 + l) * 5) * 12288 + cg * 256 + F.lane * 4;
            *(f32x4*)(o) = a0; *(f32x4*)(o + 12288) = a1; *(f32x4*)(o + 2 * 12288) = a2; *(f32x4*)(o + 3 * 12288) = a3; *(f32x4*)(o + 4 * 12288) = a4;
        }
    }
    LAS float* scr = (LAS float*)(F.lds + F.wave * 8448);
    const int gw = F.vcu * NWAVES + F.wave, NGW = F.G * NWAVES;
    constexpr int I_WIN = (DM / 64) * (ABIN / 32), I_WO = (DM / 64) * (DM / 32), I_UQ = (512 / 64) * (1536 / 32), I_UKV = (512 / 64) * (2048 / 32);
    constexpr int I_G1 = 8, I_GALL = 32 * I_G1, I_QKV = (DM / 64) * (6144 / 32), I_MOE1 = 1408;
    constexpr int NITEMS = I_WIN + I_WO + I_UQ + I_UKV + I_GALL + I_QKV + I_WO + 102 * I_MOE1;
    for (int it = gw; it < NITEMS; it += NGW) {
        int r = it;
        if (r < I_WIN) { xpose_job(p.in[I_ABWIN], DM, ABIN, (bf16*)(ws + WS_WIN), r, scr, F.lane); continue; } r -= I_WIN;
        if (r < I_WO) { xpose_job(p.in[I_ABWOUT], DM, DM, (bf16*)(ws + WS_WOUT0), r, scr, F.lane); continue; } r -= I_WO;
        if (r < I_UQ) { xpose_job(p.in[I_WUQ], 512, 1536, (bf16*)(ws + WS_WUQ), r, scr, F.lane); continue; } r -= I_UQ;
        if (r < I_UKV) { xpose_job(p.in[I_WUKV], 512, 2048, (bf16*)(ws + WS_WUKV), r, scr, F.lane); continue; } r -= I_UKV;
        if (r < I_GALL) { const int mi = r / I_G1, rr = r % I_G1;
            const int g = mi >> 3, blk = mi & 7, dir = g >> 1, ty = g & 1;
            const float* src = (ty ? p.in[I_LWI] : p.in[I_LWA]) + (size_t)(dir * 8 + blk) * 128 * 128;
            xpose_job(src, 128, 128, (bf16*)(ws + WS_WG) + (size_t)mi * 128 * 128, rr, scr, F.lane); continue; } r -= I_GALL;
        if (r < I_QKV) { xpose_job(p.in[I_NAWQKV], DM, 6144, (bf16*)(ws + WS_WQKV), r, scr, F.lane); continue; } r -= I_QKV;
        if (r < I_WO) { xpose_job(p.in[I_NAWOUT], DM, DM, (bf16*)(ws + WS_WOUT1), r, scr, F.lane); continue; } r -= I_WO;
        { const int m = r / I_MOE1, rr = r % I_MOE1, l = m / 51, mm = m % 51, which = mm / 17, e = mm % 17;
          if (which < 2) {
              const float* src = which == 0 ? (e < 16 ? p.in[I_MWG] + (size_t)(l * 16 + e) * DM * DE : p.in[I_MSG] + (size_t)l * DM * DE)
                                            : (e < 16 ? p.in[I_MWU] + (size_t)(l * 16 + e) * DM * DE : p.in[I_MSU] + (size_t)l * DM * DE);
              const int kb = rr / 44, nb = rr % 44, n0 = 32 * nb;
              xpose_item(src, DE, (bf16*)(ws + WS_W1 + (size_t)(l * 17 + e) * W1_E), DM, 64 * kb, n0, (n0 / 128) * 256 + (n0 % 128) + (which ? 128 : 0), scr, F.lane);
          } else {
              const float* src = e < 16 ? p.in[I_MWD] + (size_t)(l * 16 + e) * DE * DM : p.in[I_MSD] + (size_t)l * DE * DM;
              const int kb = rr / 64, nb = rr % 64;
              xpose_item(src, DM, (bf16*)(ws + WS_W2 + (size_t)(l * 17 + e) * W2_E), DE, 64 * kb, 32 * nb, 32 * nb, scr, F.lane);
          } }
    }
}

__device__ __forceinline__ void load_row_f32(const float* xrow, int lane, f32x4 (&v)[8]) {
#pragma unroll
    for (int j = 0; j < 8; ++j) v[j] = *(const f32x4*)(xrow + 4 * lane + 256 * j);
}
__device__ __forceinline__ float row_rstd(const f32x4 (&v)[8]) {
    float s = 0.f;
#pragma unroll
    for (int j = 0; j < 8; ++j) s += (v[j].x * v[j].x + v[j].y * v[j].y) + (v[j].z * v[j].z + v[j].w * v[j].w);
    return rsqrtf(wave_sum(s) * (1.0f / DM) + EPS);
}
__device__ __forceinline__ void store_row_bf16(bf16* orow, int lane, const f32x4 (&h)[8]) {
#pragma unroll
    for (int j = 0; j < 8; ++j) { u32x2 w; w.x = pk2(h[j].x, h[j].y); w.y = pk2(h[j].z, h[j].w); *(u32x2*)(orow + 4 * lane + 256 * j) = w; }
}
__device__ __forceinline__ void p1_modulate0(Frame& F, const Params& p) {
    unsigned char* ws = F.ws;
    const float* modp = (const float*)(ws + WS_MODP);
    { float* mod = (float*)(ws + WS_MOD);
      for (int i = blockIdx.x * NTHR + F.tid; i < 2 * 5 * 12288; i += F.G * NTHR) { const int l = i / (5 * 12288), n = i % 12288; float s = p.in[I_ADAB][l * 12288 + n];
#pragma unroll
          for (int kc = 0; kc < 8; ++kc) s += modp[(size_t)kc * (2 * 5 * 12288) + i];
          mod[i] = s; } }
    LAS float* gs = (LAS float*)F.lds; LAS float* sh = gs + DM;
    for (int g = blockIdx.x; g < NTOK / 64; g += F.G) {
        const int row0 = 64 * g, v = vec_of_row(row0);
        for (int n = F.tid; n < DM; n += NTHR) { float sc = p.in[I_ADAB][DM + n], sf = p.in[I_ADAB][n];
#pragma unroll
            for (int kc = 0; kc < 8; ++kc) { const float* mp = modp + ((size_t)(kc * 2 + 0) * 5 + v) * 12288; sf += mp[n]; sc += mp[DM + n]; }
            gs[n] = p.in[I_NMIXG][n] * (1.0f + sc); sh[n] = sf; }
        __syncthreads();
        for (int i = 0; i < 8; ++i) { const int row = row0 + F.wave + 8 * i;
            const float* xr = row < NCTX ? p.in[I_CTX] + (size_t)row * DM : p.in[I_X] + (size_t)(row - NCTX) * DM;
            f32x4 x[8]; load_row_f32(xr, F.lane, x); const float rstd = row_rstd(x);
#pragma unroll
            for (int j = 0; j < 8; ++j) { const f32x4 gg = *(const LAS f32x4*)(gs + 4 * F.lane + 256 * j), ss = *(const LAS f32x4*)(sh + 4 * F.lane + 256 * j); x[j] = x[j] * rstd * gg + ss; }
            store_row_bf16((bf16*)(ws + WS_H) + (size_t)row * DM, F.lane, x); }
        __syncthreads();
    }
}

__device__ __forceinline__ void p3_rank_norms(Frame& F, const Params& p) {
    const bf16* U = (const bf16*)(F.ws + WS_U); bf16* CQN = (bf16*)(F.ws + WS_CQN); bf16* CKVN = (bf16*)(F.ws + WS_CKVN);
    const int gw = blockIdx.x * NWAVES + F.wave, NGW = F.G * NWAVES;
    for (int row = gw; row < NTOK; row += NGW) {
#pragma unroll
        for (int w = 0; w < 2; ++w) {
            const u32x4 v = *(const u32x4*)(U + (size_t)row * ABIN + 2048 + 512 * w + 8 * F.lane);
            float x[8] = {bflo(v.x), bfhi(v.x), bflo(v.y), bfhi(v.y), bflo(v.z), bfhi(v.z), bflo(v.w), bfhi(v.w)};
            float s = 0.f;
#pragma unroll
            for (int j = 0; j < 8; ++j) s += x[j] * x[j];
            const float rstd = rsqrtf(wave_sum(s) * (1.0f / 512.0f) + EPS);
            const float* g = (w ? p.in[I_KVNG] : p.in[I_QNG]) + 8 * F.lane;
            const f32x4 g0 = *(const f32x4*)g, g1 = *(const f32x4*)(g + 4);
            u32x4 o; o.x = pk2(x[0] * rstd * g0.x, x[1] * rstd * g0.y); o.y = pk2(x[2] * rstd * g0.z, x[3] * rstd * g0.w);
            o.z = pk2(x[4] * rstd * g1.x, x[5] * rstd * g1.y); o.w = pk2(x[6] * rstd * g1.z, x[7] * rstd * g1.w);
            *(u32x4*)((w ? CKVN : CQN) + (size_t)row * 512 + 8 * F.lane) = o;
        }
    }
}
__device__ __forceinline__ void p3_conv_gates(Frame& F, const Params& p) {
    const bf16* U = (const bf16*)(F.ws + WS_U);
    float* AB = (float*)(F.ws + WS_AB);
    const bf16* WG = (const bf16*)(F.ws + WS_WG);
    LAS float* xcf = (LAS float*)F.lds;
    LAS unsigned char* xab = F.lds + 64 * 129 * 4;
    const int tid = F.tid, lane = F.lane, w = F.wave;
    for (int item = blockIdx.x; item < (NTOK / 64) * 8; item += F.G) {
        const int tt = item >> 3, n = item & 7;
        int row0, pos0, slen;
        if (tt < 16) { const int b = tt >> 2; pos0 = 64 * (tt & 3); slen = CTXL; row0 = b * CTXL + pos0; }
        else { const int tl = tt - 16, b = tl >> 6; pos0 = 64 * (tl & 63); slen = SEQ; row0 = NCTX + b * SEQ + pos0; }
        { const int i = tid >> 3, cg = tid & 7, ch0 = 128 * n + 16 * cg;
          float accv[16];
#pragma unroll
          for (int c = 0; c < 16; ++c) accv[c] = p.in[I_CONVB][ch0 + c];
#pragma unroll
          for (int j = 0; j < 4; ++j) { const int pos = pos0 + i + j - 2;
              if (pos >= 0 && pos < slen) {
                  const bf16* up = U + (size_t)(row0 + i + j - 2) * ABIN + ch0;
                  const u32x4 v0 = *(const u32x4*)up, v1 = *(const u32x4*)(up + 8);
                  const float x[16] = {bflo(v0.x), bfhi(v0.x), bflo(v0.y), bfhi(v0.y), bflo(v0.z), bfhi(v0.z), bflo(v0.w), bfhi(v0.w),
                                       bflo(v1.x), bfhi(v1.x), bflo(v1.y), bfhi(v1.y), bflo(v1.z), bfhi(v1.z), bflo(v1.w), bfhi(v1.w)};
                  const float* cw = p.in[I_CONVW] + j * DRNN + ch0;
#pragma unroll
                  for (int c = 0; c < 16; ++c) accv[c] += cw[c] * x[c]; } }
#pragma unroll
          for (int c = 0; c < 16; ++c) xcf[i * 129 + 16 * cg + c] = accv[c];
          u32x4 o0, o1; o0.x = pk2(accv[0], accv[1]); o0.y = pk2(accv[2], accv[3]); o0.z = pk2(accv[4], accv[5]); o0.w = pk2(accv[6], accv[7]);
          o1.x = pk2(accv[8], accv[9]); o1.y = pk2(accv[10], accv[11]); o1.z = pk2(accv[12], accv[13]); o1.w = pk2(accv[14], accv[15]);
          *(LAS u32x4*)(xab + i * 272 + 32 * cg) = o0; *(LAS u32x4*)(xab + i * 272 + 32 * cg + 16) = o1; }
        __syncthreads();
        bf16x8 af[4][4];
#pragma unroll
        for (int m = 0; m < 4; ++m)
#pragma unroll
            for (int ks = 0; ks < 4; ++ks) af[m][ks] = *(const LAS bf16x8*)(xab + (16 * m + (lane & 15)) * 272 + (32 * ks + 8 * (lane >> 4)) * 2);
        const int chl = 16 * w + (lane & 15), gch = 128 * n + chl;
#pragma unroll
        for (int d = 0; d < 2; ++d) {
            f32x4 ca[4], ci[4];
#pragma unroll
            for (int m = 0; m < 4; ++m) { ca[m] = (f32x4){0.f, 0.f, 0.f, 0.f}; ci[m] = ca[m]; }
#pragma unroll
            for (int ks = 0; ks < 4; ++ks) {
                const bf16x8 ba = *(const bf16x8*)(WG + ((size_t)((2 * d + 0) * 8 + n) * 128 + chl) * 128 + 32 * ks + 8 * (lane >> 4));
                const bf16x8 bi = *(const bf16x8*)(WG + ((size_t)((2 * d + 1) * 8 + n) * 128 + chl) * 128 + 32 * ks + 8 * (lane >> 4));
#pragma unroll
                for (int m = 0; m < 4; ++m) { ca[m] = __builtin_amdgcn_mfma_f32_16x16x32_bf16(af[m][ks], ba, ca[m], 0, 0, 0); ci[m] = __builtin_amdgcn_mfma_f32_16x16x32_bf16(af[m][ks], bi, ci[m], 0, 0, 0); }
            }
            const float ba_ = p.in[I_LBA][d * DRNN + gch], bi_ = p.in[I_LBI][d * DRNN + gch], lam = p.in[I_LAM][d * DRNN + gch];
            const float sp = log1pf(expf(-lam));
            float* Ao = AB + (size_t)(2 * d) * NTOK * DRNN; float* Bo = AB + (size_t)(2 * d + 1) * NTOK * DRNN;
#pragma unroll
            for (int m = 0; m < 4; ++m)
#pragma unroll
                for (int r = 0; r < 4; ++r) { const int i = 16 * m + 4 * (lane >> 4) + r;
                    const float rg = 1.0f / (1.0f + expf(-(ca[m][r] + ba_))), ig = 1.0f / (1.0f + expf(-(ci[m][r] + bi_)));
                    const float la = -8.0f * rg * sp; const float a = expf(la); const float bb = sqrtf(-expm1f(2.0f * la)) * ig * xcf[i * 129 + chl];
                    Ao[(size_t)(row0 + i) * DRNN + gch] = a; Bo[(size_t)(row0 + i) * DRNN + gch] = bb; }
        }
        __syncthreads();
    }
}
__device__ __forceinline__ int scan_row(int dir, int b, int c, int i) {
    if (dir == 0) return c < 4 ? b * CTXL + 64 * c + i : NCTX + b * SEQ + 64 * (c - 4) + i;
    return c < 4 ? b * CTXL + 255 - 64 * c - i : NCTX + b * SEQ + 4095 - 64 * (c - 4) - i;
}
__device__ __forceinline__ void scan_pass_b(Frame& F) {
    const float* AB = (const float*)(F.ws + WS_AB); f32x2* AGG = (f32x2*)(F.ws + WS_AGG);
    for (int item = blockIdx.x; item < 2 * NB * NCHUNK * 2; item += F.G) {
        const int half = item & 1, rest = item >> 1, c = rest % NCHUNK, db = rest / NCHUNK, b = db & 3, dir = db >> 2;
        const int ch = half * 512 + F.tid;
        const float* Ap = AB + (size_t)(2 * dir) * NTOK * DRNN + ch; const float* Bp = AB + (size_t)(2 * dir + 1) * NTOK * DRNN + ch;
        float A = 1.0f, Hc = 0.0f;
#pragma unroll 8
        for (int i = 0; i < 64; ++i) { const size_t r = (size_t)scan_row(dir, b, c, i) * DRNN; const float a = Ap[r], bb = Bp[r]; Hc = a * Hc + bb; A *= a; }
        AGG[((size_t)(dir * NB + b) * NCHUNK + c) * DRNN + ch] = (f32x2){A, Hc};
    }
}
__device__ __forceinline__ void scan_pass_c(Frame& F) {
    const f32x2* AGG = (const f32x2*)(F.ws + WS_AGG); float* CAR = (float*)(F.ws + WS_CARRY);
    for (int t = blockIdx.x * NTHR + F.tid; t < 2 * NB * DRNN; t += F.G * NTHR) {
        const int ch = t % DRNN, db = t / DRNN;
        float carry = 0.0f;
        for (int c = 0; c < NCHUNK; ++c) { const size_t idx = ((size_t)db * NCHUNK + c) * DRNN + ch; CAR[idx] = carry; const f32x2 ag = AGG[idx]; carry = ag.x * carry + ag.y; }
    }
}
__device__ __forceinline__ void scan_pass_d(Frame& F) {
    const float* AB = (const float*)(F.ws + WS_AB); const float* CAR = (const float*)(F.ws + WS_CARRY);
    const bf16* U = (const bf16*)(F.ws + WS_U); bf16* YC = (bf16*)(F.ws + WS_YC);
    LAS float* hf = (LAS float*)F.lds;
    for (int item = blockIdx.x; item < NB * NCHUNK * 2; item += F.G) {
        const int half = item & 1, rest = item >> 1, pc = rest % NCHUNK, b = rest / NCHUNK;
        const int ch = half * 512 + F.tid;
        const int cb = pc < 4 ? 3 - pc : 71 - pc;
        { const float* Ap = AB + ch; const float* Bp = AB + (size_t)NTOK * DRNN + ch;
          float h = CAR[((size_t)(0 * NB + b) * NCHUNK + pc) * DRNN + ch];
#pragma unroll 8
          for (int i = 0; i < 64; ++i) { const size_t r = (size_t)scan_row(0, b, pc, i) * DRNN; h = Ap[r] * h + Bp[r]; hf[i * 512 + F.tid] = h; } }
        { const float* Ap = AB + (size_t)2 * NTOK * DRNN + ch; const float* Bp = AB + (size_t)3 * NTOK * DRNN + ch;
          float h = CAR[((size_t)(1 * NB + b) * NCHUNK + cb) * DRNN + ch];
#pragma unroll 8
          for (int i = 0; i < 64; ++i) { const int row = scan_row(1, b, cb, i); const size_t r = (size_t)row * DRNN; h = Ap[r] * h + Bp[r];
              const float gate = bf2f(U[(size_t)row * ABIN + DRNN + ch]);
              YC[(size_t)row * DM + ch] = (bf16)f2bf((hf[(63 - i) * 512 + F.tid] + h) * gate); } }
    }
}

__device__ __forceinline__ void p5_mla_finalize(Frame& F, const Params& p) {
    const bf16* QRAW = (const bf16*)(F.ws + WS_QRAW); const bf16* KVRAW = (const bf16*)(F.ws + WS_KVRAW); const bf16* U = (const bf16*)(F.ws + WS_U);
    bf16* QF = (bf16*)(F.ws + WS_QF); bf16* KF = (bf16*)(F.ws + WS_KF);
    const f32x2* rope = (const f32x2*)(F.ws + WS_ROPE);
    const int lane = F.lane;
    const float gq0 = p.in[I_QHG][lane], gq1 = p.in[I_QHG][64 + lane], gq2 = p.in[I_QHG][128 + lane];
    const float gk0 = p.in[I_KHG][lane], gk1 = p.in[I_KHG][64 + lane], gk2 = p.in[I_KHG][128 + lane];
    const float qs = 0.07216878364870322f * LOG2E;
    const int gw = blockIdx.x * NWAVES + F.wave, NGW = F.G * NWAVES;
    for (int row = gw; row < NTOK; row += NGW) {
        const bool lat = row >= NCTX;
        float cs = 1.0f, sn = 0.0f;
        if (lat) { const int t = (row - NCTX) % SEQ; const int pos = (lane < 32) ? (t / GW) : (t % GW); const f32x2 r = rope[pos * 16 + (lane & 15)]; cs = r.x; sn = r.y; }
        const float kr = bf2f(U[(size_t)row * ABIN + 3072 + lane]);
        const float kr2 = kr * kr;
#pragma unroll
        for (int h = 0; h < MH; ++h) {
            { const bf16* q = QRAW + (size_t)row * 1536 + h * MQK;
              const float v0 = bf2f(q[lane]), v1 = bf2f(q[64 + lane]), v2 = bf2f(q[128 + lane]);
              const float rstd = rsqrtf(wave_sum(v0 * v0 + v1 * v1 + v2 * v2) * (1.0f / MQK) + EPS);
              const float o0 = v0 * rstd * gq0, o1 = v1 * rstd * gq1; float o2 = v2 * rstd * gq2;
              const float pr = __shfl_xor(o2, 16);
              if (lat) o2 = (lane & 16) ? (pr * sn + o2 * cs) : (o2 * cs - pr * sn);
              bf16* qo = QF + ((size_t)row * MH + h) * MQK;
              qo[lane] = (bf16)f2bf(o0 * qs); qo[64 + lane] = (bf16)f2bf(o1 * qs); qo[128 + lane] = (bf16)f2bf(o2 * qs); }
            { const bf16* k = KVRAW + (size_t)row * 2048 + h * 256;
              const float v0 = bf2f(k[lane]), v1 = bf2f(k[64 + lane]);
              const float rstd = rsqrtf(wave_sum(v0 * v0 + v1 * v1 + kr2) * (1.0f / MQK) + EPS);
              const float o0 = v0 * rstd * gk0, o1 = v1 * rstd * gk1; float o2 = kr * rstd * gk2;
              const float pr = __shfl_xor(o2, 16);
              if (lat) o2 = (lane & 16) ? (pr * sn + o2 * cs) : (o2 * cs - pr * sn);
              bf16* ko = KF + ((size_t)row * MH + h) * MQK;
              ko[lane] = (bf16)f2bf(o0); ko[64 + lane] = (bf16)f2bf(o1); ko[128 + lane] = (bf16)f2bf(o2); }
        }
    }
}

__device__ __forceinline__ int crow(int r, int hi) { return (r & 3) + 8 * (r >> 2) + 4 * hi; }
__device__ __forceinline__ int v_st(int k, int c) { const int kk = (k & ~0xC) | ((k & 4) << 1) | ((k & 8) >> 1); return ((kk >> 3) * 4 + (c >> 5)) * 512 + ((kk & 7) * 32 + (c & 31)) * 2; }
__device__ __forceinline__ int v_rd_base(int lane) { return ((lane & 3) << 3) | (((lane >> 2) & 3) << 6) | (((lane >> 4) & 1) << 5) | (((lane >> 5) & 1) << 8); }
constexpr int v_rd_off(int d0, int ks, int half) { return d0 * 512 + ks * 4096 + half * 2048; }
template <int OFF> __device__ __forceinline__ s16x4 tr_read(int vb) {
    s16x4 r; asm volatile("ds_read_b64_tr_b16 %0, %1 offset:%2" : "=&v"(r) : "v"(vb), "i"(OFF) : "memory"); return r;
}
template <int D0> __device__ __forceinline__ void pv_one(f32x16& od, int vb, bf16x8 pa0, bf16x8 pa1, bf16x8 pa2, bf16x8 pa3) {
    const s16x4 l0 = tr_read<v_rd_off(D0, 0, 0)>(vb), h0 = tr_read<v_rd_off(D0, 0, 1)>(vb), l1 = tr_read<v_rd_off(D0, 1, 0)>(vb), h1 = tr_read<v_rd_off(D0, 1, 1)>(vb);
    const s16x4 l2 = tr_read<v_rd_off(D0, 2, 0)>(vb), h2 = tr_read<v_rd_off(D0, 2, 1)>(vb), l3 = tr_read<v_rd_off(D0, 3, 0)>(vb), h3 = tr_read<v_rd_off(D0, 3, 1)>(vb);
    asm volatile("s_waitcnt lgkmcnt(0)" ::: "memory"); __builtin_amdgcn_sched_barrier(0);
#define PKV(L, H) (bf16x8){L[0], L[1], L[2], L[3], H[0], H[1], H[2], H[3]}
    od = __builtin_amdgcn_mfma_f32_32x32x16_bf16(pa0, PKV(l0, h0), od, 0, 0, 0);
    od = __builtin_amdgcn_mfma_f32_32x32x16_bf16(pa1, PKV(l1, h1), od, 0, 0, 0);
    od = __builtin_amdgcn_mfma_f32_32x32x16_bf16(pa2, PKV(l2, h2), od, 0, 0, 0);
    od = __builtin_amdgcn_mfma_f32_32x32x16_bf16(pa3, PKV(l3, h3), od, 0, 0, 0);
#undef PKV
}
__device__ __forceinline__ void pv_d0(f32x16* o, int vb, bf16x8 pa0, bf16x8 pa1, bf16x8 pa2, bf16x8 pa3) {
    pv_one<0>(o[0], vb, pa0, pa1, pa2, pa3); pv_one<1>(o[1], vb, pa0, pa1, pa2, pa3); pv_one<2>(o[2], vb, pa0, pa1, pa2, pa3); pv_one<3>(o[3], vb, pa0, pa1, pa2, pa3);
}
__device__ __forceinline__ void pack_p(const f32x16& p0, const f32x16& p1, bf16x8& pa0, bf16x8& pa1, bf16x8& pa2, bf16x8& pa3) {
#define PK4(P, BASE, OUT) do { unsigned a0 = cvt_pk_bf16(P[BASE + 0], P[BASE + 1]), a1 = cvt_pk_bf16(P[BASE + 2], P[BASE + 3]);   \
    unsigned b0 = cvt_pk_bf16(P[BASE + 4], P[BASE + 5]), b1 = cvt_pk_bf16(P[BASE + 6], P[BASE + 7]);                              \
    auto r0 = __builtin_amdgcn_permlane32_swap(a0, b0, false, false); auto r1 = __builtin_amdgcn_permlane32_swap(a1, b1, false, false); \
    u32x4 w = {r0[0], r1[0], r0[1], r1[1]}; OUT = __builtin_bit_cast(bf16x8, w); } while (0)
    PK4(p0, 0, pa0); PK4(p0, 8, pa1); PK4(p1, 0, pa2); PK4(p1, 8, pa3);
#undef PK4
}
template <int DQK> struct AttnG {
    static constexpr int CPR = DQK / 8, KSTR = DQK * 2 + 16, KBYTES = 64 * KSTR, NKCH = (64 * CPR) / 512, ND0 = DQK / 16;
    static constexpr int VOFF = 2 * KBYTES, LIOFF = VOFF + 2 * 16384, END = LIOFF + 8 * 128;
};
template <int DQK> __device__ __forceinline__ void attn_tile_load(bf16x8 (&kreg)[AttnG<DQK>::NKCH], bf16x8 (&vreg)[2], const bf16* kt, int ldk, const bf16* vt, int ldv, int tid) {
    using G = AttnG<DQK>;
#pragma unroll
    for (int i = 0; i < G::NKCH; ++i) { const int q = tid + 512 * i, row = q / G::CPR, ch = q % G::CPR; kreg[i] = *(const bf16x8*)(kt + (size_t)row * ldk + ch * 8); }
    const int sr = tid >> 4, sc = (tid & 15) * 8;
    vreg[0] = *(const bf16x8*)(vt + (size_t)sr * ldv + sc); vreg[1] = *(const bf16x8*)(vt + (size_t)(32 + sr) * ldv + sc);
}
template <int DQK> __device__ __forceinline__ void attn_tile_write(const bf16x8 (&kreg)[AttnG<DQK>::NKCH], const bf16x8 (&vreg)[2], LAS unsigned char* kb, LAS unsigned char* vbuf, int tid) {
    using G = AttnG<DQK>;
#pragma unroll
    for (int i = 0; i < G::NKCH; ++i) { const int q = tid + 512 * i, row = q / G::CPR, ch = q % G::CPR; *(LAS bf16x8*)(kb + row * G::KSTR + ch * 16) = kreg[i]; }
    const int sr = tid >> 4, sc = (tid & 15) * 8;
    *(LAS bf16x8*)(vbuf + v_st(sr, sc)) = vreg[0]; *(LAS bf16x8*)(vbuf + v_st(32 + sr, sc)) = vreg[1];
}
template <int DQK> __device__ __forceinline__ void attn_qkt(f32x16& p0, f32x16& p1, const LAS unsigned char* kb, const bf16x8 (&qr)[AttnG<DQK>::ND0], int r32, int hi) {
    using G = AttnG<DQK>;
#pragma unroll
    for (int r = 0; r < 16; ++r) { p0[r] = 0.f; p1[r] = 0.f; }
#pragma unroll
    for (int d0 = 0; d0 < G::ND0; ++d0) { const int cb = (d0 * 16 + hi * 8) * 2;
        const bf16x8 b0 = *(const LAS bf16x8*)(kb + r32 * G::KSTR + cb);
        const bf16x8 b1 = *(const LAS bf16x8*)(kb + (32 + r32) * G::KSTR + cb);
        p0 = __builtin_amdgcn_mfma_f32_32x32x16_bf16(b0, qr[d0], p0, 0, 0, 0);
        p1 = __builtin_amdgcn_mfma_f32_32x32x16_bf16(b1, qr[d0], p1, 0, 0, 0); }
}
__device__ __forceinline__ void attn_store(const f32x16 (&o)[4], float lsum, LAS float* li, bf16* orow0, int ldo, int r32, int hi) {
    lsum += __shfl_xor(lsum, 32);
    if (hi == 0) li[r32] = lsum;
    LDS_WAIT();
    float rli[16];
#pragma unroll
    for (int r = 0; r < 16; ++r) rli[r] = 1.0f / li[crow(r, hi)];
#pragma unroll
    for (int r = 0; r < 16; ++r) { bf16* op = orow0 + (size_t)crow(r, hi) * ldo + r32;
#pragma unroll
        for (int d0 = 0; d0 < 4; ++d0) op[d0 * 32] = (bf16)f2bf(o[d0][r] * rli[r]); }
    LDS_WAIT();
}

__device__ __forceinline__ void mla_unit(Frame& F, int b, int h, int qrow0, int ntile) {
    using G = AttnG<MQK>;
    const bf16* QF = (const bf16*)(F.ws + WS_QF); const bf16* KF = (const bf16*)(F.ws + WS_KF); const bf16* KVRAW = (const bf16*)(F.ws + WS_KVRAW);
    bf16* YC = (bf16*)(F.ws + WS_YC);
    const int tid = F.tid, lane = F.lane, r32 = lane & 31, hi = lane >> 5, wid = F.wave;
    LAS unsigned char* lds = F.lds;
    LAS float* li = (LAS float*)(lds + G::LIOFF + wid * 128);
    bf16x8 qr[G::ND0];
    { const bf16* qp = QF + ((size_t)(qrow0 + wid * 32 + r32) * MH + h) * MQK + hi * 8;
#pragma unroll
      for (int d0 = 0; d0 < G::ND0; ++d0) qr[d0] = *(const bf16x8*)(qp + d0 * 16); }
    f32x16 o[4];
#pragma unroll
    for (int d = 0; d < 4; ++d)
#pragma unroll
        for (int r = 0; r < 16; ++r) o[d][r] = 0.f;
    float lsum = 0.f;
    const int vb0 = (int)(unsigned)(uintptr_t)(lds + G::VOFF) + v_rd_base(lane);
    bf16x8 kreg[G::NKCH], vreg[2];
#define MLA_TROW(j) ((j) < 4 ? b * CTXL + 64 * (j) : NCTX + b * SEQ + 64 * ((j) - 4))
    { const int tr = MLA_TROW(0); attn_tile_load<MQK>(kreg, vreg, KF + ((size_t)tr * MH + h) * MQK, MH * MQK, KVRAW + (size_t)tr * 2048 + h * 256 + 128, 2048, tid); }
    attn_tile_write<MQK>(kreg, vreg, lds, lds + G::VOFF, tid);
    __syncthreads();
    for (int j = 0; j < ntile; ++j) {
        const int cur = j & 1;
        if (j + 1 < ntile) { const int tr = MLA_TROW(j + 1); attn_tile_load<MQK>(kreg, vreg, KF + ((size_t)tr * MH + h) * MQK, MH * MQK, KVRAW + (size_t)tr * 2048 + h * 256 + 128, 2048, tid); }
        f32x16 p0, p1;
        attn_qkt<MQK>(p0, p1, lds + cur * G::KBYTES, qr, r32, hi);
#pragma unroll
        for (int r = 0; r < 16; ++r) { p0[r] = __builtin_amdgcn_exp2f(p0[r]); p1[r] = __builtin_amdgcn_exp2f(p1[r]); }
        float ps = 0.f;
#pragma unroll
        for (int r = 0; r < 16; ++r) ps += p0[r] + p1[r];
        lsum += ps;
        bf16x8 pa0, pa1, pa2, pa3; pack_p(p0, p1, pa0, pa1, pa2, pa3);
        pv_d0(o, vb0 + cur * 16384, pa0, pa1, pa2, pa3);
        if (j + 1 < ntile) attn_tile_write<MQK>(kreg, vreg, lds + (cur ^ 1) * G::KBYTES, lds + G::VOFF + (cur ^ 1) * 16384, tid);
        __syncthreads();
    }
#undef MLA_TROW
    attn_store(o, lsum, li, YC + (size_t)(qrow0 + wid * 32) * DM + DRNN + h * MV, DM, r32, hi);
    __syncthreads();
}
__device__ __forceinline__ void p6_mla_attention(Frame& F) {
    for (int U = F.vcu; U < 544; U += F.G) {
        int b, h, qrow0, ntile;
        if (U < 512) { const int bh = U >> 4, qb = U & 15; b = bh >> 3; h = bh & 7; qrow0 = NCTX + b * SEQ + qb * 256; ntile = 68; }
        else { const int bh = U - 512; b = bh >> 3; h = bh & 7; qrow0 = b * CTXL; ntile = 4; }
        mla_unit(F, b, h, qrow0, ntile);
    }
}

__device__ __forceinline__ void p15_na_finalize(Frame& F, const Params& p) {
    bf16* QKV = (bf16*)(F.ws + WS_QKV);
    const int lane = F.lane;
    const float gq0 = p.in[I_NAQHG][lane], gq1 = p.in[I_NAQHG][64 + lane], gk0 = p.in[I_NAKHG][lane], gk1 = p.in[I_NAKHG][64 + lane];
    const float qs = 0.08838834764831845f * LOG2E;
    const int gw = blockIdx.x * NWAVES + F.wave, NGW = F.G * NWAVES;
    for (int row = gw; row < NTOK; row += NGW) {
        bf16* rp = QKV + (size_t)row * 6144;
        if (row >= NCTX) {
#pragma unroll 4
            for (int h = 0; h < NAH; ++h) { bf16* q = rp + h * NAD; const float v0 = bf2f(q[lane]), v1 = bf2f(q[64 + lane]);
                const float rstd = rsqrtf(wave_sum(v0 * v0 + v1 * v1) * (1.0f / NAD) + EPS);
                q[lane] = (bf16)f2bf(v0 * rstd * gq0 * qs); q[64 + lane] = (bf16)f2bf(v1 * rstd * gq1 * qs); } }
#pragma unroll 4
        for (int h = 0; h < NAH; ++h) { bf16* k = rp + DM + h * NAD; const float v0 = bf2f(k[lane]), v1 = bf2f(k[64 + lane]);
            const float rstd = rsqrtf(wave_sum(v0 * v0 + v1 * v1) * (1.0f / NAD) + EPS);
            k[lane] = (bf16)f2bf(v0 * rstd * gk0); k[64 + lane] = (bf16)f2bf(v1 * rstd * gk1); }
    }
}
__device__ __forceinline__ void na_unit(Frame& F, const Params& p, int b, int h, int R0) {
    using G = AttnG<NAD>;
    const bf16* QKV = (const bf16*)(F.ws + WS_QKV); bf16* ATT = (bf16*)(F.ws + WS_ATT2);
    const int tid = F.tid, lane = F.lane, r32 = lane & 31, hi = lane >> 5, wid = F.wave;
    LAS unsigned char* lds = F.lds;
    LAS float* li = (LAS float*)(lds + G::LIOFF + wid * 128);
    LAS float* rpbl = (LAS float*)(lds + G::END);
    for (int i = tid; i < 15 * 32; i += NTHR) { const int dr = i >> 5, dc = i & 31; rpbl[i] = dc < 31 ? p.in[I_RPB][(h * 15 + dr) * 31 + dc] * LOG2E : 0.f; }
    const int rq = R0 + (wid >> 1), qc = 32 * (wid & 1) + r32;
    const int qrow = NCTX + b * SEQ + rq * GW + qc;
    bf16x8 qr[G::ND0];
    { const bf16* qp = QKV + (size_t)qrow * 6144 + h * NAD + hi * 8;
#pragma unroll
      for (int d0 = 0; d0 < G::ND0; ++d0) qr[d0] = *(const bf16x8*)(qp + d0 * 16); }
    f32x16 o[4];
#pragma unroll
    for (int d = 0; d < 4; ++d)
#pragma unroll
        for (int r = 0; r < 16; ++r) o[d][r] = 0.f;
    float lsum = 0.f;
    const int vb0 = (int)(unsigned)(uintptr_t)(lds + G::VOFF) + v_rd_base(lane);
    const int klo = min(max(R0 - 4, 0), 56), khi = min(max(R0 + 3 - 4, 0), 56) + 7, nloc = khi - klo + 1, ntile = nloc + 4;
    const int w0 = min(max(rq - 4, 0), 56);
    const int cst = min(max(qc - 8, 0), 48);
    bf16x8 kreg[G::NKCH], vreg[2];
#define NA_TROW(j) ((j) < nloc ? NCTX + b * SEQ + (klo + (j)) * GW : b * CTXL + 64 * ((j) - nloc))
    { const int tr = NA_TROW(0); attn_tile_load<NAD>(kreg, vreg, QKV + (size_t)tr * 6144 + DM + h * NAD, 6144, QKV + (size_t)tr * 6144 + 2 * DM + h * NAD, 6144, tid); }
    attn_tile_write<NAD>(kreg, vreg, lds, lds + G::VOFF, tid);
    __syncthreads();
    for (int j = 0; j < ntile; ++j) {
        const int cur = j & 1;
        if (j + 1 < ntile) { const int tr = NA_TROW(j + 1); attn_tile_load<NAD>(kreg, vreg, QKV + (size_t)tr * 6144 + DM + h * NAD, 6144, QKV + (size_t)tr * 6144 + 2 * DM + h * NAD, 6144, tid); }
        const bool local = j < nloc; const int krow = klo + j;
        if (!local || (krow >= w0 && krow < w0 + 8)) {
            f32x16 p0, p1;
            attn_qkt<NAD>(p0, p1, lds + cur * G::KBYTES, qr, r32, hi);
            if (local) {
                const LAS float* brow = rpbl + (krow - rq + 7) * 32 + (15 - qc);
#pragma unroll
                for (int r = 0; r < 16; ++r) {
                    const int kc0 = crow(r, hi), kc1 = 32 + kc0;
                    const bool ok0 = kc0 >= cst && kc0 < cst + 16, ok1 = kc1 >= cst && kc1 < cst + 16;
                    const float b0 = ok0 ? brow[kc0] : 0.f, b1 = ok1 ? brow[kc1] : 0.f;
                    p0[r] = ok0 ? __builtin_amdgcn_exp2f(p0[r] + b0) : 0.f; p1[r] = ok1 ? __builtin_amdgcn_exp2f(p1[r] + b1) : 0.f; }
            } else {
#pragma unroll
                for (int r = 0; r < 16; ++r) { p0[r] = __builtin_amdgcn_exp2f(p0[r]); p1[r] = __builtin_amdgcn_exp2f(p1[r]); }
            }
            float ps = 0.f;
#pragma unroll
            for (int r = 0; r < 16; ++r) ps += p0[r] + p1[r];
            lsum += ps;
            bf16x8 pa0, pa1, pa2, pa3; pack_p(p0, p1, pa0, pa1, pa2, pa3);
            pv_d0(o, vb0 + cur * 16384, pa0, pa1, pa2, pa3);
        }
        if (j + 1 < ntile) attn_tile_write<NAD>(kreg, vreg, lds + (cur ^ 1) * G::KBYTES, lds + G::VOFF + (cur ^ 1) * 16384, tid);
        __syncthreads();
    }
#undef NA_TROW
    attn_store(o, lsum, li, ATT + (size_t)(NCTX + b * SEQ + rq * GW + 32 * (wid & 1)) * DM + h * NAD, DM, r32, hi);
    __syncthreads();
}
__device__ __forceinline__ void p16_na_attention(Frame& F, const Params& p) {
    for (int rnd = 0; rnd < 4; ++rnd)
        for (int U = rnd * 256 + F.vcu; U < rnd * 256 + 256; U += F.G) { const int bh = U >> 4, rg = U & 15, b = bh >> 4, h = bh & 15; na_unit(F, p, b, h, 4 * rg); }
}

__device__ __forceinline__ void p8_h2_route(Frame& F, const Params& p, int l, const float* X, int rbase) {
    unsigned char* ws = F.ws;
    LAS float* wt = (LAS float*)F.lds;
    for (int i = F.tid; i < DM * NE; i += NTHR) { const int k = i >> 4, e = i & 15; wt[e * DM + k] = p.in[I_RW][i]; }
    volatile LAS unsigned* lcnt = F.MISC + 16; volatile LAS unsigned* lbase = F.MISC + 32;
    LAS int* lrec = (LAS int*)(F.MISC + 64);
    if (F.tid < 16) lcnt[F.tid] = 0u;
    __syncthreads();
    const float* mod = (const float*)(ws + WS_MOD) + (size_t)l * 5 * 12288;
    const float* gn = p.in[I_NFFNG] + l * DM;
    float rb[16];
#pragma unroll
    for (int e = 0; e < 16; ++e) rb[e] = p.in[I_RB][e];
    int it = 0;
    for (int row = rbase + blockIdx.x * NWAVES + F.wave; row < NTOK; row += F.G * NWAVES, ++it) {
        const int v = vec_of_row(row);
        f32x4 x[8]; load_row_f32(X + (size_t)row * DM, F.lane, x); const float rstd = row_rstd(x);
        const float* mv = mod + (size_t)v * 12288;
#pragma unroll
        for (int j = 0; j < 8; ++j) { const int c = 4 * F.lane + 256 * j; const f32x4 g = *(const f32x4*)(gn + c), sc = *(const f32x4*)(mv + 4 * DM + c), sh = *(const f32x4*)(mv + 3 * DM + c);
            x[j] = x[j] * rstd * g * (1.0f + sc) + sh; }
        store_row_bf16((bf16*)(ws + WS_H) + (size_t)row * DM, F.lane, x);
        float lg[16];
#pragma unroll
        for (int e = 0; e < 16; ++e) { float s = 0.f;
#pragma unroll
            for (int j = 0; j < 8; ++j) { const f32x4 w = *(const LAS f32x4*)(wt + e * DM + 4 * F.lane + 256 * j); s += (x[j].x * w.x + x[j].y * w.y) + (x[j].z * w.z + x[j].w * w.w); }
            lg[e] = wave_sum(s); }
        float sc[16], sel[16];
#pragma unroll
        for (int e = 0; e < 16; ++e) { sc[e] = 1.0f / (1.0f + expf(-lg[e])); sel[e] = sc[e] + rb[e]; }
        int best = 0; float bestv = -3.0e38f;
#pragma unroll
        for (int g = 0; g < 4; ++g) { float m1 = -3.0e38f, m2 = -3.0e38f;
#pragma unroll
            for (int k = 0; k < 4; ++k) { const float s = sel[4 * g + k]; if (s > m1) { m2 = m1; m1 = s; } else if (s > m2) m2 = s; }
            const float gs = m1 + m2; if (gs > bestv) { bestv = gs; best = g; } }
        int e0 = 0, e1 = 0; float s0 = -3.0e38f, s1 = -3.0e38f, w0 = 0.f, w1 = 0.f;
#pragma unroll
        for (int e = 0; e < 16; ++e) { if ((e >> 2) == best) { const float s = sel[e];
                if (s > s0) { s1 = s0; e1 = e0; w1 = w0; s0 = s; e0 = e; w0 = sc[e]; } else if (s > s1) { s1 = s; e1 = e; w1 = sc[e]; } } }
        const float wn = 1.0f / (w0 + w1);
        if (F.lane == 0) {
            const int lp0 = (int)__hip_atomic_fetch_add((LAS unsigned*)(lcnt + e0), 1u, __ATOMIC_RELAXED, __HIP_MEMORY_SCOPE_WORKGROUP);
            const int lp1 = (int)__hip_atomic_fetch_add((LAS unsigned*)(lcnt + e1), 1u, __ATOMIC_RELAXED, __HIP_MEMORY_SCOPE_WORKGROUP);
            if (it < 64) { LAS int* r = lrec + (F.wave * 64 + it) * 4; r[0] = e0; r[1] = e1; r[2] = lp0; r[3] = lp1; }
            ((int*)(ws + WS_TOKE))[2 * row] = e0; ((int*)(ws + WS_TOKE))[2 * row + 1] = e1;
            ((float*)(ws + WS_TOKW))[2 * row] = w0 * wn; ((float*)(ws + WS_TOKW))[2 * row + 1] = w1 * wn;
        }
    }
    __syncthreads();
    if (F.tid < 16) { const unsigned n = lcnt[F.tid]; lbase[F.tid] = n ? __hip_atomic_fetch_add(F.ctl + CW_CNT + (l * 16 + F.tid) * 64, n, RLX_AGENT) : 0u; }
    __syncthreads();
    if (F.lane == 0) { it = 0;
        for (int row = rbase + blockIdx.x * NWAVES + F.wave; row < NTOK; row += F.G * NWAVES, ++it) { if (it >= 64) break;
            const LAS int* r = lrec + (F.wave * 64 + it) * 4;
            ((int*)(ws + WS_TOKP))[2 * row] = (int)lbase[r[0]] + r[2]; ((int*)(ws + WS_TOKP))[2 * row + 1] = (int)lbase[r[1]] + r[3]; } }
    __syncthreads();
}
__device__ __forceinline__ int moe_tiles(Frame& F, int l, int nsh, volatile LAS int* tile_e, int& ntot) {
    int nt_r = 0;
    if (F.tid == 0) { int t = 0;
        for (int e = 0; e < 16; ++e) { const int c = (int)__hip_atomic_load(F.ctl + CW_CNT + (l * 16 + e) * 64, RLX_AGENT); const int n = (c + 255) >> 8; for (int i = 0; i < n; ++i) tile_e[t++] = e; }
        for (int i = 0; i < nsh; ++i) tile_e[t + i] = 16;
        tile_e[255] = t; }
    __syncthreads();
    nt_r = __builtin_amdgcn_readfirstlane(tile_e[255]); ntot = nt_r + nsh;
    return nt_r;
}
__device__ __forceinline__ void p9_scatter(Frame& F, int l, int rbase) {
    unsigned char* ws = F.ws;
    int off[17]; { int t = 0;
#pragma unroll
        for (int e = 0; e < 16; ++e) { off[e] = t * 256; const int c = (int)__hip_atomic_load(F.ctl + CW_CNT + (l * 16 + e) * 64, RLX_AGENT); t += (c + 255) >> 8; }
        off[16] = t * 256; }
    const int* toke = (const int*)(ws + WS_TOKE); const int* tokp = (const int*)(ws + WS_TOKP); int* toks = (int*)(ws + WS_TOKS); int* slottok = (int*)(ws + WS_SLOTTOK);
    for (int i = blockIdx.x * NTHR + F.tid; i < (NTOK - rbase) * 2; i += F.G * NTHR) { const int row = rbase + (i >> 1), k = i & 1;
        const int e = toke[2 * row + k]; int o = 0;
#pragma unroll
        for (int q = 0; q < 16; ++q) o = (e == q) ? off[q] : o;
        const int slot = o + tokp[2 * row + k]; slottok[slot] = row; toks[2 * row + k] = slot; }
    for (int i = blockIdx.x * NTHR + F.tid; i < NTOK - rbase; i += F.G * NTHR) slottok[off[16] + i] = rbase + i;
    for (int i = blockIdx.x * NTHR + F.tid; i < 16 * 256; i += F.G * NTHR) { const int e = i >> 8, j = i & 255; int o = 0, on = 0;
#pragma unroll
        for (int q = 0; q < 16; ++q) { o = (e == q) ? off[q] : o; on = (e == q) ? off[q + 1] : on; }
        const int c = (int)__hip_atomic_load(F.ctl + CW_CNT + (l * 16 + e) * 64, RLX_AGENT);
        if (o + c + j < on) slottok[o + c + j] = rbase; }
}
__device__ __forceinline__ void p12_combine(Frame& F, const Params& p, int l, const float* Xin, float* Xout, int rbase, int sr_off) {
    unsigned char* ws = F.ws;
    const bf16* Y = (const bf16*)(ws + WS_Y);
    const float* mod = (const float*)(ws + WS_MOD) + (size_t)l * 5 * 12288;
    const int* toks = (const int*)(ws + WS_TOKS); const float* tokw = (const float*)(ws + WS_TOKW);
    for (int row = rbase + blockIdx.x * NWAVES + F.wave; row < NTOK; row += F.G * NWAVES) {
        const int v = vec_of_row(row);
        const int s0 = toks[2 * row], s1 = toks[2 * row + 1]; const float w0 = tokw[2 * row], w1 = tokw[2 * row + 1];
        const bf16* y0 = Y + (size_t)s0 * DM; const bf16* y1 = Y + (size_t)s1 * DM; const bf16* ys = Y + (size_t)(sr_off + row - rbase) * DM;
        const float* g5 = mod + (size_t)v * 12288 + 5 * DM;
        f32x4 x[8];
#pragma unroll
        for (int j = 0; j < 8; ++j) { const int c = 4 * F.lane + 256 * j;
            const f32x4 xi = *(const f32x4*)(Xin + (size_t)row * DM + c), g = *(const f32x4*)(g5 + c);
            const u32x2 a = *(const u32x2*)(ys + c), b0 = *(const u32x2*)(y0 + c), b1 = *(const u32x2*)(y1 + c);
            f32x4 m;
            m.x = bflo(a.x) + w0 * bflo(b0.x) + w1 * bflo(b1.x); m.y = bfhi(a.x) + w0 * bfhi(b0.x) + w1 * bfhi(b1.x);
            m.z = bflo(a.y) + w0 * bflo(b0.y) + w1 * bflo(b1.y); m.w = bfhi(a.y) + w0 * bfhi(b0.y) + w1 * bfhi(b1.y);
            x[j] = xi + g * m; }
        if (l == 0) {
#pragma unroll
            for (int j = 0; j < 8; ++j) *(f32x4*)(Xout + (size_t)row * DM + 4 * F.lane + 256 * j) = x[j];
            const float rstd = row_rstd(x);
            const float* m1 = (const float*)(ws + WS_MOD) + (size_t)(5 + v) * 12288; const float* gn = p.in[I_NMIXG] + DM;
#pragma unroll
            for (int j = 0; j < 8; ++j) { const int c = 4 * F.lane + 256 * j; const f32x4 g = *(const f32x4*)(gn + c), sc = *(const f32x4*)(m1 + DM + c), sh = *(const f32x4*)(m1 + c);
                x[j] = x[j] * rstd * g * (1.0f + sc) + sh; }
            store_row_bf16((bf16*)(ws + WS_H) + (size_t)row * DM, F.lane, x);
        } else {
#pragma unroll
            for (int j = 0; j < 8; ++j) *(f32x4*)(Xout + (size_t)(row - NCTX) * DM + 4 * F.lane + 256 * j) = x[j];
        }
    }
}

constexpr int NPHASE = 22;
__global__ void __launch_bounds__(NTHR, 2) mega_fwd(Params p) {
    extern __shared__ __attribute__((aligned(16))) unsigned char lds_raw[];
    Frame F;
    F.lds = (LAS unsigned char*)lds_raw; F.MISC = (volatile LAS unsigned*)(F.lds + MISC_OFF);
    F.tid = threadIdx.x; F.lane = F.tid & 63; F.wave = __builtin_amdgcn_readfirstlane(F.tid >> 6);
    F.G = gridDim.x; { const int bx = blockIdx.x; F.vcu = (F.G % 8 == 0) ? (bx % 8) * (F.G / 8) + bx / 8 : bx; }
    F.ws = p.ws; F.ctl = (unsigned*)(p.ws + WS_CTL);
    unsigned char* ws = p.ws;
    for (int u = F.tid; u < (LDS_BYTES - MISC_OFF) / 4; u += NTHR) ((LAS unsigned*)(F.lds + MISC_OFF))[u] = 0u;
    __syncthreads();
    const int lo = p.ph_lo, hi = p.ph_hi;
    XcdBarrier bar; bar.bar = F.ctl + CW_BAR; bar.x = 0; bar.st = F.MISC;
    if (hi - lo > 1) bar = xcd_barrier_post(F.ctl + CW_BAR, F.MISC);
#ifdef ONLY_PHASE
#define IN(k) ((k) == ONLY_PHASE && lo <= (k) && (k) < hi)
#else
#define IN(k) (lo <= (k) && (k) < hi)
#endif
#define SEAM(k) do { if (IN(k) && IN((k) + 1)) xcd_barrier(bar); } while (0)
    volatile LAS int* tile_e = (volatile LAS int*)(F.MISC + 2112);
#define REFRESH() do { int _tz = threadIdx.x; asm volatile("" : "+v"(_tz)); F.tid = _tz; F.lane = _tz & 63; F.wave = __builtin_amdgcn_readfirstlane(_tz >> 6); } while (0)
    const size_t TS2048 = (size_t)256 * 2048 * 2;

    if (IN(0)) { REFRESH(); p0_prologue(F, p); } SEAM(0);
    if (IN(1)) { REFRESH(); p1_modulate0(F, p); } SEAM(1);
    if (IN(2)) {   REFRESH();
        pg8::DenseSched S; S.T.init(NTOK / 256, ABINP / 256, F.G, (int)blockIdx.x); S.A = (const char*)(ws + WS_H); S.Bt = (const char*)(ws + WS_WIN); S.tstepB = TS2048; S.row0 = 0;
        EpiU E{(bf16*)(ws + WS_U)};
        pg8::gemm_phase<EpiU, pg8::DenseSched>(F.lds, DM, S, E);
    } SEAM(2);
    if (IN(3)) { REFRESH(); p3_rank_norms(F, p); REFRESH(); p3_conv_gates(F, p); } SEAM(3);
    if (IN(4)) {   REFRESH();
        { pg8::DenseSched S; S.T.init(NTOK / 256, 1536 / 256, F.G, (int)blockIdx.x); S.A = (const char*)(ws + WS_CQN); S.Bt = (const char*)(ws + WS_WUQ); S.tstepB = (size_t)256 * 512 * 2; S.row0 = 0;
          EpiBf E{(bf16*)(ws + WS_QRAW), 1536};
          pg8::gemm_phase<EpiBf, pg8::DenseSched>(F.lds, 512, S, E); }
        REFRESH();
        { pg8::DenseSched S; S.T.init(NTOK / 256, 2048 / 256, F.G, (int)blockIdx.x); S.A = (const char*)(ws + WS_CKVN); S.Bt = (const char*)(ws + WS_WUKV); S.tstepB = (size_t)256 * 512 * 2; S.row0 = 0;
          EpiBf E{(bf16*)(ws + WS_KVRAW), 2048};
          pg8::gemm_phase<EpiBf, pg8::DenseSched>(F.lds, 512, S, E); }
        REFRESH(); scan_pass_b(F);
    } SEAM(4);
    if (IN(5)) { REFRESH(); p5_mla_finalize(F, p); scan_pass_c(F); } SEAM(5);
    if (IN(6)) { REFRESH(); p6_mla_attention(F); REFRESH(); scan_pass_d(F); } SEAM(6);
    if (IN(7)) {   REFRESH();
        pg8::DenseSched S; S.T.init(NTOK / 256, DM / 256, F.G, (int)blockIdx.x); S.A = (const char*)(ws + WS_YC); S.Bt = (const char*)(ws + WS_WOUT0); S.tstepB = TS2048; S.row0 = 0;
        EpiRes E{p.in[I_CTX], p.in[I_X], (float*)(ws + WS_XA), (const float*)(ws + WS_MOD) + 2 * DM, 0};
        pg8::gemm_phase<EpiRes, pg8::DenseSched>(F.lds, DM, S, E);
    } SEAM(7);

#define MOE_PHASES(l) do { \
        constexpr int pb = (l) ? 17 : 8, rbase = (l) ? NCTX : 0, nsh = (l) ? NLAT / 256 : NTOK / 256; \
        if (IN(pb + 0)) { REFRESH(); p8_h2_route(F, p, (l), (const float*)(ws + WS_XA), rbase); } SEAM(pb + 0); \
        if (IN(pb + 1)) { REFRESH(); p9_scatter(F, (l), rbase); } SEAM(pb + 1); \
        if (IN(pb + 2)) { REFRESH(); \
            int ntot; moe_tiles(F, (l), nsh, tile_e, ntot); \
            pg8::MoeSched S; S.T.init(ntot, 11, F.G, (int)blockIdx.x); S.A = (const char*)(ws + WS_H); S.Bt = (const char*)(ws + WS_W1 + (size_t)(l) * 17 * W1_E); S.tstepB = TS2048; S.estride = W1_E; \
            S.rowmap = (const int*)(ws + WS_SLOTTOK); S.tile_e = tile_e; \
            EpiSwiglu E{(bf16*)(ws + WS_ACT)}; \
            pg8::gemm_phase<EpiSwiglu, pg8::MoeSched>(F.lds, DM, S, E); \
        } SEAM(pb + 2); \
        if (IN(pb + 3)) { REFRESH(); \
            int ntot; moe_tiles(F, (l), nsh, tile_e, ntot); \
            pg8::MoeSched S; S.T.init(ntot, 8, F.G, (int)blockIdx.x); S.A = (const char*)(ws + WS_ACT); S.Bt = (const char*)(ws + WS_W2 + (size_t)(l) * 17 * W2_E); S.tstepB = (size_t)256 * DE * 2; S.estride = W2_E; \
            S.rowmap = nullptr; S.tile_e = tile_e; \
            EpiBf E{(bf16*)(ws + WS_Y), DM}; \
            pg8::gemm_phase<EpiBf, pg8::MoeSched>(F.lds, DE, S, E); \
        } SEAM(pb + 3); \
        if (IN(pb + 4)) { REFRESH(); \
            int ntot; const int ntr = moe_tiles(F, (l), nsh, tile_e, ntot); \
            p12_combine(F, p, (l), (const float*)(ws + WS_XA), (l) ? p.out : (float*)(ws + WS_XB), rbase, ntr * 256); \
        } SEAM(pb + 4); \
    } while (0)
    MOE_PHASES(0);
    if (IN(13)) {   REFRESH();
        pg8::DenseSched S; S.T.init(NTOK / 256, 6144 / 256, F.G, (int)blockIdx.x); S.A = (const char*)(ws + WS_H); S.Bt = (const char*)(ws + WS_WQKV); S.tstepB = TS2048; S.row0 = 0;
        EpiBf E{(bf16*)(ws + WS_QKV), 6144};
        pg8::gemm_phase<EpiBf, pg8::DenseSched>(F.lds, DM, S, E);
    } SEAM(13);
    if (IN(14)) { REFRESH(); p15_na_finalize(F, p); } SEAM(14);
    if (IN(15)) { REFRESH(); p16_na_attention(F, p); } SEAM(15);
    if (IN(16)) {   REFRESH();
        pg8::DenseSched S; S.T.init(NLAT / 256, DM / 256, F.G, (int)blockIdx.x); S.A = (const char*)(ws + WS_ATT2); S.Bt = (const char*)(ws + WS_WOUT1); S.tstepB = TS2048; S.row0 = NCTX;
        EpiRes E{(const float*)(ws + WS_XB), (const float*)(ws + WS_XB) + (size_t)NCTX * DM, (float*)(ws + WS_XA), (const float*)(ws + WS_MOD) + (size_t)5 * 12288 + 2 * DM, NCTX};
        pg8::gemm_phase<EpiRes, pg8::DenseSched>(F.lds, DM, S, E);
    } SEAM(16);
    MOE_PHASES(1);
#undef MOE_PHASES
#undef IN
#undef SEAM
}

extern "C" void kernel_launch(void* const* d_in, const int* in_sizes, int n_in, void* d_out, int out_size, void* d_ws, size_t ws_size, hipStream_t stream) {
    static int grid = 0;
    if (grid == 0) {
        if (n_in != 36 || in_sizes[0] != NLAT * DM || out_size != NLAT * DM || ws_size < WS_END) {
            fprintf(stderr, "kernel_launch: shape mismatch: n_in %d in0 %d out %d ws %zu (need %zu)\n", n_in, n_in > 0 ? in_sizes[0] : -1, out_size, ws_size, (size_t)WS_END); grid = -1; return; }
        int dev = 0, cus = 0, per_cu = 0;
        if (hipGetDevice(&dev) != hipSuccess || hipDeviceGetAttribute(&cus, hipDeviceAttributeMultiprocessorCount, dev) != hipSuccess) { grid = -1; return; }
        if (hipFuncSetAttribute((const void*)mega_fwd, hipFuncAttributeMaxDynamicSharedMemorySize, LDS_BYTES) != hipSuccess) { fprintf(stderr, "kernel_launch: hipFuncSetAttribute failed\n"); grid = -1; return; }
        if (hipOccupancyMaxActiveBlocksPerMultiprocessor(&per_cu, (const void*)mega_fwd, NTHR, LDS_BYTES) != hipSuccess || per_cu < 1) { fprintf(stderr, "kernel_launch: occupancy query says %d\n", per_cu); }
        (void)hipGetLastError();
        grid = cus;
    }
    if (grid < 0) return;
    if (hipMemsetAsync((char*)d_ws + WS_CTL, 0, CTL_BYTES, stream) != hipSuccess) return;
    Params P{};
    for (int i = 0; i < 36; ++i) P.in[i] = (const float*)d_in[i];
    P.out = (float*)d_out; P.ws = (unsigned char*)d_ws;
#if MK_N_LAUNCHES == 1
    P.ph_lo = 0; P.ph_hi = NPHASE;
    hipLaunchKernelGGL(mega_fwd, dim3(grid), dim3(NTHR), LDS_BYTES, stream, P);
#else
    for (int k = 0; k < NPHASE; ++k) { P.ph_lo = k; P.ph_hi = k + 1; hipLaunchKernelGGL(mega_fwd, dim3(grid), dim3(NTHR), LDS_BYTES, stream, P); }
#endif
    const hipError_t le = hipPeekAtLastError();
    if (le != hipSuccess) fprintf(stderr, "kernel_launch: launch failed: %s\n", hipGetErrorName(le));
}
```

```cpp
#include <hip/hip_runtime.h>
#include <cstdio>
#include <cstdint>

#ifndef MK_N_LAUNCHES
#define MK_N_LAUNCHES 1
#endif

#define GAS __attribute__((address_space(1)))
#define LAS __attribute__((address_space(3)))
typedef unsigned short bf16;
typedef short bf16x8 __attribute__((ext_vector_type(8)));
typedef short s16x4 __attribute__((ext_vector_type(4)));
typedef float f32x2 __attribute__((ext_vector_type(2)));
typedef float f32x4 __attribute__((ext_vector_type(4)));
typedef float f32x16 __attribute__((ext_vector_type(16)));
typedef unsigned u32x2 __attribute__((ext_vector_type(2)));
typedef unsigned u32x4 __attribute__((ext_vector_type(4)));
#define LDS_WAIT() asm volatile("s_waitcnt lgkmcnt(0)" ::: "memory")
#define VM_WAIT() asm volatile("s_waitcnt vmcnt(0)" ::: "memory")
#define RLX_AGENT __ATOMIC_RELAXED, __HIP_MEMORY_SCOPE_AGENT

constexpr int DM = 2048, NB = 4, SEQ = 4096, CTXL = 256, GW = 64;
constexpr int NCTX = NB * CTXL, NLAT = NB * SEQ, NTOK = NCTX + NLAT;
constexpr int DRNN = 1024, QRK = 512, KVRK = 512, MROPE = 64, MNOPE = 128, MQK = 192, MV = 128, MH = 8;
constexpr int ABIN = 3136, ABINP = 3328;
constexpr int NAH = 16, NAD = 128;
constexpr int NE = 16, DE = 1408, NG = 4;
constexpr int NCHUNK = 68;
constexpr float EPS = 1e-6f;
constexpr float LOG2E = 1.4426950408889634f;
constexpr int MAXSLOT = 56320;

constexpr size_t al256(size_t x) { return (x + 255) / 256 * 256; }
constexpr size_t WS_CTL = 0, CTL_BYTES = 1u << 20;
constexpr int CW_TMO = 0, CW_BAR = 4096, CW_CNT = 16384;
constexpr size_t WS_MODP = CTL_BYTES;
constexpr size_t WS_MOD = WS_MODP + al256((size_t)8 * 2 * 5 * 12288 * 4);
constexpr size_t WS_ROPE = WS_MOD + al256((size_t)2 * 5 * 12288 * 4);
constexpr size_t WS_AGG = WS_ROPE + al256(64 * 16 * 8);
constexpr size_t WS_CARRY = WS_AGG + al256((size_t)2 * 4 * NCHUNK * 1024 * 8);
constexpr size_t WS_TOKE = WS_CARRY + al256((size_t)2 * 4 * NCHUNK * 1024 * 4);
constexpr size_t WS_TOKW = WS_TOKE + al256((size_t)NTOK * 8);
constexpr size_t WS_TOKP = WS_TOKW + al256((size_t)NTOK * 8);
constexpr size_t WS_TOKS = WS_TOKP + al256((size_t)NTOK * 8);
constexpr size_t WS_SLOTTOK = WS_TOKS + al256((size_t)NTOK * 8);
constexpr size_t WS_WIN = al256(WS_SLOTTOK + (size_t)MAXSLOT * 4);
constexpr size_t WS_WOUT0 = WS_WIN + (size_t)ABINP * DM * 2;
constexpr size_t WS_WUQ = WS_WOUT0 + (size_t)DM * DM * 2;
constexpr size_t WS_WUKV = WS_WUQ + (size_t)1536 * 512 * 2;
constexpr size_t WS_WG = WS_WUKV + (size_t)2048 * 512 * 2;
constexpr size_t WS_WQKV = WS_WG + (size_t)4 * 8 * 128 * 128 * 2;
constexpr size_t WS_WOUT1 = WS_WQKV + (size_t)6144 * DM * 2;
constexpr size_t W1_E = (size_t)2816 * DM * 2, W2_E = (size_t)DM * DE * 2;
constexpr size_t WS_W1 = WS_WOUT1 + (size_t)DM * DM * 2;
constexpr size_t WS_W2 = WS_W1 + 2 * 17 * W1_E;
constexpr size_t WS_XA = WS_W2 + 2 * 17 * W2_E;
constexpr size_t XBYTES = (size_t)NTOK * DM * 4;
constexpr size_t WS_XB = WS_XA + XBYTES;
constexpr size_t WS_H = WS_XB + XBYTES;
constexpr size_t WS_D = WS_H + (size_t)NTOK * DM * 2;
constexpr size_t WS_U = WS_D;
constexpr size_t WS_AB = WS_U + al256((size_t)NTOK * ABIN * 2);
constexpr size_t ABSZ = (size_t)NTOK * DRNN * 4;
constexpr size_t WS_CQN = WS_AB + 4 * ABSZ;
constexpr size_t WS_CKVN = WS_CQN + (size_t)NTOK * 512 * 2;
constexpr size_t WS_YC = WS_CKVN + (size_t)NTOK * 512 * 2;
constexpr size_t WS_D_END0 = WS_YC + (size_t)NTOK * DM * 2;
constexpr size_t WS_QRAW = WS_XA;
constexpr size_t WS_KVRAW = WS_QRAW + al256((size_t)NTOK * 1536 * 2);
constexpr size_t WS_QF = WS_XB;
constexpr size_t WS_KF = WS_QF + al256((size_t)NTOK * 1536 * 2);
static_assert(WS_KVRAW + (size_t)NTOK * 2048 * 2 <= WS_XB && WS_KF + (size_t)NTOK * 1536 * 2 <= WS_H, "mixer overlays");
constexpr size_t WS_ACT = WS_D;
constexpr size_t WS_Y = WS_ACT + al256((size_t)MAXSLOT * DE * 2);
constexpr size_t WS_D_END1 = WS_Y + (size_t)MAXSLOT * DM * 2;
constexpr size_t WS_QKV = WS_D;
constexpr size_t WS_ATT2 = WS_QKV + (size_t)NTOK * 6144 * 2;
constexpr size_t WS_D_END2 = WS_ATT2 + (size_t)NTOK * DM * 2;
constexpr size_t WS_END = (WS_D_END0 > WS_D_END1 ? (WS_D_END0 > WS_D_END2 ? WS_D_END0 : WS_D_END2) : (WS_D_END1 > WS_D_END2 ? WS_D_END1 : WS_D_END2));

constexpr int RING_BYTES = 131072;
constexpr int MISC_OFF = RING_BYTES;
constexpr int LDS_BYTES = 147456;
constexpr int NWAVES = 8, NTHR = 512;

__device__ __forceinline__ unsigned f2bf(float f) { unsigned u = __builtin_bit_cast(unsigned, f); return (u + 0x7fffu + ((u >> 16) & 1u)) >> 16; }
__device__ __forceinline__ unsigned pk2(float lo, float hi) { return f2bf(lo) | (f2bf(hi) << 16); }
__device__ __forceinline__ float bf2f(unsigned short b) { return __builtin_bit_cast(float, (unsigned)b << 16); }
__device__ __forceinline__ float bflo(unsigned w) { return __builtin_bit_cast(float, w << 16); }
__device__ __forceinline__ float bfhi(unsigned w) { return __builtin_bit_cast(float, w & 0xffff0000u); }
__device__ __forceinline__ unsigned cvt_pk_bf16(float lo, float hi) { unsigned r; asm volatile("v_cvt_pk_bf16_f32 %0, %1, %2" : "=v"(r) : "v"(lo), "v"(hi)); return r; }
__device__ __forceinline__ float wave_sum(float v) {
#pragma unroll
    for (int o = 1; o < 64; o <<= 1) v += __shfl_xor(v, o);
    return v;
}
__device__ __forceinline__ float sigmoidf_(float x) { return 1.0f / (1.0f + __expf(-x)); }
__device__ __forceinline__ float gelu_tanh(float x) { const float u = 0.7978845608028654f * (x + 0.044715f * x * x * x); const float th = 1.0f - 2.0f / (1.0f + __expf(2.0f * u)); return 0.5f * x * (1.0f + th); }
__device__ __forceinline__ int vec_of_row(int row) { return row < NCTX ? 4 : (row - NCTX) / SEQ; }

#define XB_TMO      128
#define XB_XCNT(j)  (256  + 64 * (j))
#define XB_XSUB(j)  (1280 + 64 * (j))
#define XB_XGEN(j)  (2304 + 64 * (j))
#define XB_TOP      3328
#define XB_TOPGEN   3392
#define XCD_BAR_WORDS 3456
#define XB_SPIN_CAP (1u << 18)
__device__ __forceinline__ unsigned xb_ld(unsigned* p)              { return __hip_atomic_load(p, __ATOMIC_RELAXED, __HIP_MEMORY_SCOPE_AGENT); }
__device__ __forceinline__ unsigned xb_add(unsigned* p, unsigned v) { return __hip_atomic_fetch_add(p, v, __ATOMIC_RELAXED, __HIP_MEMORY_SCOPE_AGENT); }
__device__ __forceinline__ unsigned xb_xcc_id() { return (unsigned)__builtin_amdgcn_s_getreg((3 << 11) | 20) & 0xFu; }
#define XB_SPIN(cond, bar) do { unsigned _sp = 0; while (cond) { __builtin_amdgcn_s_sleep(1); \
    if ((++_sp & 255u) == 0u) { if (xb_ld(&(bar)[XB_TMO])) break; if (_sp > XB_SPIN_CAP) { atomicAdd(&(bar)[XB_TMO], 1u); break; } } } } while (0)
struct XcdBarrier { unsigned* bar; unsigned x; volatile LAS unsigned* st; };
__device__ __forceinline__ XcdBarrier xcd_barrier_post(unsigned* bar, volatile LAS unsigned* st) {
    XcdBarrier b; b.bar = bar; b.x = xb_xcc_id(); b.st = st;
    if (threadIdx.x == 0) (void)xb_add(&bar[XB_XCNT(b.x)], 1u);
    return b;
}
__device__ __forceinline__ void xcd_barrier_complete(unsigned* bar, unsigned x, unsigned& nloc, unsigned& nx) {
    const unsigned G = gridDim.x * gridDim.y * gridDim.z;
    unsigned sum, cnt, mine, sp = 0u;
    for (;;) {
        sum = 0u; cnt = 0u; mine = 0u;
#pragma unroll
        for (unsigned j = 0; j < 16; ++j) { const unsigned c = xb_ld(&bar[XB_XCNT(j)]); sum += c; cnt += (c > 0u) ? 1u : 0u; mine = (j == x) ? c : mine; }
        if (sum == G) break;
        __builtin_amdgcn_s_sleep(1);
        if ((++sp & 255u) == 0u) { if (xb_ld(&bar[XB_TMO])) break; if (sp > XB_SPIN_CAP) { atomicAdd(&bar[XB_TMO], 1u); break; } }
    }
    nloc = mine > 0u ? mine : 1u; nx = cnt > 0u ? cnt : 1u;
}
__device__ __forceinline__ void xcd_barrier(const XcdBarrier& b) {
    asm volatile("s_waitcnt vmcnt(0)" ::: "memory");
    __syncthreads();
    if (threadIdx.x == 0) {
        unsigned* bar = b.bar;
        __builtin_amdgcn_s_waitcnt(0);
        unsigned nloc = b.st[0], nx = b.st[1];
        if (nloc == 0u) { xcd_barrier_complete(bar, b.x, nloc, nx); b.st[0] = nloc; b.st[1] = nx; }
        const unsigned old = xb_add(&bar[XB_XSUB(b.x)], 1u);
        const unsigned gen = old / nloc;
        if (old + 1u == (gen + 1u) * nloc) {
            __builtin_amdgcn_fence(__ATOMIC_RELEASE, "agent");
            asm volatile("s_waitcnt vmcnt(0)" ::: "memory");
            const unsigned og = xb_add(&bar[XB_TOP], 1u);
            const unsigned tg = og / nx;
            if (og + 1u == (tg + 1u) * nx) xb_add(&bar[XB_TOPGEN], 1u);
            else XB_SPIN(xb_ld(&bar[XB_TOPGEN]) == tg, bar);
            __builtin_amdgcn_fence(__ATOMIC_ACQUIRE, "agent");
            xb_add(&bar[XB_XGEN(b.x)], 1u);
            asm volatile("s_waitcnt vmcnt(0)" ::: "memory");
        } else {
            XB_SPIN(xb_ld(&bar[XB_XGEN(b.x)]) == gen, bar);
            __builtin_amdgcn_fence(__ATOMIC_ACQUIRE, "agent");
            asm volatile("s_waitcnt vmcnt(0)" ::: "memory");
        }
    }
    __syncthreads();
}

namespace pg8 {
constexpr int BM = 256, BK = 64, HALF = 128, HTB = HALF * BK * 2, STAGE_BYTES = 8 * HTB, NXCD = 8, WGM = 8;
__device__ __forceinline__ int lds_byte(int r, int c) { const int st = (r >> 4) * 2 + (c >> 5), rr = r & 15, cc = c & 31, ob = rr * 64 + cc * 2; return st * 1024 + (ob ^ (((ob >> 9) & 1) << 5)); }
__device__ __forceinline__ void stage_rc(int b, int& R, int& C) { const int st = b / 1024, sb = b % 1024, swz = sb ^ (((sb >> 9) & 1) << 5); R = (st >> 1) * 16 + swz / 64; C = (st & 1) * 32 + (swz % 64) / 2; }
__device__ __forceinline__ int perm32(int rho) { const int n = rho >> 4, i = rho & 15; return 8 * (i >> 2) + 4 * n + (i & 3); }

struct Unit {
    const char* ap;
    const char* bp;
    const int* rowmap;
    int arow0;
    int pm, pn, grp;
};
struct TileOrder {
    int nM, nN, nwg, G, c;
    __device__ __forceinline__ void init(int nM_, int nN_, int G_, int c_) { nM = nM_; nN = nN_; nwg = nM * nN; G = G_; c = c_; }
    __device__ __forceinline__ bool tile(int i, int& pm, int& pn) const {
        const long L = (long)i * G + c; if (L >= nwg) return false;
        int wgid = (int)L; { const int q = nwg / NXCD, r = nwg % NXCD, xcd = wgid % NXCD, off = wgid / NXCD; wgid = (xcd < r ? xcd * (q + 1) : r * (q + 1) + (xcd - r) * q) + off; }
        const int nig = WGM * nN, gid = wgid / nig, fm = gid * WGM, gsz = (nM - fm) < WGM ? (nM - fm) : WGM;
        pm = fm + ((wgid % nig) % gsz); pn = (wgid % nig) / gsz; return true;
    }
};
struct DenseSched {
    TileOrder T; const char* A; const char* Bt; size_t tstepB; int row0;
    __device__ __forceinline__ bool next(int i, Unit& u) const {
        int pm, pn; if (!T.tile(i, pm, pn)) return false;
        u.ap = A; u.bp = Bt + (size_t)pn * tstepB; u.rowmap = nullptr; u.arow0 = row0 + pm * BM; u.pm = pm; u.pn = pn; u.grp = 0; return true;
    }
};
struct MoeSched {
    TileOrder T; const char* A; const char* Bt; size_t tstepB, estride; const int* rowmap; const volatile LAS int* tile_e;
    __device__ __forceinline__ bool next(int i, Unit& u) const {
        int pm, pn; if (!T.tile(i, pm, pn)) return false;
        const int e = __builtin_amdgcn_readfirstlane(tile_e[pm]);
        u.ap = A; u.bp = Bt + (size_t)e * estride + (size_t)pn * tstepB; u.rowmap = rowmap; u.arow0 = pm * BM; u.pm = pm; u.pn = pn; u.grp = e; return true;
    }
};

template <class Epi, class Sched>
__device__ __forceinline__ void gemm_phase(LAS unsigned char* lds, const int K, const Sched& S, const Epi& E) {
    const int tid = threadIdx.x, wid = __builtin_amdgcn_readfirstlane(tid >> 6), lane = tid & 63, wr = wid >> 2, wc = wid & 3, fr = lane & 15, fq = lane >> 4;
    const int nt = K / BK;
    int sR[2]; unsigned sC2[2], voffB[2];
#pragma unroll
    for (int i = 0; i < 2; ++i) { int R, C; stage_rc(tid * 16 + i * 8192, R, C); const int Rb = Epi::PERM ? ((R & ~31) + perm32(R & 31)) : R;
        sR[i] = R; sC2[i] = (unsigned)C * 2u; voffB[i] = (unsigned)(Rb * K + C) * 2u; }
    const size_t kstep = (size_t)(BK * 2);
    const size_t hstepB = (size_t)HALF * K * 2;
    const unsigned rowB = (unsigned)K * 2u;
    const unsigned ldsw = (unsigned)wid * 1024u;
    const int aoff = lds_byte(wr * 64 + fr, fq * 8), boff = lds_byte(wc * 32 + fr, fq * 8);
#define PG8_SA(b, h) (((b) * 2 + (h)) * HTB)
#define PG8_SB(b, h) ((4 + (b) * 2 + (h)) * HTB)
#define PG8_STAGE(bufoff, gbase, voff) do { _Pragma("unroll") for (int _i = 0; _i < 2; ++_i) \
        __builtin_amdgcn_global_load_lds((const unsigned*)((const char*)(gbase) + (voff)[_i]), (LAS unsigned*)(lds + (bufoff) + ldsw + _i * 8192), 16, 0, 0); } while (0)
#define PG8_LDA(dst, b, h) do { _Pragma("unroll") for (int m = 0; m < 4; ++m) _Pragma("unroll") for (int k = 0; k < 2; ++k) dst[m][k] = *(const LAS bf16x8*)(lds + PG8_SA(b, h) + aoff + m * 2048 + k * 1024); } while (0)
#define PG8_LDB(dst, b, h) do { _Pragma("unroll") for (int n = 0; n < 2; ++n) _Pragma("unroll") for (int k = 0; k < 2; ++k) dst[n][k] = *(const LAS bf16x8*)(lds + PG8_SB(b, h) + boff + n * 2048 + k * 1024); } while (0)
#define PG8_MMA(ai, bj, At, Bt) do { __builtin_amdgcn_s_setprio(1); _Pragma("unroll") for (int m = 0; m < 4; ++m) _Pragma("unroll") for (int n = 0; n < 2; ++n) _Pragma("unroll") for (int k = 0; k < 2; ++k) \
        acc[ai][bj][m][n] = __builtin_amdgcn_mfma_f32_16x16x32_bf16(Bt[n][k], At[m][k], acc[ai][bj][m][n], 0, 0, 0); __builtin_amdgcn_s_setprio(0); } while (0)
#define PG8_WAIT_V(n) asm volatile("s_waitcnt vmcnt(" #n ")" ::: "memory")
#define PG8_WAIT_L(n) asm volatile("s_waitcnt lgkmcnt(" #n ")" ::: "memory")
#define PG8_BAR __builtin_amdgcn_s_barrier()
#define PG8_SCHED __builtin_amdgcn_sched_barrier(0)
#define PG8_MKOFF(u, o0, o1) do { _Pragma("unroll") for (int _i = 0; _i < 2; ++_i) { const int _r0 = (u).arow0 + sR[_i], _r1 = _r0 + HALF; \
        const int _g0 = (u).rowmap ? (u).rowmap[_r0] : _r0, _g1 = (u).rowmap ? (u).rowmap[_r1] : _r1; \
        o0[_i] = (unsigned)_g0 * rowB + sC2[_i]; o1[_i] = (unsigned)_g1 * rowB + sC2[_i]; } } while (0)
    Unit cur, nxt; int ui = 0;
    if (!S.next(0, cur)) return;
    f32x4 acc[2][2][4][2];
#pragma unroll
    for (int a = 0; a < 2; ++a)
#pragma unroll
        for (int b = 0; b < 2; ++b)
#pragma unroll
            for (int m = 0; m < 4; ++m)
#pragma unroll
                for (int n = 0; n < 2; ++n) acc[a][b][m][n] = (f32x4){0.f, 0.f, 0.f, 0.f};
    bf16x8 At[4][2], B0[2][2], B1[2][2];
    unsigned oc0[2], oc1[2], on0[2], on1[2];
    PG8_MKOFF(cur, oc0, oc1);
    on0[0] = oc0[0]; on0[1] = oc0[1]; on1[0] = oc1[0]; on1[1] = oc1[1];
    const char* cA = cur.ap; const char* cB = cur.bp;
    PG8_STAGE(PG8_SB(0, 0), cB, voffB); PG8_STAGE(PG8_SB(0, 1), cB + hstepB, voffB); PG8_STAGE(PG8_SA(0, 0), cA, oc0); PG8_STAGE(PG8_SA(0, 1), cA, oc1);
    if (wr == 1) PG8_BAR;
    PG8_WAIT_V(2); PG8_BAR;
    PG8_STAGE(PG8_SB(1, 0), cB + kstep, voffB); PG8_STAGE(PG8_SA(1, 0), cA + kstep, oc0); PG8_STAGE(PG8_SB(1, 1), cB + hstepB + kstep, voffB);
    PG8_WAIT_V(6); PG8_BAR;
    for (;;) {
        const bool has_next = S.next(ui + 1, nxt);
        const char* nA = has_next ? nxt.ap : cA; const char* nB = has_next ? nxt.bp : cB;
        for (int t = 0; t < nt; t += 2) {
            const bool last = (t == nt - 2);
            if (last && has_next) { PG8_MKOFF(nxt, on0, on1); }
            const char* a1 = cA + (size_t)(t + 1) * kstep;
            const char* a2 = last ? nA : cA + (size_t)(t + 2) * kstep; const char* b2 = last ? nB : cB + (size_t)(t + 2) * kstep;
            const char* a3 = a2 + kstep; const char* b3 = b2 + kstep;
            unsigned o20[2], o21[2];
            o20[0] = last ? on0[0] : oc0[0]; o20[1] = last ? on0[1] : oc0[1]; o21[0] = last ? on1[0] : oc1[0]; o21[1] = last ? on1[1] : oc1[1];
            PG8_LDB(B0, 0, 0); PG8_LDB(B1, 0, 1); PG8_SCHED; PG8_LDA(At, 0, 0); PG8_STAGE(PG8_SA(1, 1), a1, oc1);
            PG8_WAIT_V(8); PG8_WAIT_L(0); PG8_BAR; PG8_MMA(0, 0, At, B0); PG8_MMA(0, 1, At, B1); PG8_BAR; PG8_SCHED;
            PG8_LDA(At, 0, 1); PG8_STAGE(PG8_SB(0, 0), b2, voffB); PG8_STAGE(PG8_SB(0, 1), b2 + hstepB, voffB); PG8_STAGE(PG8_SA(0, 0), a2, o20);
            PG8_WAIT_V(8); PG8_WAIT_L(0); PG8_BAR; PG8_MMA(1, 0, At, B0); PG8_MMA(1, 1, At, B1); PG8_BAR; PG8_SCHED;
            PG8_LDB(B0, 1, 0); PG8_LDB(B1, 1, 1); PG8_SCHED; PG8_LDA(At, 1, 0); PG8_STAGE(PG8_SA(0, 1), a2, o21);
            PG8_WAIT_V(8); PG8_WAIT_L(0); PG8_BAR; PG8_MMA(0, 0, At, B0); PG8_MMA(0, 1, At, B1); PG8_BAR; PG8_SCHED;
            PG8_LDA(At, 1, 1); PG8_STAGE(PG8_SB(1, 0), b3, voffB); PG8_STAGE(PG8_SB(1, 1), b3 + hstepB, voffB); PG8_STAGE(PG8_SA(1, 0), a3, o20);
            PG8_WAIT_V(8); PG8_WAIT_L(0); PG8_BAR; PG8_MMA(1, 0, At, B0); PG8_MMA(1, 1, At, B1); PG8_BAR; PG8_SCHED;
        }
        if (wr == 0) PG8_BAR;
        E(acc, cur, wr, wc, fr, fq);
        if (!has_next) break;
#pragma unroll
        for (int a = 0; a < 2; ++a)
#pragma unroll
            for (int b = 0; b < 2; ++b)
#pragma unroll
                for (int m = 0; m < 4; ++m)
#pragma unroll
                    for (int n = 0; n < 2; ++n) acc[a][b][m][n] = (f32x4){0.f, 0.f, 0.f, 0.f};
        cur = nxt; cA = nA; cB = nB; ++ui;
        oc0[0] = on0[0]; oc0[1] = on0[1]; oc1[0] = on1[0]; oc1[1] = on1[1];
        if (wr == 1) PG8_BAR;
    }
    PG8_WAIT_V(0);
    PG8_BAR;
#undef PG8_SA
#undef PG8_SB
#undef PG8_STAGE
#undef PG8_LDA
#undef PG8_LDB
#undef PG8_MMA
#undef PG8_WAIT_V
#undef PG8_WAIT_L
#undef PG8_BAR
#undef PG8_SCHED
#undef PG8_MKOFF
}
}

struct Params { const float* in[36]; float* out; unsigned char* ws; int ph_lo, ph_hi; };
enum { I_X = 0, I_C, I_CTX, I_CCTX, I_ADAW, I_ADAB, I_NMIXG, I_NFFNG, I_ABWIN, I_ABWOUT, I_CONVW, I_CONVB, I_LWA, I_LBA, I_LWI, I_LBI, I_LAM,
       I_QNG, I_WUQ, I_KVNG, I_WUKV, I_QHG, I_KHG, I_NAWQKV, I_NAWOUT, I_NAQHG, I_NAKHG, I_RPB, I_RW, I_RB, I_MWG, I_MWU, I_MWD, I_MSG, I_MSU, I_MSD };

using pg8::Unit;
struct EpiU {
    static constexpr bool PERM = true;
    bf16* U;
    __device__ __forceinline__ void operator()(const f32x4 (&acc)[2][2][4][2], const Unit& u, int wr, int wc, int fr, int fq) const {
        const int row0 = u.pm * 256 + wr * 64 + fr, col0 = u.pn * 256 + wc * 32 + 8 * fq;
        const bool gel = (u.pn >= 4 && u.pn < 8);
#pragma unroll
        for (int ai = 0; ai < 2; ++ai)
#pragma unroll
            for (int m = 0; m < 4; ++m) { bf16* rowp = U + (size_t)(row0 + ai * 128 + m * 16) * ABIN + col0;
#pragma unroll
                for (int bj = 0; bj < 2; ++bj) { if (col0 + bj * 128 >= ABIN) continue;
                    f32x4 v0 = acc[ai][bj][m][0], v1 = acc[ai][bj][m][1];
                    if (gel) {
#pragma unroll
                        for (int j = 0; j < 4; ++j) { v0[j] = gelu_tanh(v0[j]); v1[j] = gelu_tanh(v1[j]); } }
                    u32x4 w; w.x = cvt_pk_bf16(v0[0], v0[1]); w.y = cvt_pk_bf16(v0[2], v0[3]); w.z = cvt_pk_bf16(v1[0], v1[1]); w.w = cvt_pk_bf16(v1[2], v1[3]);
                    *(u32x4*)(rowp + bj * 128) = w; } }
    }
};
struct EpiBf {
    static constexpr bool PERM = true;
    bf16* O; int ldc;
    __device__ __forceinline__ void operator()(const f32x4 (&acc)[2][2][4][2], const Unit& u, int wr, int wc, int fr, int fq) const {
        const int row0 = u.pm * 256 + wr * 64 + fr, col0 = u.pn * 256 + wc * 32 + 8 * fq;
#pragma unroll
        for (int ai = 0; ai < 2; ++ai)
#pragma unroll
            for (int m = 0; m < 4; ++m) { bf16* rowp = O + (size_t)(row0 + ai * 128 + m * 16) * ldc + col0;
#pragma unroll
                for (int bj = 0; bj < 2; ++bj) { const f32x4 v0 = acc[ai][bj][m][0], v1 = acc[ai][bj][m][1];
                    u32x4 w; w.x = cvt_pk_bf16(v0[0], v0[1]); w.y = cvt_pk_bf16(v0[2], v0[3]); w.z = cvt_pk_bf16(v1[0], v1[1]); w.w = cvt_pk_bf16(v1[2], v1[3]);
                    *(u32x4*)(rowp + bj * 128) = w; } }
    }
};
struct EpiRes {
    static constexpr bool PERM = false;
    const float* xin_ctx; const float* xin_lat;
    float* xout; const float* gate; int row0;
    __device__ __forceinline__ void operator()(const f32x4 (&acc)[2][2][4][2], const Unit& u, int wr, int wc, int fr, int fq) const {
        const int r0 = row0 + u.pm * 256 + wr * 64 + fr, col0 = u.pn * 256 + wc * 32 + 4 * fq;
        const int v = vec_of_row(row0 + u.pm * 256);
        f32x4 g[2][2];
#pragma unroll
        for (int bj = 0; bj < 2; ++bj)
#pragma unroll
            for (int n = 0; n < 2; ++n) g[bj][n] = *(const f32x4*)(gate + (size_t)v * 12288 + col0 + bj * 128 + n * 16);
#pragma unroll
        for (int ai = 0; ai < 2; ++ai)
#pragma unroll
            for (int m = 0; m < 4; ++m) { const int row = r0 + ai * 128 + m * 16;
                const float* xi = (row < NCTX ? xin_ctx + (size_t)row * DM : xin_lat + (size_t)(row - NCTX) * DM) + col0; float* xo = xout + (size_t)row * DM + col0;
#pragma unroll
                for (int bj = 0; bj < 2; ++bj)
#pragma unroll
                    for (int n = 0; n < 2; ++n) { const f32x4 xv = *(const f32x4*)(xi + bj * 128 + n * 16); *(f32x4*)(xo + bj * 128 + n * 16) = xv + g[bj][n] * acc[ai][bj][m][n]; } }
    }
};
struct EpiSwiglu {
    static constexpr bool PERM = true;
    bf16* ACT;
    __device__ __forceinline__ void operator()(const f32x4 (&acc)[2][2][4][2], const Unit& u, int wr, int wc, int fr, int fq) const {
        const int row0 = u.pm * 256 + wr * 64 + fr, col0 = u.pn * 128 + wc * 32 + 8 * fq;
#pragma unroll
        for (int ai = 0; ai < 2; ++ai)
#pragma unroll
            for (int m = 0; m < 4; ++m) { bf16* rowp = ACT + (size_t)(row0 + ai * 128 + m * 16) * DE + col0;
                float o[8];
#pragma unroll
                for (int n = 0; n < 2; ++n)
#pragma unroll
                    for (int j = 0; j < 4; ++j) { const float gv = acc[ai][0][m][n][j], uv = acc[ai][1][m][n][j]; o[n * 4 + j] = gv / (1.0f + __expf(-gv)) * uv; }
                u32x4 w; w.x = cvt_pk_bf16(o[0], o[1]); w.y = cvt_pk_bf16(o[2], o[3]); w.z = cvt_pk_bf16(o[4], o[5]); w.w = cvt_pk_bf16(o[6], o[7]);
                *(u32x4*)rowp = w; }
    }
};

struct Frame {
    LAS unsigned char* lds; volatile LAS unsigned* MISC; unsigned* ctl; unsigned char* ws;
    int tid, lane, wave, vcu, G;
};

__device__ __forceinline__ void xpose_item(const float* W, int ldw, bf16* WT, int ldt, int k0, int n0, int drow0, LAS float* scr, int lane) {
#pragma unroll 8
    for (int i = 0; i < 32; ++i) { const int kk = 2 * i + (lane >> 5); scr[kk * 33 + (lane & 31)] = W[(size_t)(k0 + kk) * ldw + n0 + (lane & 31)]; }
    LDS_WAIT(); asm volatile("" ::: "memory");
    const int c = lane & 7;
#pragma unroll
    for (int j = 0; j < 4; ++j) { const int n = (lane >> 3) + 8 * j; const LAS float* s = scr + (8 * c) * 33 + n;
        u32x4 o; o.x = pk2(s[0 * 33], s[1 * 33]); o.y = pk2(s[2 * 33], s[3 * 33]); o.z = pk2(s[4 * 33], s[5 * 33]); o.w = pk2(s[6 * 33], s[7 * 33]);
        *(u32x4*)(WT + (size_t)(drow0 + n) * ldt + k0 + 8 * c) = o; }
    LDS_WAIT(); asm volatile("" ::: "memory");
}
__device__ __forceinline__ void xpose_job(const float* W, int K, int N, bf16* WT, int r, LAS float* scr, int lane) {
    const int nblk = N / 32, kb = r / nblk, nb = r % nblk;
    xpose_item(W, N, WT, K, 64 * kb, 32 * nb, 32 * nb, scr, lane);
}
__device__ __forceinline__ void p0_prologue(Frame& F, const Params& p) {
    unsigned char* ws = F.ws;
    LAS float* sil = (LAS float*)(F.lds + 69632);
    for (int i = F.tid; i < 5 * DM; i += NTHR) { const int v = i / DM, k = i % DM; const float x = v < 4 ? p.in[I_C][v * DM + k] : p.in[I_CCTX][k]; sil[i] = x / (1.0f + __expf(-x)); }
    { const int gt = blockIdx.x * NTHR + F.tid;
      if (gt < 1024) { const int pos = gt >> 4, i = gt & 15; const float inv = powf(10000.0f, -(float)(2 * i) / 32.0f); const float ang = (float)pos * inv;
          ((f32x2*)(ws + WS_ROPE))[gt] = (f32x2){cosf(ang), sinf(ang)}; } }
    { u32x4* z = (u32x4*)(ws + WS_WIN + (size_t)ABIN * DM * 2); const int n16 = (ABINP - ABIN) * DM * 2 / 16;
      for (int i = blockIdx.x * NTHR + F.tid; i < n16; i += F.G * NTHR) z[i] = (u32x4){0u, 0u, 0u, 0u}; }
    __syncthreads();
    if (F.wave < 3) {
        for (int item = blockIdx.x * 3 + F.wave; item < 768; item += F.G * 3) {
            const int l = item / 384, rem = item % 384, cg = rem >> 3, kc = rem & 7;
            const float* wp = p.in[I_ADAW] + ((size_t)l * DM + kc * 256) * 12288 + cg * 256 + F.lane * 4;
            f32x4 a0 = {0.f, 0.f, 0.f, 0.f}, a1 = a0, a2 = a0, a3 = a0, a4 = a0;
#pragma unroll 8
            for (int kk = 0; kk < 256; ++kk) { const f32x4 w = *(const f32x4*)(wp + (size_t)kk * 12288); const int k = kc * 256 + kk;
                a0 += w * sil[k]; a1 += w * sil[DM + k]; a2 += w * sil[2 * DM + k]; a3 += w * sil[3 * DM + k]; a4 += w * sil[4 * DM + k]; }
            float* o = (float*)(ws + WS_MODP) + ((size_t)(kc * 2 + l) * 5) * 12288 + cg * 256 + F.lane * 4;
            *(f32x4*)(o) = a0; *(f32x4*)(o + 12288) = a1; *(f32x4*)(o + 2 * 12288) = a2; *(f32x4*)(o + 3 * 12288) = a3; *(f32x4*)(o + 4 * 12288) = a4;
        }
    }
    LAS float* scr = (LAS float*)(F.lds + F.wave * 8448);
    const int gw = F.vcu * NWAVES + F.wave, NGW = F.G * NWAVES;
    constexpr int I_WIN = (DM / 64) * (ABIN / 32), I_WO = (DM / 64) * (DM / 32), I_UQ = (512 / 64) * (1536 / 32), I_UKV = (512 / 64) * (2048 / 32);
    constexpr int I_G1 = 8, I_GALL = 32 * I_G1, I_QKV = (DM / 64) * (6144 / 32), I_MOE1 = 1408;
    constexpr int NITEMS = I_WIN + I_WO + I_UQ + I_UKV + I_GALL + I_QKV + I_WO + 102 * I_MOE1;
    for (int it = gw; it < NITEMS; it += NGW) {
        int r = it;
        if (r < I_WIN) { xpose_job(p.in[I_ABWIN], DM, ABIN, (bf16*)(ws + WS_WIN), r, scr, F.lane); continue; } r -= I_WIN;
        if (r < I_WO) { xpose_job(p.in[I_ABWOUT], DM, DM, (bf16*)(ws + WS_WOUT0), r, scr, F.lane); continue; } r -= I_WO;
        if (r < I_UQ) { xpose_job(p.in[I_WUQ], 512, 1536, (bf16*)(ws + WS_WUQ), r, scr, F.lane); continue; } r -= I_UQ;
        if (r < I_UKV) { xpose_job(p.in[I_WUKV], 512, 2048, (bf16*)(ws + WS_WUKV), r, scr, F.lane); continue; } r -= I_UKV;
        if (r < I_GALL) { const int mi = r / I_G1, rr = r % I_G1;
            const int g = mi >> 3, blk = mi & 7, dir = g >> 1, ty = g & 1;
            const float* src = (ty ? p.in[I_LWI] : p.in[I_LWA]) + (size_t)(dir * 8 + blk) * 128 * 128;
            xpose_job(src, 128, 128, (bf16*)(ws + WS_WG) + (size_t)mi * 128 * 128, rr, scr, F.lane); continue; } r -= I_GALL;
        if (r < I_QKV) { xpose_job(p.in[I_NAWQKV], DM, 6144, (bf16*)(ws + WS_WQKV), r, scr, F.lane); continue; } r -= I_QKV;
        if (r < I_WO) { xpose_job(p.in[I_NAWOUT], DM, DM, (bf16*)(ws + WS_WOUT1), r, scr, F.lane); continue; } r -= I_WO;
        { const int m = r / I_MOE1, rr = r % I_MOE1, l = m / 51, mm = m % 51, which = mm / 17, e = mm % 17;
          if (which < 2) {
              const float* src = which == 0 ? (e < 16 ? p.in[I_MWG] + (size_t)(l * 16 + e) * DM * DE : p.in[I_MSG] + (size_t)l * DM * DE)
                                            : (e < 16 ? p.in[I_MWU] + (size_t)(l * 16 + e) * DM * DE : p.in[I_MSU] + (size_t)l * DM * DE);
              const int kb = rr / 44, nb = rr % 44, n0 = 32 * nb;
              xpose_item(src, DE, (bf16*)(ws + WS_W1 + (size_t)(l * 17 + e) * W1_E), DM, 64 * kb, n0, (n0 / 128) * 256 + (n0 % 128) + (which ? 128 : 0), scr, F.lane);
          } else {
              const float* src = e < 16 ? p.in[I_MWD] + (size_t)(l * 16 + e) * DE * DM : p.in[I_MSD] + (size_t)l * DE * DM;
              const int kb = rr / 64, nb = rr % 64;
              xpose_item(src, DM, (bf16*)(ws + WS_W2 + (size_t)(l * 17 + e) * W2_E), DE, 64 * kb, 32 * nb, 32 * nb, scr, F.lane);
          } }
    }
}

__device__ __forceinline__ void load_row_f32(const float* xrow, int lane, f32x4 (&v)[8]) {
#pragma unroll
    for (int j = 0; j < 8; ++j) v[j] = *(const f32x4*)(xrow + 4 * lane + 256 * j);
}
__device__ __forceinline__ float row_rstd(const f32x4 (&v)[8]) {
    float s = 0.f;
#pragma unroll
    for (int j = 0; j < 8; ++j) s += (v[j].x * v[j].x + v[j].y * v[j].y) + (v[j].z * v[j].z + v[j].w * v[j].w);
    return rsqrtf(wave_sum(s) * (1.0f / DM) + EPS);
}
__device__ __forceinline__ void store_row_bf16(bf16* orow, int lane, const f32x4 (&h)[8]) {
#pragma unroll
    for (int j = 0; j < 8; ++j) { u32x2 w; w.x = pk2(h[j].x, h[j].y); w.y = pk2(h[j].z, h[j].w); *(u32x2*)(orow + 4 * lane + 256 * j) = w; }
}
__device__ __forceinline__ void p1_modulate0(Frame& F, const Params& p) {
    unsigned char* ws = F.ws;
    const float* modp = (const float*)(ws + WS_MODP);
    { float* mod = (float*)(ws + WS_MOD);
      for (int i = blockIdx.x * NTHR + F.tid; i < 2 * 5 * 12288; i += F.G * NTHR) { const int l = i / (5 * 12288), n = i % 12288; float s = p.in[I_ADAB][l * 12288 + n];
#pragma unroll
          for (int kc = 0; kc < 8; ++kc) s += modp[(size_t)kc * (2 * 5 * 12288) + i];
          mod[i] = s; } }
    LAS float* gs = (LAS float*)F.lds; LAS float* sh = gs + DM;
    for (int g = blockIdx.x; g < NTOK / 64; g += F.G) {
        const int row0 = 64 * g, v = vec_of_row(row0);
        for (int n = F.tid; n < DM; n += NTHR) { float sc = p.in[I_ADAB][DM + n], sf = p.in[I_ADAB][n];
#pragma unroll
            for (int kc = 0; kc < 8; ++kc) { const float* mp = modp + ((size_t)(kc * 2 + 0) * 5 + v) * 12288; sf += mp[n]; sc += mp[DM + n]; }
            gs[n] = p.in[I_NMIXG][n] * (1.0f + sc); sh[n] = sf; }
        __syncthreads();
        for (int i = 0; i < 8; ++i) { const int row = row0 + F.wave + 8 * i;
            const float* xr = row < NCTX ? p.in[I_CTX] + (size_t)row * DM : p.in[I_X] + (size_t)(row - NCTX) * DM;
            f32x4 x[8]; load_row_f32(xr, F.lane, x); const float rstd = row_rstd(x);
#pragma unroll
            for (int j = 0; j < 8; ++j) { const f32x4 gg = *(const LAS f32x4*)(gs + 4 * F.lane + 256 * j), ss = *(const LAS f32x4*)(sh + 4 * F.lane + 256 * j); x[j] = x[j] * rstd * gg + ss; }
            store_row_bf16((bf16*)(ws + WS_H) + (size_t)row * DM, F.lane, x); }
        __syncthreads();
    }
}

__device__ __forceinline__ void p3_rank_norms(Frame& F, const Params& p) {
    const bf16* U = (const bf16*)(F.ws + WS_U); bf16* CQN = (bf16*)(F.ws + WS_CQN); bf16* CKVN = (bf16*)(F.ws + WS_CKVN);
    const int gw = blockIdx.x * NWAVES + F.wave, NGW = F.G * NWAVES;
    for (int row = gw; row < NTOK; row += NGW) {
#pragma unroll
        for (int w = 0; w < 2; ++w) {
            const u32x4 v = *(const u32x4*)(U + (size_t)row * ABIN + 2048 + 512 * w + 8 * F.lane);
            float x[8] = {bflo(v.x), bfhi(v.x), bflo(v.y), bfhi(v.y), bflo(v.z), bfhi(v.z), bflo(v.w), bfhi(v.w)};
            float s = 0.f;
#pragma unroll
            for (int j = 0; j < 8; ++j) s += x[j] * x[j];
            const float rstd = rsqrtf(wave_sum(s) * (1.0f / 512.0f) + EPS);
            const float* g = (w ? p.in[I_KVNG] : p.in[I_QNG]) + 8 * F.lane;
            const f32x4 g0 = *(const f32x4*)g, g1 = *(const f32x4*)(g + 4);
            u32x4 o; o.x = pk2(x[0] * rstd * g0.x, x[1] * rstd * g0.y); o.y = pk2(x[2] * rstd * g0.z, x[3] * rstd * g0.w);
            o.z = pk2(x[4] * rstd * g1.x, x[5] * rstd * g1.y); o.w = pk2(x[6] * rstd * g1.z, x[7] * rstd * g1.w);
            *(u32x4*)((w ? CKVN : CQN) + (size_t)row * 512 + 8 * F.lane) = o;
        }
    }
}
__device__ __forceinline__ void p3_conv_gates(Frame& F, const Params& p) {
    const bf16* U = (const bf16*)(F.ws + WS_U);
    float* AB = (float*)(F.ws + WS_AB);
    const bf16* WG = (const bf16*)(F.ws + WS_WG);
    LAS float* xcf = (LAS float*)F.lds;
    LAS unsigned char* xab = F.lds + 64 * 129 * 4;
    const int tid = F.tid, lane = F.lane, w = F.wave;
    for (int item = blockIdx.x; item < (NTOK / 64) * 8; item += F.G) {
        const int tt = item >> 3, n = item & 7;
        int row0, pos0, slen;
        if (tt < 16) { const int b = tt >> 2; pos0 = 64 * (tt & 3); slen = CTXL; row0 = b * CTXL + pos0; }
        else { const int tl = tt - 16, b = tl >> 6; pos0 = 64 * (tl & 63); slen = SEQ; row0 = NCTX + b * SEQ + pos0; }
        { const int i = tid >> 3, cg = tid & 7, ch0 = 128 * n + 16 * cg;
          float accv[16];
#pragma unroll
          for (int c = 0; c < 16; ++c) accv[c] = p.in[I_CONVB][ch0 + c];
#pragma unroll
          for (int j = 0; j < 4; ++j) { const int pos = pos0 + i + j - 2;
              if (pos >= 0 && pos < slen) {
                  const bf16* up = U + (size_t)(row0 + i + j - 2) * ABIN + ch0;
                  const u32x4 v0 = *(const u32x4*)up, v1 = *(const u32x4*)(up + 8);
                  const float x[16] = {bflo(v0.x), bfhi(v0.x), bflo(v0.y), bfhi(v0.y), bflo(v0.z), bfhi(v0.z), bflo(v0.w), bfhi(v0.w),
                                       bflo(v1.x), bfhi(v1.x), bflo(v1.y), bfhi(v1.y), bflo(v1.z), bfhi(v1.z), bflo(v1.w), bfhi(v1.w)};
                  const float* cw = p.in[I_CONVW] + j * DRNN + ch0;
#pragma unroll
                  for (int c = 0; c < 16; ++c) accv[c] += cw[c] * x[c]; } }
#pragma unroll
          for (int c = 0; c < 16; ++c) xcf[i * 129 + 16 * cg + c] = accv[c];
          u32x4 o0, o1; o0.x = pk2(accv[0], accv[1]); o0.y = pk2(accv[2], accv[3]); o0.z = pk2(accv[4], accv[5]); o0.w = pk2(accv[6], accv[7]);
          o1.x = pk2(accv[8], accv[9]); o1.y = pk2(accv[10], accv[11]); o1.z = pk2(accv[12], accv[13]); o1.w = pk2(accv[14], accv[15]);
          *(LAS u32x4*)(xab + i * 272 + 32 * cg) = o0; *(LAS u32x4*)(xab + i * 272 + 32 * cg + 16) = o1; }
        __syncthreads();
        bf16x8 af[4][4];
#pragma unroll
        for (int m = 0; m < 4; ++m)
#pragma unroll
            for (int ks = 0; ks < 4; ++ks) af[m][ks] = *(const LAS bf16x8*)(xab + (16 * m + (lane & 15)) * 272 + (32 * ks + 8 * (lane >> 4)) * 2);
        const int chl = 16 * w + (lane & 15), gch = 128 * n + chl;
#pragma unroll
        for (int d = 0; d < 2; ++d) {
            f32x4 ca[4], ci[4];
#pragma unroll
            for (int m = 0; m < 4; ++m) { ca[m] = (f32x4){0.f, 0.f, 0.f, 0.f}; ci[m] = ca[m]; }
#pragma unroll
            for (int ks = 0; ks < 4; ++ks) {
                const bf16x8 ba = *(const bf16x8*)(WG + ((size_t)((2 * d + 0) * 8 + n) * 128 + chl) * 128 + 32 * ks + 8 * (lane >> 4));
                const bf16x8 bi = *(const bf16x8*)(WG + ((size_t)((2 * d + 1) * 8 + n) * 128 + chl) * 128 + 32 * ks + 8 * (lane >> 4));
#pragma unroll
                for (int m = 0; m < 4; ++m) { ca[m] = __builtin_amdgcn_mfma_f32_16x16x32_bf16(af[m][ks], ba, ca[m], 0, 0, 0); ci[m] = __builtin_amdgcn_mfma_f32_16x16x32_bf16(af[m][ks], bi, ci[m], 0, 0, 0); }
            }
            const float ba_ = p.in[I_LBA][d * DRNN + gch], bi_ = p.in[I_LBI][d * DRNN + gch], lam = p.in[I_LAM][d * DRNN + gch];
            const float sp = log1pf(expf(-lam));
            float* Ao = AB + (size_t)(2 * d) * NTOK * DRNN; float* Bo = AB + (size_t)(2 * d + 1) * NTOK * DRNN;
#pragma unroll
            for (int m = 0; m < 4; ++m)
#pragma unroll
                for (int r = 0; r < 4; ++r) { const int i = 16 * m + 4 * (lane >> 4) + r;
                    const float rg = 1.0f / (1.0f + expf(-(ca[m][r] + ba_))), ig = 1.0f / (1.0f + expf(-(ci[m][r] + bi_)));
                    const float la = -8.0f * rg * sp; const float a = expf(la); const float bb = sqrtf(-expm1f(2.0f * la)) * ig * xcf[i * 129 + chl];
                    Ao[(size_t)(row0 + i) * DRNN + gch] = a; Bo[(size_t)(row0 + i) * DRNN + gch] = bb; }
        }
        __syncthreads();
    }
}
__device__ __forceinline__ int scan_row(int dir, int b, int c, int i) {
    if (dir == 0) return c < 4 ? b * CTXL + 64 * c + i : NCTX + b * SEQ + 64 * (c - 4) + i;
    return c < 4 ? b * CTXL + 255 - 64 * c - i : NCTX + b * SEQ + 4095 - 64 * (c - 4) - i;
}
__device__ __forceinline__ void scan_pass_b(Frame& F) {
    const float* AB = (const float*)(F.ws + WS_AB); f32x2* AGG = (f32x2*)(F.ws + WS_AGG);
    for (int item = blockIdx.x; item < 2 * NB * NCHUNK * 2; item += F.G) {
        const int half = item & 1, rest = item >> 1, c = rest % NCHUNK, db = rest / NCHUNK, b = db & 3, dir = db >> 2;
        const int ch = half * 512 + F.tid;
        const float* Ap = AB + (size_t)(2 * dir) * NTOK * DRNN + ch; const float* Bp = AB + (size_t)(2 * dir + 1) * NTOK * DRNN + ch;
        float A = 1.0f, Hc = 0.0f;
#pragma unroll 8
        for (int i = 0; i < 64; ++i) { const size_t r = (size_t)scan_row(dir, b, c, i) * DRNN; const float a = Ap[r], bb = Bp[r]; Hc = a * Hc + bb; A *= a; }
        AGG[((size_t)(dir * NB + b) * NCHUNK + c) * DRNN + ch] = (f32x2){A, Hc};
    }
}
__device__ __forceinline__ void scan_pass_c(Frame& F) {
    const f32x2* AGG = (const f32x2*)(F.ws + WS_AGG); float* CAR = (float*)(F.ws + WS_CARRY);
    for (int t = blockIdx.x * NTHR + F.tid; t < 2 * NB * DRNN; t += F.G * NTHR) {
        const int ch = t % DRNN, db = t / DRNN;
        float carry = 0.0f;
        for (int c = 0; c < NCHUNK; ++c) { const size_t idx = ((size_t)db * NCHUNK + c) * DRNN + ch; CAR[idx] = carry; const f32x2 ag = AGG[idx]; carry = ag.x * carry + ag.y; }
    }
}
__device__ __forceinline__ void scan_pass_d(Frame& F) {
    const float* AB = (const float*)(F.ws + WS_AB); const float* CAR = (const float*)(F.ws + WS_CARRY);
    const bf16* U = (const bf16*)(F.ws + WS_U); bf16* YC = (bf16*)(F.ws + WS_YC);
    LAS float* hf = (LAS float*)F.lds;
    for (int item = blockIdx.x; item < NB * NCHUNK * 2; item += F.G) {
        const int half = item & 1, rest = item >> 1, pc = rest % NCHUNK, b = rest / NCHUNK;
        const int ch = half * 512 + F.tid;
        const int cb = pc < 4 ? 3 - pc : 71 - pc;
        { const float* Ap = AB + ch; const float* Bp = AB + (size_t)NTOK * DRNN + ch;
          float h = CAR[((size_t)(0 * NB + b) * NCHUNK + pc) * DRNN + ch];
#pragma unroll 8
          for (int i = 0; i < 64; ++i) { const size_t r = (size_t)scan_row(0, b, pc, i) * DRNN; h = Ap[r] * h + Bp[r]; hf[i * 512 + F.tid] = h; } }
        { const float* Ap = AB + (size_t)2 * NTOK * DRNN + ch; const float* Bp = AB + (size_t)3 * NTOK * DRNN + ch;
          float h = CAR[((size_t)(1 * NB + b) * NCHUNK + cb) * DRNN + ch];
#pragma unroll 8
          for (int i = 0; i < 64; ++i) { const int row = scan_row(1, b, cb, i); const size_t r = (size_t)row * DRNN; h = Ap[r] * h + Bp[r];
              const float gate = bf2f(U[(size_t)row * ABIN + DRNN + ch]);
              YC[(size_t)row * DM + ch] = (bf16)f2bf((hf[(63 - i) * 512 + F.tid] + h) * gate); } }
    }
}

__device__ __forceinline__ void p5_mla_finalize(Frame& F, const Params& p) {
    const bf16* QRAW = (const bf16*)(F.ws + WS_QRAW); const bf16* KVRAW = (const bf16*)(F.ws + WS_KVRAW); const bf16* U = (const bf16*)(F.ws + WS_U);
    bf16* QF = (bf16*)(F.ws + WS_QF); bf16* KF = (bf16*)(F.ws + WS_KF);
    const f32x2* rope = (const f32x2*)(F.ws + WS_ROPE);
    const int lane = F.lane;
    const float gq0 = p.in[I_QHG][lane], gq1 = p.in[I_QHG][64 + lane], gq2 = p.in[I_QHG][128 + lane];
    const float gk0 = p.in[I_KHG][lane], gk1 = p.in[I_KHG][64 + lane], gk2 = p.in[I_KHG][128 + lane];
    const float qs = 0.07216878364870322f * LOG2E;
    const int gw = blockIdx.x * NWAVES + F.wave, NGW = F.G * NWAVES;
    for (int row = gw; row < NTOK; row += NGW) {
        const bool lat = row >= NCTX;
        float cs = 1.0f, sn = 0.0f;
        if (lat) { const int t = (row - NCTX) % SEQ; const int pos = (lane < 32) ? (t / GW) : (t % GW); const f32x2 r = rope[pos * 16 + (lane & 15)]; cs = r.x; sn = r.y; }
        const float kr = bf2f(U[(size_t)row * ABIN + 3072 + lane]);
        const float kr2 = kr * kr;
#pragma unroll
        for (int h = 0; h < MH; ++h) {
            { const bf16* q = QRAW + (size_t)row * 1536 + h * MQK;
              const float v0 = bf2f(q[lane]), v1 = bf2f(q[64 + lane]), v2 = bf2f(q[128 + lane]);
              const float rstd = rsqrtf(wave_sum(v0 * v0 + v1 * v1 + v2 * v2) * (1.0f / MQK) + EPS);
              const float o0 = v0 * rstd * gq0, o1 = v1 * rstd * gq1; float o2 = v2 * rstd * gq2;
              const float pr = __shfl_xor(o2, 16);
              if (lat) o2 = (lane & 16) ? (pr * sn + o2 * cs) : (o2 * cs - pr * sn);
              bf16* qo = QF + ((size_t)row * MH + h) * MQK;
              qo[lane] = (bf16)f2bf(o0 * qs); qo[64 + lane] = (bf16)f2bf(o1 * qs); qo[128 + lane] = (bf16)f2bf(o2 * qs); }
            { const bf16* k = KVRAW + (size_t)row * 2048 + h * 256;
              const float v0 = bf2f(k[lane]), v1 = bf2f(k[64 + lane]);
              const float rstd = rsqrtf(wave_sum(v0 * v0 + v1 * v1 + kr2) * (1.0f / MQK) + EPS);
              const float o0 = v0 * rstd * gk0, o1 = v1 * rstd * gk1; float o2 = kr * rstd * gk2;
              const float pr = __shfl_xor(o2, 16);
              if (lat) o2 = (lane & 16) ? (pr * sn + o2 * cs) : (o2 * cs - pr * sn);
              bf16* ko = KF + ((size_t)row * MH + h) * MQK;
              ko[lane] = (bf16)f2bf(o0); ko[64 + lane] = (bf16)f2bf(o1); ko[128 + lane] = (bf16)f2bf(o2); }
        }
    }
}

__device__ __forceinline__ int crow(int r, int hi) { return (r & 3) + 8 * (r >> 2) + 4 * hi; }
__device__ __forceinline__ int v_st(int k, int c) { const int kk = (k & ~0xC) | ((k & 4) << 1) | ((k & 8) >> 1); return ((kk >> 3) * 4 + (c >> 5)) * 512 + ((kk & 7) * 32 + (c & 31)) * 2; }
__device__ __forceinline__ int v_rd_base(int lane) { return ((lane & 3) << 3) | (((lane >> 2) & 3) << 6) | (((lane >> 4) & 1) << 5) | (((lane >> 5) & 1) << 8); }
constexpr int v_rd_off(int d0, int ks, int half) { return d0 * 512 + ks * 4096 + half * 2048; }
template <int OFF> __device__ __forceinline__ s16x4 tr_read(int vb) {
    s16x4 r; asm volatile("ds_read_b64_tr_b16 %0, %1 offset:%2" : "=&v"(r) : "v"(vb), "i"(OFF) : "memory"); return r;
}
template <int D0> __device__ __forceinline__ void pv_one(f32x16& od, int vb, bf16x8 pa0, bf16x8 pa1, bf16x8 pa2, bf16x8 pa3) {
    const s16x4 l0 = tr_read<v_rd_off(D0, 0, 0)>(vb), h0 = tr_read<v_rd_off(D0, 0, 1)>(vb), l1 = tr_read<v_rd_off(D0, 1, 0)>(vb), h1 = tr_read<v_rd_off(D0, 1, 1)>(vb);
    const s16x4 l2 = tr_read<v_rd_off(D0, 2, 0)>(vb), h2 = tr_read<v_rd_off(D0, 2, 1)>(vb), l3 = tr_read<v_rd_off(D0, 3, 0)>(vb), h3 = tr_read<v_rd_off(D0, 3, 1)>(vb);
    asm volatile("s_waitcnt lgkmcnt(0)" ::: "memory"); __builtin_amdgcn_sched_barrier(0);
#define PKV(L, H) (bf16x8){L[0], L[1], L[2], L[3], H[0], H[1], H[2], H[3]}
    od = __builtin_amdgcn_mfma_f32_32x32x16_bf16(pa0, PKV(l0, h0), od, 0, 0, 0);
    od = __builtin_amdgcn_mfma_f32_32x32x16_bf16(pa1, PKV(l1, h1), od, 0, 0, 0);
    od = __builtin_amdgcn_mfma_f32_32x32x16_bf16(pa2, PKV(l2, h2), od, 0, 0, 0);
    od = __builtin_amdgcn_mfma_f32_32x32x16_bf16(pa3, PKV(l3, h3), od, 0, 0, 0);
#undef PKV
}
__device__ __forceinline__ void pv_d0(f32x16* o, int vb, bf16x8 pa0, bf16x8 pa1, bf16x8 pa2, bf16x8 pa3) {
    pv_one<0>(o[0], vb, pa0, pa1, pa2, pa3); pv_one<1>(o[1], vb, pa0, pa1, pa2, pa3); pv_one<2>(o[2], vb, pa0, pa1, pa2, pa3); pv_one<3>(o[3], vb, pa0, pa1, pa2, pa3);
}
__device__ __forceinline__ void pack_p(const f32x16& p0, const f32x16& p1, bf16x8& pa0, bf16x8& pa1, bf16x8& pa2, bf16x8& pa3) {
#define PK4(P, BASE, OUT) do { unsigned a0 = cvt_pk_bf16(P[BASE + 0], P[BASE + 1]), a1 = cvt_pk_bf16(P[BASE + 2], P[BASE + 3]);   \
    unsigned b0 = cvt_pk_bf16(P[BASE + 4], P[BASE + 5]), b1 = cvt_pk_bf16(P[BASE + 6], P[BASE + 7]);                              \
    auto r0 = __builtin_amdgcn_permlane32_swap(a0, b0, false, false); auto r1 = __builtin_amdgcn_permlane32_swap(a1, b1, false, false); \
    u32x4 w = {r0[0], r1[0], r0[1], r1[1]}; OUT = __builtin_bit_cast(bf16x8, w); } while (0)
    PK4(p0, 0, pa0); PK4(p0, 8, pa1); PK4(p1, 0, pa2); PK4(p1, 8, pa3);
#undef PK4
}
template <int DQK> struct AttnG {
    static constexpr int CPR = DQK / 8, KSTR = DQK * 2 + 16, KBYTES = 64 * KSTR, NKCH = (64 * CPR) / 512, ND0 = DQK / 16;
    static constexpr int VOFF = 2 * KBYTES, LIOFF = VOFF + 2 * 16384, END = LIOFF + 8 * 128;
};
template <int DQK> __device__ __forceinline__ void attn_tile_load(bf16x8 (&kreg)[AttnG<DQK>::NKCH], bf16x8 (&vreg)[2], const bf16* kt, int ldk, const bf16* vt, int ldv, int tid) {
    using G = AttnG<DQK>;
#pragma unroll
    for (int i = 0; i < G::NKCH; ++i) { const int q = tid + 512 * i, row = q / G::CPR, ch = q % G::CPR; kreg[i] = *(const bf16x8*)(kt + (size_t)row * ldk + ch * 8); }
    const int sr = tid >> 4, sc = (tid & 15) * 8;
    vreg[0] = *(const bf16x8*)(vt + (size_t)sr * ldv + sc); vreg[1] = *(const bf16x8*)(vt + (size_t)(32 + sr) * ldv + sc);
}
template <int DQK> __device__ __forceinline__ void attn_tile_write(const bf16x8 (&kreg)[AttnG<DQK>::NKCH], const bf16x8 (&vreg)[2], LAS unsigned char* kb, LAS unsigned char* vbuf, int tid) {
    using G = AttnG<DQK>;
#pragma unroll
    for (int i = 0; i < G::NKCH; ++i) { const int q = tid + 512 * i, row = q / G::CPR, ch = q % G::CPR; *(LAS bf16x8*)(kb + row * G::KSTR + ch * 16) = kreg[i]; }
    const int sr = tid >> 4, sc = (tid & 15) * 8;
    *(LAS bf16x8*)(vbuf + v_st(sr, sc)) = vreg[0]; *(LAS bf16x8*)(vbuf + v_st(32 + sr, sc)) = vreg[1];
}
template <int DQK> __device__ __forceinline__ void attn_qkt(f32x16& p0, f32x16& p1, const LAS unsigned char* kb, const bf16x8 (&qr)[AttnG<DQK>::ND0], int r32, int hi) {
    using G = AttnG<DQK>;
#pragma unroll
    for (int r = 0; r < 16; ++r) { p0[r] = 0.f; p1[r] = 0.f; }
#pragma unroll
    for (int d0 = 0; d0 < G::ND0; ++d0) { const int cb = (d0 * 16 + hi * 8) * 2;
        const bf16x8 b0 = *(const LAS bf16x8*)(kb + r32 * G::KSTR + cb);
        const bf16x8 b1 = *(const LAS bf16x8*)(kb + (32 + r32) * G::KSTR + cb);
        p0 = __builtin_amdgcn_mfma_f32_32x32x16_bf16(b0, qr[d0], p0, 0, 0, 0);
        p1 = __builtin_amdgcn_mfma_f32_32x32x16_bf16(b1, qr[d0], p1, 0, 0, 0); }
}
__device__ __forceinline__ void attn_store(const f32x16 (&o)[4], float lsum, LAS float* li, bf16* orow0, int ldo, int r32, int hi) {
    lsum += __shfl_xor(lsum, 32);
    if (hi == 0) li[r32] = lsum;
    LDS_WAIT();
    float rli[16];
#pragma unroll
    for (int r = 0; r < 16; ++r) rli[r] = 1.0f / li[crow(r, hi)];
#pragma unroll
    for (int r = 0; r < 16; ++r) { bf16* op = orow0 + (size_t)crow(r, hi) * ldo + r32;
#pragma unroll
        for (int d0 = 0; d0 < 4; ++d0) op[d0 * 32] = (bf16)f2bf(o[d0][r] * rli[r]); }
    LDS_WAIT();
}

__device__ __forceinline__ void mla_unit(Frame& F, int b, int h, int qrow0, int ntile) {
    using G = AttnG<MQK>;
    const bf16* QF = (const bf16*)(F.ws + WS_QF); const bf16* KF = (const bf16*)(F.ws + WS_KF); const bf16* KVRAW = (const bf16*)(F.ws + WS_KVRAW);
    bf16* YC = (bf16*)(F.ws + WS_YC);
    const int tid = F.tid, lane = F.lane, r32 = lane & 31, hi = lane >> 5, wid = F.wave;
    LAS unsigned char* lds = F.lds;
    LAS float* li = (LAS float*)(lds + G::LIOFF + wid * 128);
    bf16x8 qr[G::ND0];
    { const bf16* qp = QF + ((size_t)(qrow0 + wid * 32 + r32) * MH + h) * MQK + hi * 8;
#pragma unroll
      for (int d0 = 0; d0 < G::ND0; ++d0) qr[d0] = *(const bf16x8*)(qp + d0 * 16); }
    f32x16 o[4];
#pragma unroll
    for (int d = 0; d < 4; ++d)
#pragma unroll
        for (int r = 0; r < 16; ++r) o[d][r] = 0.f;
    float lsum = 0.f;
    const int vb0 = (int)(unsigned)(uintptr_t)(lds + G::VOFF) + v_rd_base(lane);
    bf16x8 kreg[G::NKCH], vreg[2];
#define MLA_TROW(j) ((j) < 4 ? b * CTXL + 64 * (j) : NCTX + b * SEQ + 64 * ((j) - 4))
    { const int tr = MLA_TROW(0); attn_tile_load<MQK>(kreg, vreg, KF + ((size_t)tr * MH + h) * MQK, MH * MQK, KVRAW + (size_t)tr * 2048 + h * 256 + 128, 2048, tid); }
    attn_tile_write<MQK>(kreg, vreg, lds, lds + G::VOFF, tid);
    __syncthreads();
    for (int j = 0; j < ntile; ++j) {
        const int cur = j & 1;
        if (j + 1 < ntile) { const int tr = MLA_TROW(j + 1); attn_tile_load<MQK>(kreg, vreg, KF + ((size_t)tr * MH + h) * MQK, MH * MQK, KVRAW + (size_t)tr * 2048 + h * 256 + 128, 2048, tid); }
        f32x16 p0, p1;
        attn_qkt<MQK>(p0, p1, lds + cur * G::KBYTES, qr, r32, hi);
#pragma unroll
        for (int r = 0; r < 16; ++r) { p0[r] = __builtin_amdgcn_exp2f(p0[r]); p1[r] = __builtin_amdgcn_exp2f(p1[r]); }
        float ps = 0.f;
#pragma unroll
        for (int r = 0; r < 16; ++r) ps += p0[r] + p1[r];
        lsum += ps;
        bf16x8 pa0, pa1, pa2, pa3; pack_p(p0, p1, pa0, pa1, pa2, pa3);
        pv_d0(o, vb0 + cur * 16384, pa0, pa1, pa2, pa3);
        if (j + 1 < ntile) attn_tile_write<MQK>(kreg, vreg, lds + (cur ^ 1) * G::KBYTES, lds + G::VOFF + (cur ^ 1) * 16384, tid);
        __syncthreads();
    }
#undef MLA_TROW
    attn_store(o, lsum, li, YC + (size_t)(qrow0 + wid * 32) * DM + DRNN + h * MV, DM, r32, hi);
    __syncthreads();
}
__device__ __forceinline__ void p6_mla_attention(Frame& F) {
    for (int U = F.vcu; U < 544; U += F.G) {
        int b, h, qrow0, ntile;
        if (U < 512) { const int bh = U >> 4, qb = U & 15; b = bh >> 3; h = bh & 7; qrow0 = NCTX + b * SEQ + qb * 256; ntile = 68; }
        else { const int bh = U - 512; b = bh >> 3; h = bh & 7; qrow0 = b * CTXL; ntile = 4; }
        mla_unit(F, b, h, qrow0, ntile);
    }
}

__device__ __forceinline__ void p15_na_finalize(Frame& F, const Params& p) {
    bf16* QKV = (bf16*)(F.ws + WS_QKV);
    const int lane = F.lane;
    const float gq0 = p.in[I_NAQHG][lane], gq1 = p.in[I_NAQHG][64 + lane], gk0 = p.in[I_NAKHG][lane], gk1 = p.in[I_NAKHG][64 + lane];
    const float qs = 0.08838834764831845f * LOG2E;
    const int gw = blockIdx.x * NWAVES + F.wave, NGW = F.G * NWAVES;
    for (int row = gw; row < NTOK; row += NGW) {
        bf16* rp = QKV + (size_t)row * 6144;
        if (row >= NCTX) {
#pragma unroll 4
            for (int h = 0; h < NAH; ++h) { bf16* q = rp + h * NAD; const float v0 = bf2f(q[lane]), v1 = bf2f(q[64 + lane]);
                const float rstd = rsqrtf(wave_sum(v0 * v0 + v1 * v1) * (1.0f / NAD) + EPS);
                q[lane] = (bf16)f2bf(v0 * rstd * gq0 * qs); q[64 + lane] = (bf16)f2bf(v1 * rstd * gq1 * qs); } }
#pragma unroll 4
        for (int h = 0; h < NAH; ++h) { bf16* k = rp + DM + h * NAD; const float v0 = bf2f(k[lane]), v1 = bf2f(k[64 + lane]);
            const float rstd = rsqrtf(wave_sum(v0 * v0 + v1 * v1) * (1.0f / NAD) + EPS);
            k[lane] = (bf16)f2bf(v0 * rstd * gk0); k[64 + lane] = (bf16)f2bf(v1 * rstd * gk1); }
    }
}
__device__ __forceinline__ void na_unit(Frame& F, const Params& p, int b, int h, int R0) {
    using G = AttnG<NAD>;
    const bf16* QKV = (const bf16*)(F.ws + WS_QKV); bf16* ATT = (bf16*)(F.ws + WS_ATT2);
    const int tid = F.tid, lane = F.lane, r32 = lane & 31, hi = lane >> 5, wid = F.wave;
    LAS unsigned char* lds = F.lds;
    LAS float* li = (LAS float*)(lds + G::LIOFF + wid * 128);
    LAS float* rpbl = (LAS float*)(lds + G::END);
    for (int i = tid; i < 15 * 32; i += NTHR) { const int dr = i >> 5, dc = i & 31; rpbl[i] = dc < 31 ? p.in[I_RPB][(h * 15 + dr) * 31 + dc] * LOG2E : 0.f; }
    const int rq = R0 + (wid >> 1), qc = 32 * (wid & 1) + r32;
    const int qrow = NCTX + b * SEQ + rq * GW + qc;
    bf16x8 qr[G::ND0];
    { const bf16* qp = QKV + (size_t)qrow * 6144 + h * NAD + hi * 8;
#pragma unroll
      for (int d0 = 0; d0 < G::ND0; ++d0) qr[d0] = *(const bf16x8*)(qp + d0 * 16); }
    f32x16 o[4];
#pragma unroll
    for (int d = 0; d < 4; ++d)
#pragma unroll
        for (int r = 0; r < 16; ++r) o[d][r] = 0.f;
    float lsum = 0.f;
    const int vb0 = (int)(unsigned)(uintptr_t)(lds + G::VOFF) + v_rd_base(lane);
    const int klo = min(max(R0 - 4, 0), 56), khi = min(max(R0 + 3 - 4, 0), 56) + 7, nloc = khi - klo + 1, ntile = nloc + 4;
    const int w0 = min(max(rq - 4, 0), 56);
    const int cst = min(max(qc - 8, 0), 48);
    bf16x8 kreg[G::NKCH], vreg[2];
#define NA_TROW(j) ((j) < nloc ? NCTX + b * SEQ + (klo + (j)) * GW : b * CTXL + 64 * ((j) - nloc))
    { const int tr = NA_TROW(0); attn_tile_load<NAD>(kreg, vreg, QKV + (size_t)tr * 6144 + DM + h * NAD, 6144, QKV + (size_t)tr * 6144 + 2 * DM + h * NAD, 6144, tid); }
    attn_tile_write<NAD>(kreg, vreg, lds, lds + G::VOFF, tid);
    __syncthreads();
    for (int j = 0; j < ntile; ++j) {
        const int cur = j & 1;
        if (j + 1 < ntile) { const int tr = NA_TROW(j + 1); attn_tile_load<NAD>(kreg, vreg, QKV + (size_t)tr * 6144 + DM + h * NAD, 6144, QKV + (size_t)tr * 6144 + 2 * DM + h * NAD, 6144, tid); }
        const bool local = j < nloc; const int krow = klo + j;
        if (!local || (krow >= w0 && krow < w0 + 8)) {
            f32x16 p0, p1;
            attn_qkt<NAD>(p0, p1, lds + cur * G::KBYTES, qr, r32, hi);
            if (local) {
                const LAS float* brow = rpbl + (krow - rq + 7) * 32 + (15 - qc);
#pragma unroll
                for (int r = 0; r < 16; ++r) {
                    const int kc0 = crow(r, hi), kc1 = 32 + kc0;
                    const bool ok0 = kc0 >= cst && kc0 < cst + 16, ok1 = kc1 >= cst && kc1 < cst + 16;
                    const float b0 = ok0 ? brow[kc0] : 0.f, b1 = ok1 ? brow[kc1] : 0.f;
                    p0[r] = ok0 ? __builtin_amdgcn_exp2f(p0[r] + b0) : 0.f; p1[r] = ok1 ? __builtin_amdgcn_exp2f(p1[r] + b1) : 0.f; }
            } else {
#pragma unroll
                for (int r = 0; r < 16; ++r) { p0[r] = __builtin_amdgcn_exp2f(p0[r]); p1[r] = __builtin_amdgcn_exp2f(p1[r]); }
            }
            float ps = 0.f;
#pragma unroll
            for (int r = 0; r < 16; ++r) ps += p0[r] + p1[r];
            lsum += ps;
            bf16x8 pa0, pa1, pa2, pa3; pack_p(p0, p1, pa0, pa1, pa2, pa3);
            pv_d0(o, vb0 + cur * 16384, pa0, pa1, pa2, pa3);
        }
        if (j + 1 < ntile) attn_tile_write<NAD>(kreg, vreg, lds + (cur ^ 1) * G::KBYTES, lds + G::VOFF + (cur ^ 1) * 16384, tid);
        __syncthreads();
    }
#undef NA_TROW
    attn_store(o, lsum, li, ATT + (size_t)(NCTX + b * SEQ + rq * GW + 32 * (wid & 1)) * DM + h * NAD, DM, r32, hi);
    __syncthreads();
}
__device__ __forceinline__ void p16_na_attention(Frame& F, const Params& p) {
    for (int rnd = 0; rnd < 4; ++rnd)
        for (int U = rnd * 256 + F.vcu; U < rnd * 256 + 256; U += F.G) { const int bh = U >> 4, rg = U & 15, b = bh >> 4, h = bh & 15; na_unit(F, p, b, h, 4 * rg); }
}

__device__ __forceinline__ void p8_h2_route(Frame& F, const Params& p, int l, const float* X, int rbase) {
    unsigned char* ws = F.ws;
    LAS float* wt = (LAS float*)F.lds;
    for (int i = F.tid; i < DM * NE; i += NTHR) { const int k = i >> 4, e = i & 15; wt[e * DM + k] = p.in[I_RW][i]; }
    volatile LAS unsigned* lcnt = F.MISC + 16; volatile LAS unsigned* lbase = F.MISC + 32;
    LAS int* lrec = (LAS int*)(F.MISC + 64);
    if (F.tid < 16) lcnt[F.tid] = 0u;
    __syncthreads();
    const float* mod = (const float*)(ws + WS_MOD) + (size_t)l * 5 * 12288;
    const float* gn = p.in[I_NFFNG] + l * DM;
    float rb[16];
#pragma unroll
    for (int e = 0; e < 16; ++e) rb[e] = p.in[I_RB][e];
    int it = 0;
    for (int row = rbase + blockIdx.x * NWAVES + F.wave; row < NTOK; row += F.G * NWAVES, ++it) {
        const int v = vec_of_row(row);
        f32x4 x[8]; load_row_f32(X + (size_t)row * DM, F.lane, x); const float rstd = row_rstd(x);
        const float* mv = mod + (size_t)v * 12288;
#pragma unroll
        for (int j = 0; j < 8; ++j) { const int c = 4 * F.lane + 256 * j; const f32x4 g = *(const f32x4*)(gn + c), sc = *(const f32x4*)(mv + 4 * DM + c), sh = *(const f32x4*)(mv + 3 * DM + c);
            x[j] = x[j] * rstd * g * (1.0f + sc) + sh; }
        store_row_bf16((bf16*)(ws + WS_H) + (size_t)row * DM, F.lane, x);
        float lg[16];
#pragma unroll
        for (int e = 0; e < 16; ++e) { float s = 0.f;
#pragma unroll
            for (int j = 0; j < 8; ++j) { const f32x4 w = *(const LAS f32x4*)(wt + e * DM + 4 * F.lane + 256 * j); s += (x[j].x * w.x + x[j].y * w.y) + (x[j].z * w.z + x[j].w * w.w); }
            lg[e] = wave_sum(s); }
        float sc[16], sel[16];
#pragma unroll
        for (int e = 0; e < 16; ++e) { sc[e] = 1.0f / (1.0f + expf(-lg[e])); sel[e] = sc[e] + rb[e]; }
        int best = 0; float bestv = -3.0e38f;
#pragma unroll
        for (int g = 0; g < 4; ++g) { float m1 = -3.0e38f, m2 = -3.0e38f;
#pragma unroll
            for (int k = 0; k < 4; ++k) { const float s = sel[4 * g + k]; if (s > m1) { m2 = m1; m1 = s; } else if (s > m2) m2 = s; }
            const float gs = m1 + m2; if (gs > bestv) { bestv = gs; best = g; } }
        int e0 = 0, e1 = 0; float s0 = -3.0e38f, s1 = -3.0e38f, w0 = 0.f, w1 = 0.f;
#pragma unroll
        for (int e = 0; e < 16; ++e) { if ((e >> 2) == best) { const float s = sel[e];
                if (s > s0) { s1 = s0; e1 = e0; w1 = w0; s0 = s; e0 = e; w0 = sc[e]; } else if (s > s1) { s1 = s; e1 = e; w1 = sc[e]; } } }
        const float wn = 1.0f / (w0 + w1);
        if (F.lane == 0) {
            const int lp0 = (int)__hip_atomic_fetch_add((LAS unsigned*)(lcnt + e0), 1u, __ATOMIC_RELAXED, __HIP_MEMORY_SCOPE_WORKGROUP);
            const int lp1 = (int)__hip_atomic_fetch_add((LAS unsigned*)(lcnt + e1), 1u, __ATOMIC_RELAXED, __HIP_MEMORY_SCOPE_WORKGROUP);
            if (it < 64) { LAS int* r = lrec + (F.wave * 64 + it) * 4; r[0] = e0; r[1] = e1; r[2] = lp0; r[3] = lp1; }
            ((int*)(ws + WS_TOKE))[2 * row] = e0; ((int*)(ws + WS_TOKE))[2 * row + 1] = e1;
            ((float*)(ws + WS_TOKW))[2 * row] = w0 * wn; ((float*)(ws + WS_TOKW))[2 * row + 1] = w1 * wn;
        }
    }
    __syncthreads();
    if (F.tid < 16) { const unsigned n = lcnt[F.tid]; lbase[F.tid] = n ? __hip_atomic_fetch_add(F.ctl + CW_CNT + (l * 16 + F.tid) * 64, n, RLX_AGENT) : 0u; }
    __syncthreads();
    if (F.lane == 0) { it = 0;
        for (int row = rbase + blockIdx.x * NWAVES + F.wave; row < NTOK; row += F.G * NWAVES, ++it) { if (it >= 64) break;
            const LAS int* r = lrec + (F.wave * 64 + it) * 4;
            ((int*)(ws + WS_TOKP))[2 * row] = (int)lbase[r[0]] + r[2]; ((int*)(ws + WS_TOKP))[2 * row + 1] = (int)lbase[r[1]] + r[3]; } }
    __syncthreads();
}
__device__ __forceinline__ int moe_tiles(Frame& F, int l, int nsh, volatile LAS int* tile_e, int& ntot) {
    int nt_r = 0;
    if (F.tid == 0) { int t = 0;
        for (int e = 0; e < 16; ++e) { const int c = (int)__hip_atomic_load(F.ctl + CW_CNT + (l * 16 + e) * 64, RLX_AGENT); const int n = (c + 255) >> 8; for (int i = 0; i < n; ++i) tile_e[t++] = e; }
        for (int i = 0; i < nsh; ++i) tile_e[t + i] = 16;
        tile_e[255] = t; }
    __syncthreads();
    nt_r = __builtin_amdgcn_readfirstlane(tile_e[255]); ntot = nt_r + nsh;
    return nt_r;
}
__device__ __forceinline__ void p9_scatter(Frame& F, int l, int rbase) {
    unsigned char* ws = F.ws;
    int off[17]; { int t = 0;
#pragma unroll
        for (int e = 0; e < 16; ++e) { off[e] = t * 256; const int c = (int)__hip_atomic_load(F.ctl + CW_CNT + (l * 16 + e) * 64, RLX_AGENT); t += (c + 255) >> 8; }
        off[16] = t * 256; }
    const int* toke = (const int*)(ws + WS_TOKE); const int* tokp = (const int*)(ws + WS_TOKP); int* toks = (int*)(ws + WS_TOKS); int* slottok = (int*)(ws + WS_SLOTTOK);
    for (int i = blockIdx.x * NTHR + F.tid; i < (NTOK - rbase) * 2; i += F.G * NTHR) { const int row = rbase + (i >> 1), k = i & 1;
        const int e = toke[2 * row + k]; int o = 0;
#pragma unroll
        for (int q = 0; q < 16; ++q) o = (e == q) ? off[q] : o;
        const int slot = o + tokp[2 * row + k]; slottok[slot] = row; toks[2 * row + k] = slot; }
    for (int i = blockIdx.x * NTHR + F.tid; i < NTOK - rbase; i += F.G * NTHR) slottok[off[16] + i] = rbase + i;
    for (int i = blockIdx.x * NTHR + F.tid; i < 16 * 256; i += F.G * NTHR) { const int e = i >> 8, j = i & 255; int o = 0, on = 0;
#pragma unroll
        for (int q = 0; q < 16; ++q) { o = (e == q) ? off[q] : o; on = (e == q) ? off[q + 1] : on; }
        const int c = (int)__hip_atomic_load(F.ctl + CW_CNT + (l * 16 + e) * 64, RLX_AGENT);
        if (o + c + j < on) slottok[o + c + j] = rbase; }
}
__device__ __forceinline__ void p12_combine(Frame& F, const Params& p, int l, const float* Xin, float* Xout, int rbase, int sr_off) {
    unsigned char* ws = F.ws;
    const bf16* Y = (const bf16*)(ws + WS_Y);
    const float* mod = (const float*)(ws + WS_MOD) + (size_t)l * 5 * 12288;
    const int* toks = (const int*)(ws + WS_TOKS); const float* tokw = (const float*)(ws + WS_TOKW);
    for (int row = rbase + blockIdx.x * NWAVES + F.wave; row < NTOK; row += F.G * NWAVES) {
        const int v = vec_of_row(row);
        const int s0 = toks[2 * row], s1 = toks[2 * row + 1]; const float w0 = tokw[2 * row], w1 = tokw[2 * row + 1];
        const bf16* y0 = Y + (size_t)s0 * DM; const bf16* y1 = Y + (size_t)s1 * DM; const bf16* ys = Y + (size_t)(sr_off + row - rbase) * DM;
        const float* g5 = mod + (size_t)v * 12288 + 5 * DM;
        f32x4 x[8];
#pragma unroll
        for (int j = 0; j < 8; ++j) { const int c = 4 * F.lane + 256 * j;
            const f32x4 xi = *(const f32x4*)(Xin + (size_t)row * DM + c), g = *(const f32x4*)(g5 + c);
            const u32x2 a = *(const u32x2*)(ys + c), b0 = *(const u32x2*)(y0 + c), b1 = *(const u32x2*)(y1 + c);
            f32x4 m;
            m.x = bflo(a.x) + w0 * bflo(b0.x) + w1 * bflo(b1.x); m.y = bfhi(a.x) + w0 * bfhi(b0.x) + w1 * bfhi(b1.x);
            m.z = bflo(a.y) + w0 * bflo(b0.y) + w1 * bflo(b1.y); m.w = bfhi(a.y) + w0 * bfhi(b0.y) + w1 * bfhi(b1.y);
            x[j] = xi + g * m; }
        if (l == 0) {
#pragma unroll
            for (int j = 0; j < 8; ++j) *(f32x4*)(Xout + (size_t)row * DM + 4 * F.lane + 256 * j) = x[j];
            const float rstd = row_rstd(x);
            const float* m1 = (const float*)(ws + WS_MOD) + (size_t)(5 + v) * 12288; const float* gn = p.in[I_NMIXG] + DM;
#pragma unroll
            for (int j = 0; j < 8; ++j) { const int c = 4 * F.lane + 256 * j; const f32x4 g = *(const f32x4*)(gn + c), sc = *(const f32x4*)(m1 + DM + c), sh = *(const f32x4*)(m1 + c);
                x[j] = x[j] * rstd * g * (1.0f + sc) + sh; }
            store_row_bf16((bf16*)(ws + WS_H) + (size_t)row * DM, F.lane, x);
        } else {
#pragma unroll
            for (int j = 0; j < 8; ++j) *(f32x4*)(Xout + (size_t)(row - NCTX) * DM + 4 * F.lane + 256 * j) = x[j];
        }
    }
}

constexpr int NPHASE = 22;
__global__ void __launch_bounds__(NTHR, 2) mega_fwd(Params p) {
    extern __shared__ __attribute__((aligned(16))) unsigned char lds_raw[];
    Frame F;
    F.lds = (LAS unsigned char*)lds_raw; F.MISC = (volatile LAS unsigned*)(F.lds + MISC_OFF);
    F.tid = threadIdx.x; F.lane = F.tid & 63; F.wave = __builtin_amdgcn_readfirstlane(F.tid >> 6);
    F.G = gridDim.x; { const int bx = blockIdx.x; F.vcu = (F.G % 8 == 0) ? (bx % 8) * (F.G / 8) + bx / 8 : bx; }
    F.ws = p.ws; F.ctl = (unsigned*)(p.ws + WS_CTL);
    unsigned char* ws = p.ws;
    for (int u = F.tid; u < (LDS_BYTES - MISC_OFF) / 4; u += NTHR) ((LAS unsigned*)(F.lds + MISC_OFF))[u] = 0u;
    __syncthreads();
    const int lo = p.ph_lo, hi = p.ph_hi;
    XcdBarrier bar; bar.bar = F.ctl + CW_BAR; bar.x = 0; bar.st = F.MISC;
    if (hi - lo > 1) bar = xcd_barrier_post(F.ctl + CW_BAR, F.MISC);
#ifdef ONLY_PHASE
#define IN(k) ((k) == ONLY_PHASE && lo <= (k) && (k) < hi)
#else
#define IN(k) (lo <= (k) && (k) < hi)
#endif
#define SEAM(k) do { if (IN(k) && IN((k) + 1)) xcd_barrier(bar); } while (0)
    volatile LAS int* tile_e = (volatile LAS int*)(F.MISC + 2112);
#define REFRESH() do { int _tz = threadIdx.x; asm volatile("" : "+v"(_tz)); F.tid = _tz; F.lane = _tz & 63; F.wave = __builtin_amdgcn_readfirstlane(_tz >> 6); } while (0)
    const size_t TS2048 = (size_t)256 * 2048 * 2;

    if (IN(0)) { REFRESH(); p0_prologue(F, p); } SEAM(0);
    if (IN(1)) { REFRESH(); p1_modulate0(F, p); } SEAM(1);
    if (IN(2)) {   REFRESH();
        pg8::DenseSched S; S.T.init(NTOK / 256, ABINP / 256, F.G, (int)blockIdx.x); S.A = (const char*)(ws + WS_H); S.Bt = (const char*)(ws + WS_WIN); S.tstepB = TS2048; S.row0 = 0;
        EpiU E{(bf16*)(ws + WS_U)};
        pg8::gemm_phase<EpiU, pg8::DenseSched>(F.lds, DM, S, E);
    } SEAM(2);
    if (IN(3)) { REFRESH(); p3_rank_norms(F, p); REFRESH(); p3_conv_gates(F, p); } SEAM(3);
    if (IN(4)) {   REFRESH();
        { pg8::DenseSched S; S.T.init(NTOK / 256, 1536 / 256, F.G, (int)blockIdx.x); S.A = (const char*)(ws + WS_CQN); S.Bt = (const char*)(ws + WS_WUQ); S.tstepB = (size_t)256 * 512 * 2; S.row0 = 0;
          EpiBf E{(bf16*)(ws + WS_QRAW), 1536};
          pg8::gemm_phase<EpiBf, pg8::DenseSched>(F.lds, 512, S, E); }
        REFRESH();
        { pg8::DenseSched S; S.T.init(NTOK / 256, 2048 / 256, F.G, (int)blockIdx.x); S.A = (const char*)(ws + WS_CKVN); S.Bt = (const char*)(ws + WS_WUKV); S.tstepB = (size_t)256 * 512 * 2; S.row0 = 0;
          EpiBf E{(bf16*)(ws + WS_KVRAW), 2048};
          pg8::gemm_phase<EpiBf, pg8::DenseSched>(F.lds, 512, S, E); }
        REFRESH(); scan_pass_b(F);
    } SEAM(4);
    if (IN(5)) { REFRESH(); p5_mla_finalize(F, p); scan_pass_c(F); } SEAM(5);
    if (IN(6)) { REFRESH(); p6_mla_attention(F); REFRESH(); scan_pass_d(F); } SEAM(6);
    if (IN(7)) {   REFRESH();
        pg8::DenseSched S; S.T.init(NTOK / 256, DM / 256, F.G, (int)blockIdx.x); S.A = (const char*)(ws + WS_YC); S.Bt = (const char*)(ws + WS_WOUT0); S.tstepB = TS2048; S.row0 = 0;
        EpiRes E{p.in[I_CTX], p.in[I_X], (float*)(ws + WS_XA), (const float*)(ws + WS_MOD) + 2 * DM, 0};
        pg8::gemm_phase<EpiRes, pg8::DenseSched>(F.lds, DM, S, E);
    } SEAM(7);

#define MOE_PHASES(l) do { \
        constexpr int pb = (l) ? 17 : 8, rbase = (l) ? NCTX : 0, nsh = (l) ? NLAT / 256 : NTOK / 256; \
        if (IN(pb + 0)) { REFRESH(); p8_h2_route(F, p, (l), (const float*)(ws + WS_XA), rbase); } SEAM(pb + 0); \
        if (IN(pb + 1)) { REFRESH(); p9_scatter(F, (l), rbase); } SEAM(pb + 1); \
        if (IN(pb + 2)) { REFRESH(); \
            int ntot; moe_tiles(F, (l), nsh, tile_e, ntot); \
            pg8::MoeSched S; S.T.init(ntot, 11, F.G, (int)blockIdx.x); S.A = (const char*)(ws + WS_H); S.Bt = (const char*)(ws + WS_W1 + (size_t)(l) * 17 * W1_E); S.tstepB = TS2048; S.estride = W1_E; \
            S.rowmap = (const int*)(ws + WS_SLOTTOK); S.tile_e = tile_e; \
            EpiSwiglu E{(bf16*)(ws + WS_ACT)}; \
            pg8::gemm_phase<EpiSwiglu, pg8::MoeSched>(F.lds, DM, S, E); \
        } SEAM(pb + 2); \
        if (IN(pb + 3)) { REFRESH(); \
            int ntot; moe_tiles(F, (l), nsh, tile_e, ntot); \
            pg8::MoeSched S; S.T.init(ntot, 8, F.G, (int)blockIdx.x); S.A = (const char*)(ws + WS_ACT); S.Bt = (const char*)(ws + WS_W2 + (size_t)(l) * 17 * W2_E); S.tstepB = (size_t)256 * DE * 2; S.estride = W2_E; \
            S.rowmap = nullptr; S.tile_e = tile_e; \
            EpiBf E{(bf16*)(ws + WS_Y), DM}; \
            pg8::gemm_phase<EpiBf, pg8::MoeSched>(F.lds, DE, S, E); \
        } SEAM(pb + 3); \
        if (IN(pb + 4)) { REFRESH(); \
            int ntot; const int ntr = moe_tiles(F, (l), nsh, tile_e, ntot); \
            p12_combine(F, p, (l), (const float*)(ws + WS_XA), (l) ? p.out : (float*)(ws + WS_XB), rbase, ntr * 256); \
        } SEAM(pb + 4); \
    } while (0)
    MOE_PHASES(0);
    if (IN(13)) {   REFRESH();
        pg8::DenseSched S; S.T.init(NTOK / 256, 6144 / 256, F.G, (int)blockIdx.x); S.A = (const char*)(ws + WS_H); S.Bt = (const char*)(ws + WS_WQKV); S.tstepB = TS2048; S.row0 = 0;
        EpiBf E{(bf16*)(ws + WS_QKV), 6144};
        pg8::gemm_phase<EpiBf, pg8::DenseSched>(F.lds, DM, S, E);
    } SEAM(13);
    if (IN(14)) { REFRESH(); p15_na_finalize(F, p); } SEAM(14);
    if (IN(15)) { REFRESH(); p16_na_attention(F, p); } SEAM(15);
    if (IN(16)) {   REFRESH();
        pg8::DenseSched S; S.T.init(NLAT / 256, DM / 256, F.G, (int)blockIdx.x); S.A = (const char*)(ws + WS_ATT2); S.Bt = (const char*)(ws + WS_WOUT1); S.tstepB = TS2048; S.row0 = NCTX;
        EpiRes E{(const float*)(ws + WS_XB), (const float*)(ws + WS_XB) + (size_t)NCTX * DM, (float*)(ws + WS_XA), (const float*)(ws + WS_MOD) + (size_t)5 * 12288 + 2 * DM, NCTX};
        pg8::gemm_phase<EpiRes, pg8::DenseSched>(F.lds, DM, S, E);
    } SEAM(16);
    MOE_PHASES(1);
#undef MOE_PHASES
#undef IN
#undef SEAM
}

extern "C" void kernel_launch(void* const* d_in, const int* in_sizes, int n_in, void* d_out, int out_size, void* d_ws, size_t ws_size, hipStream_t stream) {
    static int grid = 0;
    if (grid == 0) {
        if (n_in != 36 || in_sizes[0] != NLAT * DM || out_size != NLAT * DM || ws_size < WS_END) {
            fprintf(stderr, "kernel_launch: shape mismatch: n_in %d in0 %d out %d ws %zu (need %zu)\n", n_in, n_in > 0 ? in_sizes[0] : -1, out_size, ws_size, (size_t)WS_END); grid = -1; return; }
        int dev = 0, cus = 0, per_cu = 0;
        if (hipGetDevice(&dev) != hipSuccess || hipDeviceGetAttribute(&cus, hipDeviceAttributeMultiprocessorCount, dev) != hipSuccess) { grid = -1; return; }
        if (hipFuncSetAttribute((const void*)mega_fwd, hipFuncAttributeMaxDynamicSharedMemorySize, LDS_BYTES) != hipSuccess) { fprintf(stderr, "kernel_launch: hipFuncSetAttribute failed\n"); grid = -1; return; }
        if (hipOccupancyMaxActiveBlocksPerMultiprocessor(&per_cu, (const void*)mega_fwd, NTHR, LDS_BYTES) != hipSuccess || per_cu < 1) { fprintf(stderr, "kernel_launch: occupancy query says %d\n", per_cu); }
        (void)hipGetLastError();
        grid = cus;
    }
    if (grid < 0) return;
    if (hipMemsetAsync((char*)d_ws + WS_CTL, 0, CTL_BYTES, stream) != hipSuccess) return;
    Params P{};
    for (int i = 0; i < 36; ++i) P.in[i] = (const float*)d_in[i];
    P.out = (float*)d_out; P.ws = (unsigned char*)d_ws;
#if MK_N_LAUNCHES == 1
    P.ph_lo = 0; P.ph_hi = NPHASE;
    hipLaunchKernelGGL(mega_fwd, dim3(grid), dim3(NTHR), LDS_BYTES, stream, P);
#else
    for (int k = 0; k < NPHASE; ++k) { P.ph_lo = k; P.ph_hi = k + 1; hipLaunchKernelGGL(mega_fwd, dim3(grid), dim3(NTHR), LDS_BYTES, stream, P); }
#endif
    const hipError_t le = hipPeekAtLastError();
    if (le != hipSuccess) fprintf(stderr, "kernel_launch: launch failed: %s\n", hipGetErrorName(le));
}
```

```cpp
#include <hip/hip_runtime.h>
#include <cstdio>
#include <cstdint>

#ifndef MK_N_LAUNCHES
#define MK_N_LAUNCHES 1
#endif

#define GAS __attribute__((address_space(1)))
#define LAS __attribute__((address_space(3)))
typedef unsigned short bf16;
typedef short bf16x8 __attribute__((ext_vector_type(8)));
typedef short s16x4 __attribute__((ext_vector_type(4)));
typedef float f32x2 __attribute__((ext_vector_type(2)));
typedef float f32x4 __attribute__((ext_vector_type(4)));
typedef float f32x16 __attribute__((ext_vector_type(16)));
typedef unsigned u32x2 __attribute__((ext_vector_type(2)));
typedef unsigned u32x4 __attribute__((ext_vector_type(4)));
#define LDS_WAIT() asm volatile("s_waitcnt lgkmcnt(0)" ::: "memory")
#define VM_WAIT() asm volatile("s_waitcnt vmcnt(0)" ::: "memory")
#define RLX_AGENT __ATOMIC_RELAXED, __HIP_MEMORY_SCOPE_AGENT

constexpr int DM = 2048, NB = 4, SEQ = 4096, CTXL = 256, GW = 64;
constexpr int NCTX = NB * CTXL, NLAT = NB * SEQ, NTOK = NCTX + NLAT;
constexpr int DRNN = 1024, QRK = 512, KVRK = 512, MROPE = 64, MNOPE = 128, MQK = 192, MV = 128, MH = 8;
constexpr int ABIN = 3136, ABINP = 3328;
constexpr int NAH = 16, NAD = 128;
constexpr int NE = 16, DE = 1408, NG = 4;
constexpr int NCHUNK = 68;
constexpr float EPS = 1e-6f;
constexpr float LOG2E = 1.4426950408889634f;
constexpr int MAXSLOT = 56320;

constexpr size_t al256(size_t x) { return (x + 255) / 256 * 256; }
constexpr size_t WS_CTL = 0, CTL_BYTES = 1u << 20;
constexpr int CW_TMO = 0, CW_BAR = 4096, CW_CNT = 16384;
constexpr size_t WS_MODP = CTL_BYTES;
constexpr size_t WS_MOD = WS_MODP + al256((size_t)8 * 2 * 5 * 12288 * 4);
constexpr size_t WS_ROPE = WS_MOD + al256((size_t)2 * 5 * 12288 * 4);
constexpr size_t WS_AGG = WS_ROPE + al256(64 * 16 * 8);
constexpr size_t WS_CARRY = WS_AGG + al256((size_t)2 * 4 * NCHUNK * 1024 * 8);
constexpr size_t WS_TOKE = WS_CARRY + al256((size_t)2 * 4 * NCHUNK * 1024 * 4);
constexpr size_t WS_TOKW = WS_TOKE + al256((size_t)NTOK * 8);
constexpr size_t WS_TOKP = WS_TOKW + al256((size_t)NTOK * 8);
constexpr size_t WS_TOKS = WS_TOKP + al256((size_t)NTOK * 8);
constexpr size_t WS_SLOTTOK = WS_TOKS + al256((size_t)NTOK * 8);
constexpr size_t WS_WIN = al256(WS_SLOTTOK + (size_t)MAXSLOT * 4);
constexpr size_t WS_WOUT0 = WS_WIN + (size_t)ABINP * DM * 2;
constexpr size_t WS_WUQ = WS_WOUT0 + (size_t)DM * DM * 2;
constexpr size_t WS_WUKV = WS_WUQ + (size_t)1536 * 512 * 2;
constexpr size_t WS_WG = WS_WUKV + (size_t)2048 * 512 * 2;
constexpr size_t WS_WQKV = WS_WG + (size_t)4 * 8 * 128 * 128 * 2;
constexpr size_t WS_WOUT1 = WS_WQKV + (size_t)6144 * DM * 2;
#ifndef MOE_FP8
#define MOE_FP8 1
#endif
constexpr int DEP = 1536;
#if MOE_FP8
constexpr size_t W1_E = (size_t)2816 * DM, W2_E = (size_t)DM * DEP;
constexpr int ACT_LD = DEP, ACT_ES = 1;
#else
constexpr size_t W1_E = (size_t)2816 * DM * 2, W2_E = (size_t)DM * DE * 2;
constexpr int ACT_LD = DE, ACT_ES = 2;
#endif
constexpr size_t WS_W1 = WS_WOUT1 + (size_t)DM * DM * 2;
constexpr size_t WS_W2 = WS_W1 + 2 * 17 * W1_E;
constexpr size_t WS_XA = WS_W2 + 2 * 17 * W2_E;
constexpr size_t XBYTES = (size_t)NTOK * DM * 4;
constexpr size_t WS_XB = WS_XA + XBYTES;
constexpr size_t WS_H = WS_XB + XBYTES;
constexpr size_t WS_D = WS_H + (size_t)NTOK * DM * 2;
constexpr size_t WS_U = WS_D;
constexpr size_t WS_AB = WS_U + al256((size_t)NTOK * ABIN * 2);
constexpr size_t ABSZ = (size_t)NTOK * DRNN * 4;
constexpr size_t WS_CQN = WS_AB + 4 * ABSZ;
constexpr size_t WS_CKVN = WS_CQN + (size_t)NTOK * 512 * 2;
constexpr size_t WS_YC = WS_CKVN + (size_t)NTOK * 512 * 2;
constexpr size_t WS_D_END0 = WS_YC + (size_t)NTOK * DM * 2;
constexpr size_t WS_QRAW = WS_XA;
constexpr size_t WS_KVRAW = WS_QRAW + al256((size_t)NTOK * 1536 * 2);
constexpr size_t WS_QF = WS_XB;
constexpr size_t WS_KF = WS_QF + al256((size_t)NTOK * 1536 * 2);
static_assert(WS_KVRAW + (size_t)NTOK * 2048 * 2 <= WS_XB && WS_KF + (size_t)NTOK * 1536 * 2 <= WS_H, "mixer overlays");
constexpr size_t WS_ACT = WS_D;
constexpr size_t WS_Y = WS_ACT + al256((size_t)MAXSLOT * ACT_LD * ACT_ES);
constexpr size_t WS_D_END1 = WS_Y + (size_t)MAXSLOT * DM * 2;
constexpr size_t WS_QKV = WS_D;
constexpr size_t WS_ATT2 = WS_QKV + (size_t)NTOK * 6144 * 2;
constexpr size_t WS_D_END2 = WS_ATT2 + (size_t)NTOK * DM * 2;
constexpr size_t WS_END = (WS_D_END0 > WS_D_END1 ? (WS_D_END0 > WS_D_END2 ? WS_D_END0 : WS_D_END2) : (WS_D_END1 > WS_D_END2 ? WS_D_END1 : WS_D_END2));

constexpr int RING_BYTES = 131072;
constexpr int MISC_OFF = RING_BYTES;
constexpr int LDS_BYTES = 147456;
constexpr int NWAVES = 8, NTHR = 512;

__device__ __forceinline__ unsigned f2bf(float f) { unsigned u = __builtin_bit_cast(unsigned, f); return (u + 0x7fffu + ((u >> 16) & 1u)) >> 16; }
__device__ __forceinline__ unsigned pk2(float lo, float hi) { return f2bf(lo) | (f2bf(hi) << 16); }
__device__ __forceinline__ float bf2f(unsigned short b) { return __builtin_bit_cast(float, (unsigned)b << 16); }
__device__ __forceinline__ float bflo(unsigned w) { return __builtin_bit_cast(float, w << 16); }
__device__ __forceinline__ float bfhi(unsigned w) { return __builtin_bit_cast(float, w & 0xffff0000u); }
__device__ __forceinline__ unsigned cvt_pk_bf16(float lo, float hi) { unsigned r; asm volatile("v_cvt_pk_bf16_f32 %0, %1, %2" : "=v"(r) : "v"(lo), "v"(hi)); return r; }
__device__ __forceinline__ unsigned pk4_fp8(float a, float b, float c, float d) { int w = 0; w = __builtin_amdgcn_cvt_pk_fp8_f32(a, b, w, false); w = __builtin_amdgcn_cvt_pk_fp8_f32(c, d, w, true); return (unsigned)w; }
__device__ __forceinline__ float wave_sum(float v) {
#pragma unroll
    for (int o = 1; o < 64; o <<= 1) v += __shfl_xor(v, o);
    return v;
}
__device__ __forceinline__ float sigmoidf_(float x) { return 1.0f / (1.0f + __expf(-x)); }
__device__ __forceinline__ float gelu_tanh(float x) { const float u = 0.7978845608028654f * (x + 0.044715f * x * x * x); const float th = 1.0f - 2.0f / (1.0f + __expf(2.0f * u)); return 0.5f * x * (1.0f + th); }
__device__ __forceinline__ int vec_of_row(int row) { return row < NCTX ? 4 : (row - NCTX) / SEQ; }

#define XB_TMO      128
#define XB_XCNT(j)  (256  + 64 * (j))
#define XB_XSUB(j)  (1280 + 64 * (j))
#define XB_XGEN(j)  (2304 + 64 * (j))
#define XB_TOP      3328
#define XB_TOPGEN   3392
#define XCD_BAR_WORDS 3456
#define XB_SPIN_CAP (1u << 18)
__device__ __forceinline__ unsigned xb_ld(unsigned* p)              { return __hip_atomic_load(p, __ATOMIC_RELAXED, __HIP_MEMORY_SCOPE_AGENT); }
__device__ __forceinline__ unsigned xb_add(unsigned* p, unsigned v) { return __hip_atomic_fetch_add(p, v, __ATOMIC_RELAXED, __HIP_MEMORY_SCOPE_AGENT); }
__device__ __forceinline__ unsigned xb_xcc_id() { return (unsigned)__builtin_amdgcn_s_getreg((3 << 11) | 20) & 0xFu; }
#define XB_SPIN(cond, bar) do { unsigned _sp = 0; while (cond) { __builtin_amdgcn_s_sleep(1); \
    if ((++_sp & 255u) == 0u) { if (xb_ld(&(bar)[XB_TMO])) break; if (_sp > XB_SPIN_CAP) { atomicAdd(&(bar)[XB_TMO], 1u); break; } } } } while (0)
struct XcdBarrier { unsigned* bar; unsigned x; volatile LAS unsigned* st; };
__device__ __forceinline__ XcdBarrier xcd_barrier_post(unsigned* bar, volatile LAS unsigned* st) {
    XcdBarrier b; b.bar = bar; b.x = xb_xcc_id(); b.st = st;
    if (threadIdx.x == 0) (void)xb_add(&bar[XB_XCNT(b.x)], 1u);
    return b;
}
__device__ __forceinline__ void xcd_barrier_complete(unsigned* bar, unsigned x, unsigned& nloc, unsigned& nx) {
    const unsigned G = gridDim.x * gridDim.y * gridDim.z;
    unsigned sum, cnt, mine, sp = 0u;
    for (;;) {
        sum = 0u; cnt = 0u; mine = 0u;
#pragma unroll
        for (unsigned j = 0; j < 16; ++j) { const unsigned c = xb_ld(&bar[XB_XCNT(j)]); sum += c; cnt += (c > 0u) ? 1u : 0u; mine = (j == x) ? c : mine; }
        if (sum == G) break;
        __builtin_amdgcn_s_sleep(1);
        if ((++sp & 255u) == 0u) { if (xb_ld(&bar[XB_TMO])) break; if (sp > XB_SPIN_CAP) { atomicAdd(&bar[XB_TMO], 1u); break; } }
    }
    nloc = mine > 0u ? mine : 1u; nx = cnt > 0u ? cnt : 1u;
}
__device__ __forceinline__ void xcd_barrier(const XcdBarrier& b) {
    asm volatile("s_waitcnt vmcnt(0)" ::: "memory");
    __syncthreads();
    if (threadIdx.x == 0) {
        unsigned* bar = b.bar;
        __builtin_amdgcn_s_waitcnt(0);
        unsigned nloc = b.st[0], nx = b.st[1];
        if (nloc == 0u) { xcd_barrier_complete(bar, b.x, nloc, nx); b.st[0] = nloc; b.st[1] = nx; }
        const unsigned old = xb_add(&bar[XB_XSUB(b.x)], 1u);
        const unsigned gen = old / nloc;
        if (old + 1u == (gen + 1u) * nloc) {
            __builtin_amdgcn_fence(__ATOMIC_RELEASE, "agent");
            asm volatile("s_waitcnt vmcnt(0)" ::: "memory");
            const unsigned og = xb_add(&bar[XB_TOP], 1u);
            const unsigned tg = og / nx;
            if (og + 1u == (tg + 1u) * nx) xb_add(&bar[XB_TOPGEN], 1u);
            else XB_SPIN(xb_ld(&bar[XB_TOPGEN]) == tg, bar);
            __builtin_amdgcn_fence(__ATOMIC_ACQUIRE, "agent");
            xb_add(&bar[XB_XGEN(b.x)], 1u);
            asm volatile("s_waitcnt vmcnt(0)" ::: "memory");
        } else {
            XB_SPIN(xb_ld(&bar[XB_XGEN(b.x)]) == gen, bar);
            __builtin_amdgcn_fence(__ATOMIC_ACQUIRE, "agent");
            asm volatile("s_waitcnt vmcnt(0)" ::: "memory");
        }
    }
    __syncthreads();
}

namespace pg8 {
constexpr int BM = 256, BK = 64, HALF = 128, HTB = HALF * BK * 2, STAGE_BYTES = 8 * HTB, NXCD = 8, WGM = 8;
__device__ __forceinline__ int lds_byte(int r, int c) { const int st = (r >> 4) * 2 + (c >> 5), rr = r & 15, cc = c & 31, ob = rr * 64 + cc * 2; return st * 1024 + (ob ^ (((ob >> 9) & 1) << 5)); }
__device__ __forceinline__ void stage_rc(int b, int& R, int& C) { const int st = b / 1024, sb = b % 1024, swz = sb ^ (((sb >> 9) & 1) << 5); R = (st >> 1) * 16 + swz / 64; C = (st & 1) * 32 + (swz % 64) / 2; }
__device__ __forceinline__ int perm32(int rho) { const int n = rho >> 4, i = rho & 15; return 8 * (i >> 2) + 4 * n + (i & 3); }

__device__ __forceinline__ void dma16(unsigned lds_dst, const void* sbase, unsigned voff) {
    unsigned keep;
    asm volatile("s_mov_b32 %0, m0\n\ts_mov_b32 m0, %3\n\ts_nop 0\n\tglobal_load_lds_dwordx4 %1, %2\n\ts_mov_b32 m0, %0" : "=&s"(keep) : "v"(voff), "s"(sbase), "s"(lds_dst) : "memory");
}
struct Unit {
    const char* ap;
    const char* bp;
    const int* rowmap;
    int arow0;
    int pm, pn, grp;
};
struct TileOrder {
    int nM, nN, nwg, G, c;
    __device__ __forceinline__ void init(int nM_, int nN_, int G_, int c_) { nM = nM_; nN = nN_; nwg = nM * nN; G = G_; c = c_; }
    __device__ __forceinline__ bool tile(int i, int& pm, int& pn) const {
        const long L = (long)i * G + c; if (L >= nwg) return false;
        int wgid = (int)L; { const int q = nwg / NXCD, r = nwg % NXCD, xcd = wgid % NXCD, off = wgid / NXCD; wgid = (xcd < r ? xcd * (q + 1) : r * (q + 1) + (xcd - r) * q) + off; }
        const int nig = WGM * nN, gid = wgid / nig, fm = gid * WGM, gsz = (nM - fm) < WGM ? (nM - fm) : WGM;
        pm = fm + ((wgid % nig) % gsz); pn = (wgid % nig) / gsz; return true;
    }
};
struct DenseSched {
    TileOrder T; const char* A; const char* Bt; size_t tstepB; int row0;
    __device__ __forceinline__ bool next(int i, Unit& u) const {
        int pm, pn; if (!T.tile(i, pm, pn)) return false;
        u.ap = A; u.bp = Bt + (size_t)pn * tstepB; u.rowmap = nullptr; u.arow0 = row0 + pm * BM; u.pm = pm; u.pn = pn; u.grp = 0; return true;
    }
};
struct MoeSched {
    TileOrder T; const char* A; const char* Bt; size_t tstepB, estride; const int* rowmap; const volatile LAS int* tile_e;
    __device__ __forceinline__ bool next(int i, Unit& u) const {
        int pm, pn; if (!T.tile(i, pm, pn)) return false;
        const int e = __builtin_amdgcn_readfirstlane(tile_e[pm]);
        u.ap = A; u.bp = Bt + (size_t)e * estride + (size_t)pn * tstepB; u.rowmap = rowmap; u.arow0 = pm * BM; u.pm = pm; u.pn = pn; u.grp = e; return true;
    }
};

typedef int v8i __attribute__((ext_vector_type(8)));
template <class Epi, class Sched, bool FP8>
__device__ __forceinline__ void gemm_phase(LAS unsigned char* lds, const int rowBytes, const Sched& S, const Epi& E) {
    const int tid = threadIdx.x, wid = __builtin_amdgcn_readfirstlane(tid >> 6), lane = tid & 63, wr = wid >> 2, wc = wid & 3, fr = lane & 15, fq = lane >> 4;
    const int nt = rowBytes / 128;
    int sR[2]; unsigned sC2[2], voffB[2];
#pragma unroll
    for (int i = 0; i < 2; ++i) { int R, C; stage_rc(tid * 16 + i * 8192, R, C); const int Rb = Epi::PERM ? ((R & ~31) + perm32(R & 31)) : R;
        sR[i] = R; sC2[i] = (unsigned)C * 2u; voffB[i] = (unsigned)Rb * (unsigned)rowBytes + (unsigned)C * 2u; }
    const size_t kstep = 128;
    const size_t hstepB = (size_t)HALF * rowBytes;
    const unsigned rowB = (unsigned)rowBytes;
    const unsigned ldsw = (unsigned)wid * 1024u;
    const int aoff = FP8 ? lds_byte(wr * 64 + fr, fq * 16) : lds_byte(wr * 64 + fr, fq * 8), boff = FP8 ? lds_byte(wc * 32 + fr, fq * 16) : lds_byte(wc * 32 + fr, fq * 8);
#define PG8_SA(b, h) (((b) * 2 + (h)) * HTB)
#define PG8_SB(b, h) ((4 + (b) * 2 + (h)) * HTB)
#define PG8_STAGE(bufoff, gbase, voff) do { _Pragma("unroll") for (int _i = 0; _i < 2; ++_i) \
        dma16((unsigned)((bufoff) + _i * 8192) + ldsw, (const void*)(gbase), (voff)[_i]); } while (0)
#define PG8_LDA(dst, b, h) do { if constexpr (FP8) { _Pragma("unroll") for (int m = 0; m < 4; ++m) dst##8[m] = *(const LAS v8i*)(lds + PG8_SA(b, h) + aoff + m * 2048); } \
        else { _Pragma("unroll") for (int m = 0; m < 4; ++m) _Pragma("unroll") for (int k = 0; k < 2; ++k) dst[m][k] = *(const LAS bf16x8*)(lds + PG8_SA(b, h) + aoff + m * 2048 + k * 1024); } } while (0)
#define PG8_LDB(dst, b, h) do { if constexpr (FP8) { _Pragma("unroll") for (int n = 0; n < 2; ++n) dst##8[n] = *(const LAS v8i*)(lds + PG8_SB(b, h) + boff + n * 2048); } \
        else { _Pragma("unroll") for (int n = 0; n < 2; ++n) _Pragma("unroll") for (int k = 0; k < 2; ++k) dst[n][k] = *(const LAS bf16x8*)(lds + PG8_SB(b, h) + boff + n * 2048 + k * 1024); } } while (0)
#define PG8_MMA(ai, bj, At, Bt) do { __builtin_amdgcn_s_setprio(1); \
        if constexpr (FP8) { _Pragma("unroll") for (int m = 0; m < 4; ++m) _Pragma("unroll") for (int n = 0; n < 2; ++n) \
            asm volatile("v_mfma_scale_f32_16x16x128_f8f6f4 %0, %1, %2, %0, %3, %4 op_sel_hi:[0,0,0]" : "+v"(acc[ai][bj][m][n]) : "v"(Bt##8[n]), "v"(At##8[m]), "v"(sclW), "v"(sclA)); } \
        else { _Pragma("unroll") for (int m = 0; m < 4; ++m) _Pragma("unroll") for (int n = 0; n < 2; ++n) _Pragma("unroll") for (int k = 0; k < 2; ++k) \
            acc[ai][bj][m][n] = __builtin_amdgcn_mfma_f32_16x16x32_bf16(Bt[n][k], At[m][k], acc[ai][bj][m][n], 0, 0, 0); } \
        __builtin_amdgcn_s_setprio(0); } while (0)
#define PG8_WAIT_V(n) asm volatile("s_waitcnt vmcnt(" #n ")" ::: "memory")
#define PG8_WAIT_L(n) asm volatile("s_waitcnt lgkmcnt(" #n ")" ::: "memory")
#define PG8_BAR __builtin_amdgcn_s_barrier()
#define PG8_SCHED __builtin_amdgcn_sched_barrier(0)
#define PG8_MKOFF(u, o0, o1) do { _Pragma("unroll") for (int _i = 0; _i < 2; ++_i) { const int _r0 = (u).arow0 + sR[_i], _r1 = _r0 + HALF; \
        const int _g0 = (u).rowmap ? (u).rowmap[_r0] : _r0, _g1 = (u).rowmap ? (u).rowmap[_r1] : _r1; \
        o0[_i] = (unsigned)_g0 * rowB + sC2[_i]; o1[_i] = (unsigned)_g1 * rowB + sC2[_i]; } } while (0)
    Unit cur, nxt; int ui = 0;
    if (!S.next(0, cur)) return;
    f32x4 acc[2][2][4][2];
#pragma unroll
    for (int a = 0; a < 2; ++a)
#pragma unroll
        for (int b = 0; b < 2; ++b)
#pragma unroll
            for (int m = 0; m < 4; ++m)
#pragma unroll
                for (int n = 0; n < 2; ++n) acc[a][b][m][n] = (f32x4){0.f, 0.f, 0.f, 0.f};
    bf16x8 At[4][2], B0[2][2], B1[2][2]; v8i At8[4], B08[2], B18[2];
    const unsigned sclW = 0x79797979u, sclA = 0x7f7f7f7fu;
    unsigned oc0[2], oc1[2], on0[2], on1[2];
    PG8_MKOFF(cur, oc0, oc1);
    on0[0] = oc0[0]; on0[1] = oc0[1]; on1[0] = oc1[0]; on1[1] = oc1[1];
    const char* cA = cur.ap; const char* cB = cur.bp;
    PG8_STAGE(PG8_SB(0, 0), cB, voffB); PG8_STAGE(PG8_SB(0, 1), cB + hstepB, voffB); PG8_STAGE(PG8_SA(0, 0), cA, oc0); PG8_STAGE(PG8_SA(0, 1), cA, oc1);
    if (wr == 1) PG8_BAR;
    PG8_WAIT_V(2); PG8_BAR;
    PG8_STAGE(PG8_SB(1, 0), cB + kstep, voffB); PG8_STAGE(PG8_SA(1, 0), cA + kstep, oc0); PG8_STAGE(PG8_SB(1, 1), cB + hstepB + kstep, voffB);
    PG8_WAIT_V(6); PG8_BAR;
    for (;;) {
        const bool has_next = S.next(ui + 1, nxt);
        const char* nA = has_next ? nxt.ap : cA; const char* nB = has_next ? nxt.bp : cB;
        for (int t = 0; t < nt; t += 2) {
            const bool last = (t == nt - 2);
            if (last && has_next) { PG8_MKOFF(nxt, on0, on1); }
            const char* a1 = cA + (size_t)(t + 1) * kstep;
            const char* a2 = last ? nA : cA + (size_t)(t + 2) * kstep; const char* b2 = last ? nB : cB + (size_t)(t + 2) * kstep;
            const char* a3 = a2 + kstep; const char* b3 = b2 + kstep;
            unsigned o20[2], o21[2];
            o20[0] = last ? on0[0] : oc0[0]; o20[1] = last ? on0[1] : oc0[1]; o21[0] = last ? on1[0] : oc1[0]; o21[1] = last ? on1[1] : oc1[1];
            PG8_LDB(B0, 0, 0); PG8_LDB(B1, 0, 1); PG8_SCHED; PG8_LDA(At, 0, 0); PG8_STAGE(PG8_SA(1, 1), a1, oc1);
            PG8_WAIT_V(8); PG8_WAIT_L(0); PG8_BAR; PG8_MMA(0, 0, At, B0); PG8_MMA(0, 1, At, B1); PG8_BAR; PG8_SCHED;
            PG8_LDA(At, 0, 1); PG8_STAGE(PG8_SB(0, 0), b2, voffB); PG8_STAGE(PG8_SB(0, 1), b2 + hstepB, voffB); PG8_STAGE(PG8_SA(0, 0), a2, o20);
            PG8_WAIT_V(8); PG8_WAIT_L(0); PG8_BAR; PG8_MMA(1, 0, At, B0); PG8_MMA(1, 1, At, B1); PG8_BAR; PG8_SCHED;
            PG8_LDB(B0, 1, 0); PG8_LDB(B1, 1, 1); PG8_SCHED; PG8_LDA(At, 1, 0); PG8_STAGE(PG8_SA(0, 1), a2, o21);
            PG8_WAIT_V(8); PG8_WAIT_L(0); PG8_BAR; PG8_MMA(0, 0, At, B0); PG8_MMA(0, 1, At, B1); PG8_BAR; PG8_SCHED;
            PG8_LDA(At, 1, 1); PG8_STAGE(PG8_SB(1, 0), b3, voffB); PG8_STAGE(PG8_SB(1, 1), b3 + hstepB, voffB); PG8_STAGE(PG8_SA(1, 0), a3, o20);
            PG8_WAIT_V(8); PG8_WAIT_L(0); PG8_BAR; PG8_MMA(1, 0, At, B0); PG8_MMA(1, 1, At, B1); PG8_BAR; PG8_SCHED;
        }
        if (wr == 0) PG8_BAR;
        if constexpr (FP8) asm volatile("s_nop 15\n\ts_nop 15" ::: "memory");
        E(acc, cur, wr, wc, fr, fq);
        if (!has_next) break;
#pragma unroll
        for (int a = 0; a < 2; ++a)
#pragma unroll
            for (int b = 0; b < 2; ++b)
#pragma unroll
                for (int m = 0; m < 4; ++m)
#pragma unroll
                    for (int n = 0; n < 2; ++n) acc[a][b][m][n] = (f32x4){0.f, 0.f, 0.f, 0.f};
        cur = nxt; cA = nA; cB = nB; ++ui;
        oc0[0] = on0[0]; oc0[1] = on0[1]; oc1[0] = on1[0]; oc1[1] = on1[1];
        if (wr == 1) PG8_BAR;
    }
    PG8_WAIT_V(0);
    PG8_BAR;
#undef PG8_SA
#undef PG8_SB
#undef PG8_STAGE
#undef PG8_LDA
#undef PG8_LDB
#undef PG8_MMA
#undef PG8_WAIT_V
#undef PG8_WAIT_L
#undef PG8_BAR
#undef PG8_SCHED
#undef PG8_MKOFF
}
}

struct Params { const float* in[36]; float* out; unsigned char* ws; int ph_lo, ph_hi; };
enum { I_X = 0, I_C, I_CTX, I_CCTX, I_ADAW, I_ADAB, I_NMIXG, I_NFFNG, I_ABWIN, I_ABWOUT, I_CONVW, I_CONVB, I_LWA, I_LBA, I_LWI, I_LBI, I_LAM,
       I_QNG, I_WUQ, I_KVNG, I_WUKV, I_QHG, I_KHG, I_NAWQKV, I_NAWOUT, I_NAQHG, I_NAKHG, I_RPB, I_RW, I_RB, I_MWG, I_MWU, I_MWD, I_MSG, I_MSU, I_MSD };

using pg8::Unit;
struct EpiU {
    static constexpr bool PERM = true;
    bf16* U;
    __device__ __forceinline__ void operator()(const f32x4 (&acc)[2][2][4][2], const Unit& u, int wr, int wc, int fr, int fq) const {
        const int row0 = u.pm * 256 + wr * 64 + fr, col0 = u.pn * 256 + wc * 32 + 8 * fq;
        const bool gel = (u.pn >= 4 && u.pn < 8);
#pragma unroll
        for (int ai = 0; ai < 2; ++ai)
#pragma unroll
            for (int m = 0; m < 4; ++m) { bf16* rowp = U + (size_t)(row0 + ai * 128 + m * 16) * ABIN + col0;
#pragma unroll
                for (int bj = 0; bj < 2; ++bj) { if (col0 + bj * 128 >= ABIN) continue;
                    f32x4 v0 = acc[ai][bj][m][0], v1 = acc[ai][bj][m][1];
                    if (gel) {
#pragma unroll
                        for (int j = 0; j < 4; ++j) { v0[j] = gelu_tanh(v0[j]); v1[j] = gelu_tanh(v1[j]); } }
                    u32x4 w; w.x = cvt_pk_bf16(v0[0], v0[1]); w.y = cvt_pk_bf16(v0[2], v0[3]); w.z = cvt_pk_bf16(v1[0], v1[1]); w.w = cvt_pk_bf16(v1[2], v1[3]);
                    *(u32x4*)(rowp + bj * 128) = w; } }
    }
};
struct EpiBf {
    static constexpr bool PERM = true;
    bf16* O; int ldc;
    __device__ __forceinline__ void operator()(const f32x4 (&acc)[2][2][4][2], const Unit& u, int wr, int wc, int fr, int fq) const {
        const int row0 = u.pm * 256 + wr * 64 + fr, col0 = u.pn * 256 + wc * 32 + 8 * fq;
#pragma unroll
        for (int ai = 0; ai < 2; ++ai)
#pragma unroll
            for (int m = 0; m < 4; ++m) { bf16* rowp = O + (size_t)(row0 + ai * 128 + m * 16) * ldc + col0;
#pragma unroll
                for (int bj = 0; bj < 2; ++bj) { const f32x4 v0 = acc[ai][bj][m][0], v1 = acc[ai][bj][m][1];
                    u32x4 w; w.x = cvt_pk_bf16(v0[0], v0[1]); w.y = cvt_pk_bf16(v0[2], v0[3]); w.z = cvt_pk_bf16(v1[0], v1[1]); w.w = cvt_pk_bf16(v1[2], v1[3]);
                    *(u32x4*)(rowp + bj * 128) = w; } }
    }
};
struct EpiRes {
    static constexpr bool PERM = false;
    const float* xin_ctx; const float* xin_lat;
    float* xout; const float* gate; int row0;
    __device__ __forceinline__ void operator()(const f32x4 (&acc)[2][2][4][2], const Unit& u, int wr, int wc, int fr, int fq) const {
        const int r0 = row0 + u.pm * 256 + wr * 64 + fr, col0 = u.pn * 256 + wc * 32 + 4 * fq;
        const int v = vec_of_row(row0 + u.pm * 256);
        f32x4 g[2][2];
#pragma unroll
        for (int bj = 0; bj < 2; ++bj)
#pragma unroll
            for (int n = 0; n < 2; ++n) g[bj][n] = *(const f32x4*)(gate + (size_t)v * 12288 + col0 + bj * 128 + n * 16);
#pragma unroll
        for (int ai = 0; ai < 2; ++ai)
#pragma unroll
            for (int m = 0; m < 4; ++m) { const int row = r0 + ai * 128 + m * 16;
                const float* xi = (row < NCTX ? xin_ctx + (size_t)row * DM : xin_lat + (size_t)(row - NCTX) * DM) + col0; float* xo = xout + (size_t)row * DM + col0;
#pragma unroll
                for (int bj = 0; bj < 2; ++bj)
#pragma unroll
                    for (int n = 0; n < 2; ++n) { const f32x4 xv = *(const f32x4*)(xi + bj * 128 + n * 16); *(f32x4*)(xo + bj * 128 + n * 16) = xv + g[bj][n] * acc[ai][bj][m][n]; } }
    }
};
struct EpiSwiglu {
    static constexpr bool PERM = true;
    bf16* ACT;
    __device__ __forceinline__ void operator()(const f32x4 (&acc)[2][2][4][2], const Unit& u, int wr, int wc, int fr, int fq) const {
        const int row0 = u.pm * 256 + wr * 64 + fr, col0 = u.pn * 128 + wc * 32 + 8 * fq;
#pragma unroll
        for (int ai = 0; ai < 2; ++ai)
#pragma unroll
            for (int m = 0; m < 4; ++m) { bf16* rowp = ACT + (size_t)(row0 + ai * 128 + m * 16) * DE + col0;
                float o[8];
#pragma unroll
                for (int n = 0; n < 2; ++n)
#pragma unroll
                    for (int j = 0; j < 4; ++j) { const float gv = acc[ai][0][m][n][j], uv = acc[ai][1][m][n][j]; o[n * 4 + j] = gv / (1.0f + __expf(-gv)) * uv; }
                u32x4 w; w.x = cvt_pk_bf16(o[0], o[1]); w.y = cvt_pk_bf16(o[2], o[3]); w.z = cvt_pk_bf16(o[4], o[5]); w.w = cvt_pk_bf16(o[6], o[7]);
                *(u32x4*)rowp = w; }
    }
};

struct EpiSwiglu8 {
    static constexpr bool PERM = true;
    unsigned char* ACT;
    __device__ __forceinline__ void operator()(const f32x4 (&acc)[2][2][4][2], const Unit& u, int wr, int wc, int fr, int fq) const {
        const int row0 = u.pm * 256 + wr * 64 + fr, col0 = u.pn * 128 + wc * 32 + 8 * fq;
#pragma unroll
        for (int ai = 0; ai < 2; ++ai)
#pragma unroll
            for (int m = 0; m < 4; ++m) { unsigned char* rowp = ACT + (size_t)(row0 + ai * 128 + m * 16) * DEP + col0;
                float o[8];
#pragma unroll
                for (int n = 0; n < 2; ++n)
#pragma unroll
                    for (int j = 0; j < 4; ++j) { const float gv = acc[ai][0][m][n][j], uv = acc[ai][1][m][n][j]; o[n * 4 + j] = gv / (1.0f + __expf(-gv)) * uv; }
                u32x2 w; w.x = pk4_fp8(o[0], o[1], o[2], o[3]); w.y = pk4_fp8(o[4], o[5], o[6], o[7]);
                *(u32x2*)rowp = w;
                if (u.pn == 10) *(u32x2*)(rowp + 128) = (u32x2){0u, 0u}; }
    }
};

struct Frame {
    LAS unsigned char* lds; volatile LAS unsigned* MISC; unsigned* ctl; unsigned char* ws;
    int tid, lane, wave, vcu, G;
};

__device__ __forceinline__ void xpose_item(const float* W, int ldw, bf16* WT, int ldt, int k0, int n0, int drow0, LAS float* scr, int lane) {
#pragma unroll 8
    for (int i = 0; i < 32; ++i) { const int kk = 2 * i + (lane >> 5); scr[kk * 33 + (lane & 31)] = W[(size_t)(k0 + kk) * ldw + n0 + (lane & 31)]; }
    LDS_WAIT(); asm volatile("" ::: "memory");
    const int c = lane & 7;
#pragma unroll
    for (int j = 0; j < 4; ++j) { const int n = (lane >> 3) + 8 * j; const LAS float* s = scr + (8 * c) * 33 + n;
        u32x4 o; o.x = pk2(s[0 * 33], s[1 * 33]); o.y = pk2(s[2 * 33], s[3 * 33]); o.z = pk2(s[4 * 33], s[5 * 33]); o.w = pk2(s[6 * 33], s[7 * 33]);
        *(u32x4*)(WT + (size_t)(drow0 + n) * ldt + k0 + 8 * c) = o; }
    LDS_WAIT(); asm volatile("" ::: "memory");
}
__device__ __forceinline__ void xpose_job(const float* W, int K, int N, bf16* WT, int r, LAS float* scr, int lane) {
    const int nblk = N / 32, kb = r / nblk, nb = r % nblk;
    xpose_item(W, N, WT, K, 64 * kb, 32 * nb, 32 * nb, scr, lane);
}
__device__ __forceinline__ void xpose_item8(const float* W, int ldw, unsigned char* WT, int ldt, int k0, int n0, int drow0, float sc, LAS float* scr, int lane) {
#pragma unroll 8
    for (int i = 0; i < 32; ++i) { const int kk = 2 * i + (lane >> 5); scr[kk * 33 + (lane & 31)] = W[(size_t)(k0 + kk) * ldw + n0 + (lane & 31)]; }
    LDS_WAIT(); asm volatile("" ::: "memory");
    const int c = lane & 3;
#pragma unroll
    for (int j = 0; j < 2; ++j) { const int n = (lane >> 2) + 16 * j; const LAS float* s = scr + (16 * c) * 33 + n;
        u32x4 o; o.x = pk4_fp8(s[0 * 33] * sc, s[1 * 33] * sc, s[2 * 33] * sc, s[3 * 33] * sc); o.y = pk4_fp8(s[4 * 33] * sc, s[5 * 33] * sc, s[6 * 33] * sc, s[7 * 33] * sc);
        o.z = pk4_fp8(s[8 * 33] * sc, s[9 * 33] * sc, s[10 * 33] * sc, s[11 * 33] * sc); o.w = pk4_fp8(s[12 * 33] * sc, s[13 * 33] * sc, s[14 * 33] * sc, s[15 * 33] * sc);
        *(u32x4*)(WT + (size_t)(drow0 + n) * ldt + k0 + 16 * c) = o; }
    LDS_WAIT(); asm volatile("" ::: "memory");
}
__device__ __forceinline__ void p0_prologue(Frame& F, const Params& p) {
    unsigned char* ws = F.ws;
    LAS float* sil = (LAS float*)(F.lds + 69632);
    for (int i = F.tid; i < 5 * DM; i += NTHR) { const int v = i / DM, k = i % DM; const float x = v < 4 ? p.in[I_C][v * DM + k] : p.in[I_CCTX][k]; sil[i] = x / (1.0f + __expf(-x)); }
    { const int gt = blockIdx.x * NTHR + F.tid;
      if (gt < 1024) { const int pos = gt >> 4, i = gt & 15; const float inv = powf(10000.0f, -(float)(2 * i) / 32.0f); const float ang = (float)pos * inv;
          ((f32x2*)(ws + WS_ROPE))[gt] = (f32x2){cosf(ang), sinf(ang)}; } }
    { u32x4* z = (u32x4*)(ws + WS_WIN + (size_t)ABIN * DM * 2); const int n16 = (ABINP - ABIN) * DM * 2 / 16;
      for (int i = blockIdx.x * NTHR + F.tid; i < n16; i += F.G * NTHR) z[i] = (u32x4){0u, 0u, 0u, 0u}; }
    __syncthreads();
    if (F.wave < 3) {
        for (int item = blockIdx.x * 3 + F.wave; item < 768; item += F.G * 3) {
            const int l = item / 384, rem = item % 384, cg = rem >> 3, kc = rem & 7;
            const float* wp = p.in[I_ADAW] + ((size_t)l * DM + kc * 256) * 12288 + cg * 256 + F.lane * 4;
            f32x4 a0 = {0.f, 0.f, 0.f, 0.f}, a1 = a0, a2 = a0, a3 = a0, a4 = a0;
#pragma unroll 8
            for (int kk = 0; kk < 256; ++kk) { const f32x4 w = *(const f32x4*)(wp + (size_t)kk * 12288); const int k = kc * 256 + kk;
                a0 += w * sil[k]; a1 += w * sil[DM + k]; a2 += w * sil[2 * DM + k]; a3 += w * sil[3 * DM + k]; a4 += w * sil[4 * DM + k]; }
            float* o = (float*)(ws + WS_MODP) + ((size_t)(kc * 2 + l) * 5) * 12288 + cg * 256 + F.lane * 4;
            *(f32x4*)(o) = a0; *(f32x4*)(o + 12288) = a1; *(f32x4*)(o + 2 * 12288) = a2; *(f32x4*)(o + 3 * 12288) = a3; *(f32x4*)(o + 4 * 12288) = a4;
        }
    }
    LAS float* scr = (LAS float*)(F.lds + F.wave * 8448);
    const int gw = F.vcu * NWAVES + F.wave, NGW = F.G * NWAVES;
    constexpr int I_WIN = (DM / 64) * (ABIN / 32), I_WO = (DM / 64) * (DM / 32), I_UQ = (512 / 64) * (1536 / 32), I_UKV = (512 / 64) * (2048 / 32);
    constexpr int I_G1 = 8, I_GALL = 32 * I_G1, I_QKV = (DM / 64) * (6144 / 32), I_MOE1 = 1408;
    constexpr int NITEMS = I_WIN + I_WO + I_UQ + I_UKV + I_GALL + I_QKV + I_WO + 102 * I_MOE1;
    for (int it = gw; it < NITEMS; it += NGW) {
        int r = it;
        if (r < I_WIN) { xpose_job(p.in[I_ABWIN], DM, ABIN, (bf16*)(ws + WS_WIN), r, scr, F.lane); continue; } r -= I_WIN;
        if (r < I_WO) { xpose_job(p.in[I_ABWOUT], DM, DM, (bf16*)(ws + WS_WOUT0), r, scr, F.lane); continue; } r -= I_WO;
        if (r < I_UQ) { xpose_job(p.in[I_WUQ], 512, 1536, (bf16*)(ws + WS_WUQ), r, scr, F.lane); continue; } r -= I_UQ;
        if (r < I_UKV) { xpose_job(p.in[I_WUKV], 512, 2048, (bf16*)(ws + WS_WUKV), r, scr, F.lane); continue; } r -= I_UKV;
        if (r < I_GALL) { const int mi = r / I_G1, rr = r % I_G1;
            const int g = mi >> 3, blk = mi & 7, dir = g >> 1, ty = g & 1;
            const float* src = (ty ? p.in[I_LWI] : p.in[I_LWA]) + (size_t)(dir * 8 + blk) * 128 * 128;
            xpose_job(src, 128, 128, (bf16*)(ws + WS_WG) + (size_t)mi * 128 * 128, rr, scr, F.lane); continue; } r -= I_GALL;
        if (r < I_QKV) { xpose_job(p.in[I_NAWQKV], DM, 6144, (bf16*)(ws + WS_WQKV), r, scr, F.lane); continue; } r -= I_QKV;
        if (r < I_WO) { xpose_job(p.in[I_NAWOUT], DM, DM, (bf16*)(ws + WS_WOUT1), r, scr, F.lane); continue; } r -= I_WO;
        { const int m = r / I_MOE1, rr = r % I_MOE1, l = m / 51, mm = m % 51, which = mm / 17, e = mm % 17;
          if (which < 2) {
              const float* src = which == 0 ? (e < 16 ? p.in[I_MWG] + (size_t)(l * 16 + e) * DM * DE : p.in[I_MSG] + (size_t)l * DM * DE)
                                            : (e < 16 ? p.in[I_MWU] + (size_t)(l * 16 + e) * DM * DE : p.in[I_MSU] + (size_t)l * DM * DE);
              const int kb = rr / 44, nb = rr % 44, n0 = 32 * nb;
#if MOE_FP8
              xpose_item8(src, DE, ws + WS_W1 + (size_t)(l * 17 + e) * W1_E, DM, 64 * kb, n0, (n0 / 128) * 256 + (n0 % 128) + (which ? 128 : 0), 64.0f, scr, F.lane);
#else
              xpose_item(src, DE, (bf16*)(ws + WS_W1 + (size_t)(l * 17 + e) * W1_E), DM, 64 * kb, n0, (n0 / 128) * 256 + (n0 % 128) + (which ? 128 : 0), scr, F.lane);
#endif
          } else {
              const float* src = e < 16 ? p.in[I_MWD] + (size_t)(l * 16 + e) * DE * DM : p.in[I_MSD] + (size_t)l * DE * DM;
              const int kb = rr / 64, nb = rr % 64;
#if MOE_FP8
              xpose_item8(src, DM, ws + WS_W2 + (size_t)(l * 17 + e) * W2_E, DEP, 64 * kb, 32 * nb, 32 * nb, 64.0f, scr, F.lane);
#else
              xpose_item(src, DM, (bf16*)(ws + WS_W2 + (size_t)(l * 17 + e) * W2_E), DE, 64 * kb, 32 * nb, 32 * nb, scr, F.lane);
#endif
          } }
    }
#if MOE_FP8
    for (int i = blockIdx.x * NTHR + F.tid; i < 2 * 17 * DM * 8; i += F.G * NTHR) { const int row = i >> 3, c = i & 7; *(u32x4*)(ws + WS_W2 + (size_t)row * DEP + DE + 16 * c) = (u32x4){0u, 0u, 0u, 0u}; }
#endif
}

__device__ __forceinline__ void load_row_f32(const float* xrow, int lane, f32x4 (&v)[8]) {
#pragma unroll
    for (int j = 0; j < 8; ++j) v[j] = *(const f32x4*)(xrow + 4 * lane + 256 * j);
}
__device__ __forceinline__ float row_rstd(const f32x4 (&v)[8]) {
    float s = 0.f;
#pragma unroll
    for (int j = 0; j < 8; ++j) s += (v[j].x * v[j].x + v[j].y * v[j].y) + (v[j].z * v[j].z + v[j].w * v[j].w);
    return rsqrtf(wave_sum(s) * (1.0f / DM) + EPS);
}
__device__ __forceinline__ void store_row_bf16(bf16* orow, int lane, const f32x4 (&h)[8]) {
#pragma unroll
    for (int j = 0; j < 8; ++j) { u32x2 w; w.x = pk2(h[j].x, h[j].y); w.y = pk2(h[j].z, h[j].w); *(u32x2*)(orow + 4 * lane + 256 * j) = w; }
}
__device__ __forceinline__ void p1_modulate0(Frame& F, const Params& p) {
    unsigned char* ws = F.ws;
    const float* modp = (const float*)(ws + WS_MODP);
    { float* mod = (float*)(ws + WS_MOD);
      for (int i = blockIdx.x * NTHR + F.tid; i < 2 * 5 * 12288; i += F.G * NTHR) { const int l = i / (5 * 12288), n = i % 12288; float s = p.in[I_ADAB][l * 12288 + n];
#pragma unroll
          for (int kc = 0; kc < 8; ++kc) s += modp[(size_t)kc * (2 * 5 * 12288) + i];
          mod[i] = s; } }
    LAS float* gs = (LAS float*)F.lds; LAS float* sh = gs + DM;
    for (int g = blockIdx.x; g < NTOK / 64; g += F.G) {
        const int row0 = 64 * g, v = vec_of_row(row0);
        for (int n = F.tid; n < DM; n += NTHR) { float sc = p.in[I_ADAB][DM + n], sf = p.in[I_ADAB][n];
#pragma unroll
            for (int kc = 0; kc < 8; ++kc) { const float* mp = modp + ((size_t)(kc * 2 + 0) * 5 + v) * 12288; sf += mp[n]; sc += mp[DM + n]; }
            gs[n] = p.in[I_NMIXG][n] * (1.0f + sc); sh[n] = sf; }
        __syncthreads();
        for (int i = 0; i < 8; ++i) { const int row = row0 + F.wave + 8 * i;
            const float* xr = row < NCTX ? p.in[I_CTX] + (size_t)row * DM : p.in[I_X] + (size_t)(row - NCTX) * DM;
            f32x4 x[8]; load_row_f32(xr, F.lane, x); const float rstd = row_rstd(x);
#pragma unroll
            for (int j = 0; j < 8; ++j) { const f32x4 gg = *(const LAS f32x4*)(gs + 4 * F.lane + 256 * j), ss = *(const LAS f32x4*)(sh + 4 * F.lane + 256 * j); x[j] = x[j] * rstd * gg + ss; }
            store_row_bf16((bf16*)(ws + WS_H) + (size_t)row * DM, F.lane, x); }
        __syncthreads();
    }
}

__device__ __forceinline__ void p3_rank_norms(Frame& F, const Params& p) {
    const bf16* U = (const bf16*)(F.ws + WS_U); bf16* CQN = (bf16*)(F.ws + WS_CQN); bf16* CKVN = (bf16*)(F.ws + WS_CKVN);
    const int gw = blockIdx.x * NWAVES + F.wave, NGW = F.G * NWAVES;
    for (int row = gw; row < NTOK; row += NGW) {
#pragma unroll
        for (int w = 0; w < 2; ++w) {
            const u32x4 v = *(const u32x4*)(U + (size_t)row * ABIN + 2048 + 512 * w + 8 * F.lane);
            float x[8] = {bflo(v.x), bfhi(v.x), bflo(v.y), bfhi(v.y), bflo(v.z), bfhi(v.z), bflo(v.w), bfhi(v.w)};
            float s = 0.f;
#pragma unroll
            for (int j = 0; j < 8; ++j) s += x[j] * x[j];
            const float rstd = rsqrtf(wave_sum(s) * (1.0f / 512.0f) + EPS);
            const float* g = (w ? p.in[I_KVNG] : p.in[I_QNG]) + 8 * F.lane;
            const f32x4 g0 = *(const f32x4*)g, g1 = *(const f32x4*)(g + 4);
            u32x4 o; o.x = pk2(x[0] * rstd * g0.x, x[1] * rstd * g0.y); o.y = pk2(x[2] * rstd * g0.z, x[3] * rstd * g0.w);
            o.z = pk2(x[4] * rstd * g1.x, x[5] * rstd * g1.y); o.w = pk2(x[6] * rstd * g1.z, x[7] * rstd * g1.w);
            *(u32x4*)((w ? CKVN : CQN) + (size_t)row * 512 + 8 * F.lane) = o;
        }
    }
}
__device__ __forceinline__ void p3_conv_gates(Frame& F, const Params& p) {
    const bf16* U = (const bf16*)(F.ws + WS_U);
    float* AB = (float*)(F.ws + WS_AB);
    const bf16* WG = (const bf16*)(F.ws + WS_WG);
    LAS float* xcf = (LAS float*)F.lds;
    LAS unsigned char* xab = F.lds + 64 * 129 * 4;
    const int tid = F.tid, lane = F.lane, w = F.wave;
    for (int item = blockIdx.x; item < (NTOK / 64) * 8; item += F.G) {
        const int tt = item >> 3, n = item & 7;
        int row0, pos0, slen;
        if (tt < 16) { const int b = tt >> 2; pos0 = 64 * (tt & 3); slen = CTXL; row0 = b * CTXL + pos0; }
        else { const int tl = tt - 16, b = tl >> 6; pos0 = 64 * (tl & 63); slen = SEQ; row0 = NCTX + b * SEQ + pos0; }
        { const int i = tid >> 3, cg = tid & 7, ch0 = 128 * n + 16 * cg;
          float accv[16];
#pragma unroll
          for (int c = 0; c < 16; ++c) accv[c] = p.in[I_CONVB][ch0 + c];
#pragma unroll
          for (int j = 0; j < 4; ++j) { const int pos = pos0 + i + j - 2;
              if (pos >= 0 && pos < slen) {
                  const bf16* up = U + (size_t)(row0 + i + j - 2) * ABIN + ch0;
                  const u32x4 v0 = *(const u32x4*)up, v1 = *(const u32x4*)(up + 8);
                  const float x[16] = {bflo(v0.x), bfhi(v0.x), bflo(v0.y), bfhi(v0.y), bflo(v0.z), bfhi(v0.z), bflo(v0.w), bfhi(v0.w),
                                       bflo(v1.x), bfhi(v1.x), bflo(v1.y), bfhi(v1.y), bflo(v1.z), bfhi(v1.z), bflo(v1.w), bfhi(v1.w)};
                  const float* cw = p.in[I_CONVW] + j * DRNN + ch0;
#pragma unroll
                  for (int c = 0; c < 16; ++c) accv[c] += cw[c] * x[c]; } }
#pragma unroll
          for (int c = 0; c < 16; ++c) xcf[i * 129 + 16 * cg + c] = accv[c];
          u32x4 o0, o1; o0.x = pk2(accv[0], accv[1]); o0.y = pk2(accv[2], accv[3]); o0.z = pk2(accv[4], accv[5]); o0.w = pk2(accv[6], accv[7]);
          o1.x = pk2(accv[8], accv[9]); o1.y = pk2(accv[10], accv[11]); o1.z = pk2(accv[12], accv[13]); o1.w = pk2(accv[14], accv[15]);
          *(LAS u32x4*)(xab + i * 272 + 32 * cg) = o0; *(LAS u32x4*)(xab + i * 272 + 32 * cg + 16) = o1; }
        __syncthreads();
        bf16x8 af[4][4];
#pragma unroll
        for (int m = 0; m < 4; ++m)
#pragma unroll
            for (int ks = 0; ks < 4; ++ks) af[m][ks] = *(const LAS bf16x8*)(xab + (16 * m + (lane & 15)) * 272 + (32 * ks + 8 * (lane >> 4)) * 2);
        const int chl = 16 * w + (lane & 15), gch = 128 * n + chl;
#pragma unroll
        for (int d = 0; d < 2; ++d) {
            f32x4 ca[4], ci[4];
#pragma unroll
            for (int m = 0; m < 4; ++m) { ca[m] = (f32x4){0.f, 0.f, 0.f, 0.f}; ci[m] = ca[m]; }
#pragma unroll
            for (int ks = 0; ks < 4; ++ks) {
                const bf16x8 ba = *(const bf16x8*)(WG + ((size_t)((2 * d + 0) * 8 + n) * 128 + chl) * 128 + 32 * ks + 8 * (lane >> 4));
                const bf16x8 bi = *(const bf16x8*)(WG + ((size_t)((2 * d + 1) * 8 + n) * 128 + chl) * 128 + 32 * ks + 8 * (lane >> 4));
#pragma unroll
                for (int m = 0; m < 4; ++m) { ca[m] = __builtin_amdgcn_mfma_f32_16x16x32_bf16(af[m][ks], ba, ca[m], 0, 0, 0); ci[m] = __builtin_amdgcn_mfma_f32_16x16x32_bf16(af[m][ks], bi, ci[m], 0, 0, 0); }
            }
            const float ba_ = p.in[I_LBA][d * DRNN + gch], bi_ = p.in[I_LBI][d * DRNN + gch], lam = p.in[I_LAM][d * DRNN + gch];
            const float sp = log1pf(expf(-lam));
            float* Ao = AB + (size_t)(2 * d) * NTOK * DRNN; float* Bo = AB + (size_t)(2 * d + 1) * NTOK * DRNN;
#pragma unroll
            for (int m = 0; m < 4; ++m)
#pragma unroll
                for (int r = 0; r < 4; ++r) { const int i = 16 * m + 4 * (lane >> 4) + r;
                    const float rg = 1.0f / (1.0f + expf(-(ca[m][r] + ba_))), ig = 1.0f / (1.0f + expf(-(ci[m][r] + bi_)));
                    const float la = -8.0f * rg * sp; const float a = expf(la); const float bb = sqrtf(-expm1f(2.0f * la)) * ig * xcf[i * 129 + chl];
                    Ao[(size_t)(row0 + i) * DRNN + gch] = a; Bo[(size_t)(row0 + i) * DRNN + gch] = bb; }
        }
        __syncthreads();
    }
}
__device__ __forceinline__ int scan_row(int dir, int b, int c, int i) {
    if (dir == 0) return c < 4 ? b * CTXL + 64 * c + i : NCTX + b * SEQ + 64 * (c - 4) + i;
    return c < 4 ? b * CTXL + 255 - 64 * c - i : NCTX + b * SEQ + 4095 - 64 * (c - 4) - i;
}
__device__ __forceinline__ void scan_pass_b(Frame& F) {
    const float* AB = (const float*)(F.ws + WS_AB); f32x2* AGG = (f32x2*)(F.ws + WS_AGG);
    for (int item = blockIdx.x; item < 2 * NB * NCHUNK * 2; item += F.G) {
        const int half = item & 1, rest = item >> 1, c = rest % NCHUNK, db = rest / NCHUNK, b = db & 3, dir = db >> 2;
        const int ch = half * 512 + F.tid;
        const float* Ap = AB + (size_t)(2 * dir) * NTOK * DRNN + ch; const float* Bp = AB + (size_t)(2 * dir + 1) * NTOK * DRNN + ch;
        float A = 1.0f, Hc = 0.0f;
#pragma unroll 8
        for (int i = 0; i < 64; ++i) { const size_t r = (size_t)scan_row(dir, b, c, i) * DRNN; const float a = Ap[r], bb = Bp[r]; Hc = a * Hc + bb; A *= a; }
        AGG[((size_t)(dir * NB + b) * NCHUNK + c) * DRNN + ch] = (f32x2){A, Hc};
    }
}
__device__ __forceinline__ void scan_pass_c(Frame& F) {
    const f32x2* AGG = (const f32x2*)(F.ws + WS_AGG); float* CAR = (float*)(F.ws + WS_CARRY);
    for (int t = blockIdx.x * NTHR + F.tid; t < 2 * NB * DRNN; t += F.G * NTHR) {
        const int ch = t % DRNN, db = t / DRNN;
        float carry = 0.0f;
        for (int c = 0; c < NCHUNK; ++c) { const size_t idx = ((size_t)db * NCHUNK + c) * DRNN + ch; CAR[idx] = carry; const f32x2 ag = AGG[idx]; carry = ag.x * carry + ag.y; }
    }
}
__device__ __forceinline__ void scan_pass_d(Frame& F) {
    const float* AB = (const float*)(F.ws + WS_AB); const float* CAR = (const float*)(F.ws + WS_CARRY);
    const bf16* U = (const bf16*)(F.ws + WS_U); bf16* YC = (bf16*)(F.ws + WS_YC);
    LAS float* hf = (LAS float*)F.lds;
    for (int item = blockIdx.x; item < NB * NCHUNK * 2; item += F.G) {
        const int half = item & 1, rest = item >> 1, pc = rest % NCHUNK, b = rest / NCHUNK;
        const int ch = half * 512 + F.tid;
        const int cb = pc < 4 ? 3 - pc : 71 - pc;
        { const float* Ap = AB + ch; const float* Bp = AB + (size_t)NTOK * DRNN + ch;
          float h = CAR[((size_t)(0 * NB + b) * NCHUNK + pc) * DRNN + ch];
#pragma unroll 8
          for (int i = 0; i < 64; ++i) { const size_t r = (size_t)scan_row(0, b, pc, i) * DRNN; h = Ap[r] * h + Bp[r]; hf[i * 512 + F.tid] = h; } }
        { const float* Ap = AB + (size_t)2 * NTOK * DRNN + ch; const float* Bp = AB + (size_t)3 * NTOK * DRNN + ch;
          float h = CAR[((size_t)(1 * NB + b) * NCHUNK + cb) * DRNN + ch];
#pragma unroll 8
          for (int i = 0; i < 64; ++i) { const int row = scan_row(1, b, cb, i); const size_t r = (size_t)row * DRNN; h = Ap[r] * h + Bp[r];
              const float gate = bf2f(U[(size_t)row * ABIN + DRNN + ch]);
              YC[(size_t)row * DM + ch] = (bf16)f2bf((hf[(63 - i) * 512 + F.tid] + h) * gate); } }
    }
}

__device__ __forceinline__ void p5_mla_finalize(Frame& F, const Params& p) {
    const bf16* QRAW = (const bf16*)(F.ws + WS_QRAW); const bf16* KVRAW = (const bf16*)(F.ws + WS_KVRAW); const bf16* U = (const bf16*)(F.ws + WS_U);
    bf16* QF = (bf16*)(F.ws + WS_QF); bf16* KF = (bf16*)(F.ws + WS_KF);
    const f32x2* rope = (const f32x2*)(F.ws + WS_ROPE);
    const int lane = F.lane;
    const float gq0 = p.in[I_QHG][lane], gq1 = p.in[I_QHG][64 + lane], gq2 = p.in[I_QHG][128 + lane];
    const float gk0 = p.in[I_KHG][lane], gk1 = p.in[I_KHG][64 + lane], gk2 = p.in[I_KHG][128 + lane];
    const float qs = 0.07216878364870322f * LOG2E;
    const int gw = blockIdx.x * NWAVES + F.wave, NGW = F.G * NWAVES;
    for (int row = gw; row < NTOK; row += NGW) {
        const bool lat = row >= NCTX;
        float cs = 1.0f, sn = 0.0f;
        if (lat) { const int t = (row - NCTX) % SEQ; const int pos = (lane < 32) ? (t / GW) : (t % GW); const f32x2 r = rope[pos * 16 + (lane & 15)]; cs = r.x; sn = r.y; }
        const float kr = bf2f(U[(size_t)row * ABIN + 3072 + lane]);
        const float kr2 = kr * kr;
#pragma unroll
        for (int h = 0; h < MH; ++h) {
            { const bf16* q = QRAW + (size_t)row * 1536 + h * MQK;
              const float v0 = bf2f(q[lane]), v1 = bf2f(q[64 + lane]), v2 = bf2f(q[128 + lane]);
              const float rstd = rsqrtf(wave_sum(v0 * v0 + v1 * v1 + v2 * v2) * (1.0f / MQK) + EPS);
              const float o0 = v0 * rstd * gq0, o1 = v1 * rstd * gq1; float o2 = v2 * rstd * gq2;
              const float pr = __shfl_xor(o2, 16);
              if (lat) o2 = (lane & 16) ? (pr * sn + o2 * cs) : (o2 * cs - pr * sn);
              bf16* qo = QF + ((size_t)row * MH + h) * MQK;
              qo[lane] = (bf16)f2bf(o0 * qs); qo[64 + lane] = (bf16)f2bf(o1 * qs); qo[128 + lane] = (bf16)f2bf(o2 * qs); }
            { const bf16* k = KVRAW + (size_t)row * 2048 + h * 256;
              const float v0 = bf2f(k[lane]), v1 = bf2f(k[64 + lane]);
              const float rstd = rsqrtf(wave_sum(v0 * v0 + v1 * v1 + kr2) * (1.0f / MQK) + EPS);
              const float o0 = v0 * rstd * gk0, o1 = v1 * rstd * gk1; float o2 = kr * rstd * gk2;
              const float pr = __shfl_xor(o2, 16);
              if (lat) o2 = (lane & 16) ? (pr * sn + o2 * cs) : (o2 * cs - pr * sn);
              bf16* ko = KF + ((size_t)row * MH + h) * MQK;
              ko[lane] = (bf16)f2bf(o0); ko[64 + lane] = (bf16)f2bf(o1); ko[128 + lane] = (bf16)f2bf(o2); }
        }
    }
}

__device__ __forceinline__ int crow(int r, int hi) { return (r & 3) + 8 * (r >> 2) + 4 * hi; }
__device__ __forceinline__ int v_st(int k, int c) { const int kk = (k & ~0xC) | ((k & 4) << 1) | ((k & 8) >> 1); return ((kk >> 3) * 4 + (c >> 5)) * 512 + ((kk & 7) * 32 + (c & 31)) * 2; }
__device__ __forceinline__ int v_rd_base(int lane) { return ((lane & 3) << 3) | (((lane >> 2) & 3) << 6) | (((lane >> 4) & 1) << 5) | (((lane >> 5) & 1) << 8); }
constexpr int v_rd_off(int d0, int ks, int half) { return d0 * 512 + ks * 4096 + half * 2048; }
template <int OFF> __device__ __forceinline__ s16x4 tr_read(int vb) {
    s16x4 r; asm volatile("ds_read_b64_tr_b16 %0, %1 offset:%2" : "=&v"(r) : "v"(vb), "i"(OFF) : "memory"); return r;
}
template <int D0> __device__ __forceinline__ void pv_one(f32x16& od, int vb, bf16x8 pa0, bf16x8 pa1, bf16x8 pa2, bf16x8 pa3) {
    const s16x4 l0 = tr_read<v_rd_off(D0, 0, 0)>(vb), h0 = tr_read<v_rd_off(D0, 0, 1)>(vb), l1 = tr_read<v_rd_off(D0, 1, 0)>(vb), h1 = tr_read<v_rd_off(D0, 1, 1)>(vb);
    const s16x4 l2 = tr_read<v_rd_off(D0, 2, 0)>(vb), h2 = tr_read<v_rd_off(D0, 2, 1)>(vb), l3 = tr_read<v_rd_off(D0, 3, 0)>(vb), h3 = tr_read<v_rd_off(D0, 3, 1)>(vb);
    asm volatile("s_waitcnt lgkmcnt(0)" ::: "memory"); __builtin_amdgcn_sched_barrier(0);
#define PKV(L, H) (bf16x8){L[0], L[1], L[2], L[3], H[0], H[1], H[2], H[3]}
    od = __builtin_amdgcn_mfma_f32_32x32x16_bf16(pa0, PKV(l0, h0), od, 0, 0, 0);
    od = __builtin_amdgcn_mfma_f32_32x32x16_bf16(pa1, PKV(l1, h1), od, 0, 0, 0);
    od = __builtin_amdgcn_mfma_f32_32x32x16_bf16(pa2, PKV(l2, h2), od, 0, 0, 0);
    od = __builtin_amdgcn_mfma_f32_32x32x16_bf16(pa3, PKV(l3, h3), od, 0, 0, 0);
#undef PKV
}
__device__ __forceinline__ void pv_d0(f32x16* o, int vb, bf16x8 pa0, bf16x8 pa1, bf16x8 pa2, bf16x8 pa3) {
    pv_one<0>(o[0], vb, pa0, pa1, pa2, pa3); pv_one<1>(o[1], vb, pa0, pa1, pa2, pa3); pv_one<2>(o[2], vb, pa0, pa1, pa2, pa3); pv_one<3>(o[3], vb, pa0, pa1, pa2, pa3);
}
__device__ __forceinline__ void pack_p(const f32x16& p0, const f32x16& p1, bf16x8& pa0, bf16x8& pa1, bf16x8& pa2, bf16x8& pa3) {
#define PK4(P, BASE, OUT) do { unsigned a0 = cvt_pk_bf16(P[BASE + 0], P[BASE + 1]), a1 = cvt_pk_bf16(P[BASE + 2], P[BASE + 3]);   \
    unsigned b0 = cvt_pk_bf16(P[BASE + 4], P[BASE + 5]), b1 = cvt_pk_bf16(P[BASE + 6], P[BASE + 7]);                              \
    auto r0 = __builtin_amdgcn_permlane32_swap(a0, b0, false, false); auto r1 = __builtin_amdgcn_permlane32_swap(a1, b1, false, false); \
    u32x4 w = {r0[0], r1[0], r0[1], r1[1]}; OUT = __builtin_bit_cast(bf16x8, w); } while (0)
    PK4(p0, 0, pa0); PK4(p0, 8, pa1); PK4(p1, 0, pa2); PK4(p1, 8, pa3);
#undef PK4
}
template <int DQK> struct AttnG {
    static constexpr int CPR = DQK / 8, KSTR = DQK * 2 + 16, KBYTES = 64 * KSTR, NKCH = (64 * CPR) / 512, ND0 = DQK / 16;
    static constexpr int VOFF = 2 * KBYTES, LIOFF = VOFF + 2 * 16384, END = LIOFF + 8 * 128;
};
template <int DQK> __device__ __forceinline__ void attn_tile_load(bf16x8 (&kreg)[AttnG<DQK>::NKCH], bf16x8 (&vreg)[2], const bf16* kt, int ldk, const bf16* vt, int ldv, int tid) {
    using G = AttnG<DQK>;
#pragma unroll
    for (int i = 0; i < G::NKCH; ++i) { const int q = tid + 512 * i, row = q / G::CPR, ch = q % G::CPR; kreg[i] = *(const bf16x8*)(kt + (size_t)row * ldk + ch * 8); }
    const int sr = tid >> 4, sc = (tid & 15) * 8;
    vreg[0] = *(const bf16x8*)(vt + (size_t)sr * ldv + sc); vreg[1] = *(const bf16x8*)(vt + (size_t)(32 + sr) * ldv + sc);
}
template <int DQK> __device__ __forceinline__ void attn_tile_write(const bf16x8 (&kreg)[AttnG<DQK>::NKCH], const bf16x8 (&vreg)[2], LAS unsigned char* kb, LAS unsigned char* vbuf, int tid) {
    using G = AttnG<DQK>;
#pragma unroll
    for (int i = 0; i < G::NKCH; ++i) { const int q = tid + 512 * i, row = q / G::CPR, ch = q % G::CPR; *(LAS bf16x8*)(kb + row * G::KSTR + ch * 16) = kreg[i]; }
    const int sr = tid >> 4, sc = (tid & 15) * 8;
    *(LAS bf16x8*)(vbuf + v_st(sr, sc)) = vreg[0]; *(LAS bf16x8*)(vbuf + v_st(32 + sr, sc)) = vreg[1];
}
template <int DQK> __device__ __forceinline__ void attn_qkt(f32x16& p0, f32x16& p1, const LAS unsigned char* kb, const bf16x8 (&qr)[AttnG<DQK>::ND0], int r32, int hi) {
    using G = AttnG<DQK>;
#pragma unroll
    for (int r = 0; r < 16; ++r) { p0[r] = 0.f; p1[r] = 0.f; }
#pragma unroll
    for (int d0 = 0; d0 < G::ND0; ++d0) { const int cb = (d0 * 16 + hi * 8) * 2;
        const bf16x8 b0 = *(const LAS bf16x8*)(kb + r32 * G::KSTR + cb);
        const bf16x8 b1 = *(const LAS bf16x8*)(kb + (32 + r32) * G::KSTR + cb);
        p0 = __builtin_amdgcn_mfma_f32_32x32x16_bf16(b0, qr[d0], p0, 0, 0, 0);
        p1 = __builtin_amdgcn_mfma_f32_32x32x16_bf16(b1, qr[d0], p1, 0, 0, 0); }
}
__device__ __forceinline__ void attn_store(const f32x16 (&o)[4], float lsum, LAS float* li, bf16* orow0, int ldo, int r32, int hi) {
    lsum += __shfl_xor(lsum, 32);
    if (hi == 0) li[r32] = lsum;
    LDS_WAIT();
    float rli[16];
#pragma unroll
    for (int r = 0; r < 16; ++r) rli[r] = 1.0f / li[crow(r, hi)];
#pragma unroll
    for (int r = 0; r < 16; ++r) { bf16* op = orow0 + (size_t)crow(r, hi) * ldo + r32;
#pragma unroll
        for (int d0 = 0; d0 < 4; ++d0) op[d0 * 32] = (bf16)f2bf(o[d0][r] * rli[r]); }
    LDS_WAIT();
}

__device__ __forceinline__ void mla_unit(Frame& F, int b, int h, int qrow0, int ntile) {
    using G = AttnG<MQK>;
    const bf16* QF = (const bf16*)(F.ws + WS_QF); const bf16* KF = (const bf16*)(F.ws + WS_KF); const bf16* KVRAW = (const bf16*)(F.ws + WS_KVRAW);
    bf16* YC = (bf16*)(F.ws + WS_YC);
    const int tid = F.tid, lane = F.lane, r32 = lane & 31, hi = lane >> 5, wid = F.wave;
    LAS unsigned char* lds = F.lds;
    LAS float* li = (LAS float*)(lds + G::LIOFF + wid * 128);
    bf16x8 qr[G::ND0];
    { const bf16* qp = QF + ((size_t)(qrow0 + wid * 32 + r32) * MH + h) * MQK + hi * 8;
#pragma unroll
      for (int d0 = 0; d0 < G::ND0; ++d0) qr[d0] = *(const bf16x8*)(qp + d0 * 16); }
    f32x16 o[4];
#pragma unroll
    for (int d = 0; d < 4; ++d)
#pragma unroll
        for (int r = 0; r < 16; ++r) o[d][r] = 0.f;
    float lsum = 0.f;
    const int vb0 = (int)(unsigned)(uintptr_t)(lds + G::VOFF) + v_rd_base(lane);
    bf16x8 kreg[G::NKCH], vreg[2];
#define MLA_TROW(j) ((j) < 4 ? b * CTXL + 64 * (j) : NCTX + b * SEQ + 64 * ((j) - 4))
    { const int tr = MLA_TROW(0); attn_tile_load<MQK>(kreg, vreg, KF + ((size_t)tr * MH + h) * MQK, MH * MQK, KVRAW + (size_t)tr * 2048 + h * 256 + 128, 2048, tid); }
    attn_tile_write<MQK>(kreg, vreg, lds, lds + G::VOFF, tid);
    __syncthreads();
    for (int j = 0; j < ntile; ++j) {
        const int cur = j & 1;
        if (j + 1 < ntile) { const int tr = MLA_TROW(j + 1); attn_tile_load<MQK>(kreg, vreg, KF + ((size_t)tr * MH + h) * MQK, MH * MQK, KVRAW + (size_t)tr * 2048 + h * 256 + 128, 2048, tid); }
        f32x16 p0, p1;
        attn_qkt<MQK>(p0, p1, lds + cur * G::KBYTES, qr, r32, hi);
#pragma unroll
        for (int r = 0; r < 16; ++r) { p0[r] = __builtin_amdgcn_exp2f(p0[r]); p1[r] = __builtin_amdgcn_exp2f(p1[r]); }
        float ps = 0.f;
#pragma unroll
        for (int r = 0; r < 16; ++r) ps += p0[r] + p1[r];
        lsum += ps;
        bf16x8 pa0, pa1, pa2, pa3; pack_p(p0, p1, pa0, pa1, pa2, pa3);
        pv_d0(o, vb0 + cur * 16384, pa0, pa1, pa2, pa3);
        if (j + 1 < ntile) attn_tile_write<MQK>(kreg, vreg, lds + (cur ^ 1) * G::KBYTES, lds + G::VOFF + (cur ^ 1) * 16384, tid);
        __syncthreads();
    }
#undef MLA_TROW
    attn_store(o, lsum, li, YC + (size_t)(qrow0 + wid * 32) * DM + DRNN + h * MV, DM, r32, hi);
    __syncthreads();
}
__device__ __forceinline__ void p6_mla_attention(Frame& F) {
    for (int U = F.vcu; U < 544; U += F.G) {
        int b, h, qrow0, ntile;
        if (U < 512) { const int bh = U >> 4, qb = U & 15; b = bh >> 3; h = bh & 7; qrow0 = NCTX + b * SEQ + qb * 256; ntile = 68; }
        else { const int bh = U - 512; b = bh >> 3; h = bh & 7; qrow0 = b * CTXL; ntile = 4; }
        mla_unit(F, b, h, qrow0, ntile);
    }
}

__device__ __forceinline__ void p15_na_finalize(Frame& F, const Params& p) {
    bf16* QKV = (bf16*)(F.ws + WS_QKV);
    const int lane = F.lane;
    const float gq0 = p.in[I_NAQHG][lane], gq1 = p.in[I_NAQHG][64 + lane], gk0 = p.in[I_NAKHG][lane], gk1 = p.in[I_NAKHG][64 + lane];
    const float qs = 0.08838834764831845f * LOG2E;
    const int gw = blockIdx.x * NWAVES + F.wave, NGW = F.G * NWAVES;
    for (int row = gw; row < NTOK; row += NGW) {
        bf16* rp = QKV + (size_t)row * 6144;
        if (row >= NCTX) {
#pragma unroll 4
            for (int h = 0; h < NAH; ++h) { bf16* q = rp + h * NAD; const float v0 = bf2f(q[lane]), v1 = bf2f(q[64 + lane]);
                const float rstd = rsqrtf(wave_sum(v0 * v0 + v1 * v1) * (1.0f / NAD) + EPS);
                q[lane] = (bf16)f2bf(v0 * rstd * gq0 * qs); q[64 + lane] = (bf16)f2bf(v1 * rstd * gq1 * qs); } }
#pragma unroll 4
        for (int h = 0; h < NAH; ++h) { bf16* k = rp + DM + h * NAD; const float v0 = bf2f(k[lane]), v1 = bf2f(k[64 + lane]);
            const float rstd = rsqrtf(wave_sum(v0 * v0 + v1 * v1) * (1.0f / NAD) + EPS);
            k[lane] = (bf16)f2bf(v0 * rstd * gk0); k[64 + lane] = (bf16)f2bf(v1 * rstd * gk1); }
    }
}
__device__ __forceinline__ void na_unit(Frame& F, const Params& p, int b, int h, int R0) {
    using G = AttnG<NAD>;
    const bf16* QKV = (const bf16*)(F.ws + WS_QKV); bf16* ATT = (bf16*)(F.ws + WS_ATT2);
    const int tid = F.tid, lane = F.lane, r32 = lane & 31, hi = lane >> 5, wid = F.wave;
    LAS unsigned char* lds = F.lds;
    LAS float* li = (LAS float*)(lds + G::LIOFF + wid * 128);
    LAS float* rpbl = (LAS float*)(lds + G::END);
    for (int i = tid; i < 15 * 32; i += NTHR) { const int dr = i >> 5, dc = i & 31; rpbl[i] = dc < 31 ? p.in[I_RPB][(h * 15 + dr) * 31 + dc] * LOG2E : 0.f; }
    const int rq = R0 + (wid >> 1), qc = 32 * (wid & 1) + r32;
    const int qrow = NCTX + b * SEQ + rq * GW + qc;
    bf16x8 qr[G::ND0];
    { const bf16* qp = QKV + (size_t)qrow * 6144 + h * NAD + hi * 8;
#pragma unroll
      for (int d0 = 0; d0 < G::ND0; ++d0) qr[d0] = *(const bf16x8*)(qp + d0 * 16); }
    f32x16 o[4];
#pragma unroll
    for (int d = 0; d < 4; ++d)
#pragma unroll
        for (int r = 0; r < 16; ++r) o[d][r] = 0.f;
    float lsum = 0.f;
    const int vb0 = (int)(unsigned)(uintptr_t)(lds + G::VOFF) + v_rd_base(lane);
    const int klo = min(max(R0 - 4, 0), 56), khi = min(max(R0 + 3 - 4, 0), 56) + 7, nloc = khi - klo + 1, ntile = nloc + 4;
    const int w0 = min(max(rq - 4, 0), 56);
    const int cst = min(max(qc - 8, 0), 48);
    bf16x8 kreg[G::NKCH], vreg[2];
#define NA_TROW(j) ((j) < nloc ? NCTX + b * SEQ + (klo + (j)) * GW : b * CTXL + 64 * ((j) - nloc))
    { const int tr = NA_TROW(0); attn_tile_load<NAD>(kreg, vreg, QKV + (size_t)tr * 6144 + DM + h * NAD, 6144, QKV + (size_t)tr * 6144 + 2 * DM + h * NAD, 6144, tid); }
    attn_tile_write<NAD>(kreg, vreg, lds, lds + G::VOFF, tid);
    __syncthreads();
    for (int j = 0; j < ntile; ++j) {
        const int cur = j & 1;
        if (j + 1 < ntile) { const int tr = NA_TROW(j + 1); attn_tile_load<NAD>(kreg, vreg, QKV + (size_t)tr * 6144 + DM + h * NAD, 6144, QKV + (size_t)tr * 6144 + 2 * DM + h * NAD, 6144, tid); }
        const bool local = j < nloc; const int krow = klo + j;
        if (!local || (krow >= w0 && krow < w0 + 8)) {
            f32x16 p0, p1;
            attn_qkt<NAD>(p0, p1, lds + cur * G::KBYTES, qr, r32, hi);
            if (local) {
                const LAS float* brow = rpbl + (krow - rq + 7) * 32 + (15 - qc);
#pragma unroll
                for (int r = 0; r < 16; ++r) {
                    const int kc0 = crow(r, hi), kc1 = 32 + kc0;
                    const bool ok0 = kc0 >= cst && kc0 < cst + 16, ok1 = kc1 >= cst && kc1 < cst + 16;
                    const float b0 = ok0 ? brow[kc0] : 0.f, b1 = ok1 ? brow[kc1] : 0.f;
                    p0[r] = ok0 ? __builtin_amdgcn_exp2f(p0[r] + b0) : 0.f; p1[r] = ok1 ? __builtin_amdgcn_exp2f(p1[r] + b1) : 0.f; }
            } else {
#pragma unroll
                for (int r = 0; r < 16; ++r) { p0[r] = __builtin_amdgcn_exp2f(p0[r]); p1[r] = __builtin_amdgcn_exp2f(p1[r]); }
            }
            float ps = 0.f;
#pragma unroll
            for (int r = 0; r < 16; ++r) ps += p0[r] + p1[r];
            lsum += ps;
            bf16x8 pa0, pa1, pa2, pa3; pack_p(p0, p1, pa0, pa1, pa2, pa3);
            pv_d0(o, vb0 + cur * 16384, pa0, pa1, pa2, pa3);
        }
        if (j + 1 < ntile) attn_tile_write<NAD>(kreg, vreg, lds + (cur ^ 1) * G::KBYTES, lds + G::VOFF + (cur ^ 1) * 16384, tid);
        __syncthreads();
    }
#undef NA_TROW
    attn_store(o, lsum, li, ATT + (size_t)(NCTX + b * SEQ + rq * GW + 32 * (wid & 1)) * DM + h * NAD, DM, r32, hi);
    __syncthreads();
}
__device__ __forceinline__ void p16_na_attention(Frame& F, const Params& p) {
    for (int rnd = 0; rnd < 4; ++rnd)
        for (int U = rnd * 256 + F.vcu; U < rnd * 256 + 256; U += F.G) { const int bh = U >> 4, rg = U & 15, b = bh >> 4, h = bh & 15; na_unit(F, p, b, h, 4 * rg); }
}

__device__ __forceinline__ void p8_h2_route(Frame& F, const Params& p, int l, const float* X, int rbase) {
    unsigned char* ws = F.ws;
    LAS float* wt = (LAS float*)F.lds;
    for (int i = F.tid; i < DM * NE; i += NTHR) { const int k = i >> 4, e = i & 15; wt[e * DM + k] = p.in[I_RW][i]; }
    volatile LAS unsigned* lcnt = F.MISC + 16; volatile LAS unsigned* lbase = F.MISC + 32;
    LAS int* lrec = (LAS int*)(F.MISC + 64);
    if (F.tid < 16) lcnt[F.tid] = 0u;
    __syncthreads();
    const float* mod = (const float*)(ws + WS_MOD) + (size_t)l * 5 * 12288;
    const float* gn = p.in[I_NFFNG] + l * DM;
    float rb[16];
#pragma unroll
    for (int e = 0; e < 16; ++e) rb[e] = p.in[I_RB][e];
    int it = 0;
    for (int row = rbase + blockIdx.x * NWAVES + F.wave; row < NTOK; row += F.G * NWAVES, ++it) {
        const int v = vec_of_row(row);
        f32x4 x[8]; load_row_f32(X + (size_t)row * DM, F.lane, x); const float rstd = row_rstd(x);
        const float* mv = mod + (size_t)v * 12288;
#pragma unroll
        for (int j = 0; j < 8; ++j) { const int c = 4 * F.lane + 256 * j; const f32x4 g = *(const f32x4*)(gn + c), sc = *(const f32x4*)(mv + 4 * DM + c), sh = *(const f32x4*)(mv + 3 * DM + c);
            x[j] = x[j] * rstd * g * (1.0f + sc) + sh; }
#if MOE_FP8
#pragma unroll
        for (int j = 0; j < 8; ++j) *(unsigned*)(ws + WS_H + (size_t)row * DM + 4 * F.lane + 256 * j) = pk4_fp8(x[j].x, x[j].y, x[j].z, x[j].w);
#else
        store_row_bf16((bf16*)(ws + WS_H) + (size_t)row * DM, F.lane, x);
#endif
        float lg[16];
#pragma unroll
        for (int e = 0; e < 16; ++e) { float s = 0.f;
#pragma unroll
            for (int j = 0; j < 8; ++j) { const f32x4 w = *(const LAS f32x4*)(wt + e * DM + 4 * F.lane + 256 * j); s += (x[j].x * w.x + x[j].y * w.y) + (x[j].z * w.z + x[j].w * w.w); }
            lg[e] = wave_sum(s); }
        float sc[16], sel[16];
#pragma unroll
        for (int e = 0; e < 16; ++e) { sc[e] = 1.0f / (1.0f + expf(-lg[e])); sel[e] = sc[e] + rb[e]; }
        int best = 0; float bestv = -3.0e38f;
#pragma unroll
        for (int g = 0; g < 4; ++g) { float m1 = -3.0e38f, m2 = -3.0e38f;
#pragma unroll
            for (int k = 0; k < 4; ++k) { const float s = sel[4 * g + k]; if (s > m1) { m2 = m1; m1 = s; } else if (s > m2) m2 = s; }
            const float gs = m1 + m2; if (gs > bestv) { bestv = gs; best = g; } }
        int e0 = 0, e1 = 0; float s0 = -3.0e38f, s1 = -3.0e38f, w0 = 0.f, w1 = 0.f;
#pragma unroll
        for (int e = 0; e < 16; ++e) { if ((e >> 2) == best) { const float s = sel[e];
                if (s > s0) { s1 = s0; e1 = e0; w1 = w0; s0 = s; e0 = e; w0 = sc[e]; } else if (s > s1) { s1 = s; e1 = e; w1 = sc[e]; } } }
        const float wn = 1.0f / (w0 + w1);
        if (F.lane == 0) {
            const int lp0 = (int)__hip_atomic_fetch_add((LAS unsigned*)(lcnt + e0), 1u, __ATOMIC_RELAXED, __HIP_MEMORY_SCOPE_WORKGROUP);
            const int lp1 = (int)__hip_atomic_fetch_add((LAS unsigned*)(lcnt + e1), 1u, __ATOMIC_RELAXED, __HIP_MEMORY_SCOPE_WORKGROUP);
            if (it < 64) { LAS int* r = lrec + (F.wave * 64 + it) * 4; r[0] = e0; r[1] = e1; r[2] = lp0; r[3] = lp1; }
            ((int*)(ws + WS_TOKE))[2 * row] = e0; ((int*)(ws + WS_TOKE))[2 * row + 1] = e1;
            ((float*)(ws + WS_TOKW))[2 * row] = w0 * wn; ((float*)(ws + WS_TOKW))[2 * row + 1] = w1 * wn;
        }
    }
    __syncthreads();
    if (F.tid < 16) { const unsigned n = lcnt[F.tid]; lbase[F.tid] = n ? __hip_atomic_fetch_add(F.ctl + CW_CNT + (l * 16 + F.tid) * 64, n, RLX_AGENT) : 0u; }
    __syncthreads();
    if (F.lane == 0) { it = 0;
        for (int row = rbase + blockIdx.x * NWAVES + F.wave; row < NTOK; row += F.G * NWAVES, ++it) { if (it >= 64) break;
            const LAS int* r = lrec + (F.wave * 64 + it) * 4;
            ((int*)(ws + WS_TOKP))[2 * row] = (int)lbase[r[0]] + r[2]; ((int*)(ws + WS_TOKP))[2 * row + 1] = (int)lbase[r[1]] + r[3]; } }
    __syncthreads();
}
__device__ __forceinline__ int moe_tiles(Frame& F, int l, int nsh, volatile LAS int* tile_e, int& ntot) {
    int nt_r = 0;
    if (F.tid == 0) { int t = 0;
        for (int e = 0; e < 16; ++e) { const int c = (int)__hip_atomic_load(F.ctl + CW_CNT + (l * 16 + e) * 64, RLX_AGENT); const int n = (c + 255) >> 8; for (int i = 0; i < n; ++i) tile_e[t++] = e; }
        for (int i = 0; i < nsh; ++i) tile_e[t + i] = 16;
        tile_e[255] = t; }
    __syncthreads();
    nt_r = __builtin_amdgcn_readfirstlane(tile_e[255]); ntot = nt_r + nsh;
    return nt_r;
}
__device__ __forceinline__ void p9_scatter(Frame& F, int l, int rbase) {
    unsigned char* ws = F.ws;
    int off[17]; { int t = 0;
#pragma unroll
        for (int e = 0; e < 16; ++e) { off[e] = t * 256; const int c = (int)__hip_atomic_load(F.ctl + CW_CNT + (l * 16 + e) * 64, RLX_AGENT); t += (c + 255) >> 8; }
        off[16] = t * 256; }
    const int* toke = (const int*)(ws + WS_TOKE); const int* tokp = (const int*)(ws + WS_TOKP); int* toks = (int*)(ws + WS_TOKS); int* slottok = (int*)(ws + WS_SLOTTOK);
    for (int i = blockIdx.x * NTHR + F.tid; i < (NTOK - rbase) * 2; i += F.G * NTHR) { const int row = rbase + (i >> 1), k = i & 1;
        const int e = toke[2 * row + k]; int o = 0;
#pragma unroll
        for (int q = 0; q < 16; ++q) o = (e == q) ? off[q] : o;
        const int slot = o + tokp[2 * row + k]; slottok[slot] = row; toks[2 * row + k] = slot; }
    for (int i = blockIdx.x * NTHR + F.tid; i < NTOK - rbase; i += F.G * NTHR) slottok[off[16] + i] = rbase + i;
    for (int i = blockIdx.x * NTHR + F.tid; i < 16 * 256; i += F.G * NTHR) { const int e = i >> 8, j = i & 255; int o = 0, on = 0;
#pragma unroll
        for (int q = 0; q < 16; ++q) { o = (e == q) ? off[q] : o; on = (e == q) ? off[q + 1] : on; }
        const int c = (int)__hip_atomic_load(F.ctl + CW_CNT + (l * 16 + e) * 64, RLX_AGENT);
        if (o + c + j < on) slottok[o + c + j] = rbase; }
}
__device__ __forceinline__ void p12_combine(Frame& F, const Params& p, int l, const float* Xin, float* Xout, int rbase, int sr_off) {
    unsigned char* ws = F.ws;
    const bf16* Y = (const bf16*)(ws + WS_Y);
    const float* mod = (const float*)(ws + WS_MOD) + (size_t)l * 5 * 12288;
    const int* toks = (const int*)(ws + WS_TOKS); const float* tokw = (const float*)(ws + WS_TOKW);
    for (int row = rbase + blockIdx.x * NWAVES + F.wave; row < NTOK; row += F.G * NWAVES) {
        const int v = vec_of_row(row);
        const int s0 = toks[2 * row], s1 = toks[2 * row + 1]; const float w0 = tokw[2 * row], w1 = tokw[2 * row + 1];
        const bf16* y0 = Y + (size_t)s0 * DM; const bf16* y1 = Y + (size_t)s1 * DM; const bf16* ys = Y + (size_t)(sr_off + row - rbase) * DM;
        const float* g5 = mod + (size_t)v * 12288 + 5 * DM;
        f32x4 x[8];
#pragma unroll
        for (int j = 0; j < 8; ++j) { const int c = 4 * F.lane + 256 * j;
            const f32x4 xi = *(const f32x4*)(Xin + (size_t)row * DM + c), g = *(const f32x4*)(g5 + c);
            const u32x2 a = *(const u32x2*)(ys + c), b0 = *(const u32x2*)(y0 + c), b1 = *(const u32x2*)(y1 + c);
            f32x4 m;
            m.x = bflo(a.x) + w0 * bflo(b0.x) + w1 * bflo(b1.x); m.y = bfhi(a.x) + w0 * bfhi(b0.x) + w1 * bfhi(b1.x);
            m.z = bflo(a.y) + w0 * bflo(b0.y) + w1 * bflo(b1.y); m.w = bfhi(a.y) + w0 * bfhi(b0.y) + w1 * bfhi(b1.y);
            x[j] = xi + g * m; }
        if (l == 0) {
#pragma unroll
            for (int j = 0; j < 8; ++j) *(f32x4*)(Xout + (size_t)row * DM + 4 * F.lane + 256 * j) = x[j];
            const float rstd = row_rstd(x);
            const float* m1 = (const float*)(ws + WS_MOD) + (size_t)(5 + v) * 12288; const float* gn = p.in[I_NMIXG] + DM;
#pragma unroll
            for (int j = 0; j < 8; ++j) { const int c = 4 * F.lane + 256 * j; const f32x4 g = *(const f32x4*)(gn + c), sc = *(const f32x4*)(m1 + DM + c), sh = *(const f32x4*)(m1 + c);
                x[j] = x[j] * rstd * g * (1.0f + sc) + sh; }
            store_row_bf16((bf16*)(ws + WS_H) + (size_t)row * DM, F.lane, x);
        } else {
#pragma unroll
            for (int j = 0; j < 8; ++j) *(f32x4*)(Xout + (size_t)(row - NCTX) * DM + 4 * F.lane + 256 * j) = x[j];
        }
    }
}

constexpr int NPHASE = 22;
__global__ void __launch_bounds__(NTHR, 2) mega_fwd(Params p) {
    extern __shared__ __attribute__((aligned(16))) unsigned char lds_raw[];
    Frame F;
    F.lds = (LAS unsigned char*)lds_raw; F.MISC = (volatile LAS unsigned*)(F.lds + MISC_OFF);
    F.tid = threadIdx.x; F.lane = F.tid & 63; F.wave = __builtin_amdgcn_readfirstlane(F.tid >> 6);
    F.G = gridDim.x; { const int bx = blockIdx.x; F.vcu = (F.G % 8 == 0) ? (bx % 8) * (F.G / 8) + bx / 8 : bx; }
    F.ws = p.ws; F.ctl = (unsigned*)(p.ws + WS_CTL);
    unsigned char* ws = p.ws;
    for (int u = F.tid; u < (LDS_BYTES - MISC_OFF) / 4; u += NTHR) ((LAS unsigned*)(F.lds + MISC_OFF))[u] = 0u;
    __syncthreads();
    const int lo = p.ph_lo, hi = p.ph_hi;
    XcdBarrier bar; bar.bar = F.ctl + CW_BAR; bar.x = 0; bar.st = F.MISC;
    if (hi - lo > 1) bar = xcd_barrier_post(F.ctl + CW_BAR, F.MISC);
#ifdef ONLY_PHASE
#define IN(k) ((k) == ONLY_PHASE && lo <= (k) && (k) < hi)
#else
#define IN(k) (lo <= (k) && (k) < hi)
#endif
#define SEAM(k) do { if (IN(k) && IN((k) + 1)) xcd_barrier(bar); } while (0)
#ifndef PROBE_DUP
#define PROBE_DUP (-1)
#endif
#ifndef PROBE_DUP2
#define PROBE_DUP2 (-1)
#endif
#define REP(k) for (int _rep = 0; _rep < ((PROBE_DUP == (k) || PROBE_DUP2 == (k)) ? 2 : 1); ++_rep)
    volatile LAS int* tile_e = (volatile LAS int*)(F.MISC + 2112);
#define REFRESH() do { int _tz = threadIdx.x; asm volatile("" : "+v"(_tz)); F.tid = _tz; F.lane = _tz & 63; F.wave = __builtin_amdgcn_readfirstlane(_tz >> 6); } while (0)
    const size_t TS2048 = (size_t)256 * 2048 * 2;

    if (IN(0)) REP(0) { REFRESH(); p0_prologue(F, p); } SEAM(0);
    if (IN(1)) REP(1) { REFRESH(); p1_modulate0(F, p); } SEAM(1);
    if (IN(2)) REP(2) {   REFRESH();
        pg8::DenseSched S; S.T.init(NTOK / 256, ABINP / 256, F.G, (int)blockIdx.x); S.A = (const char*)(ws + WS_H); S.Bt = (const char*)(ws + WS_WIN); S.tstepB = TS2048; S.row0 = 0;
        EpiU E{(bf16*)(ws + WS_U)};
        pg8::gemm_phase<EpiU, pg8::DenseSched, false>(F.lds, 2 * DM, S, E);
    } SEAM(2);
    if (IN(3)) REP(3) { REFRESH(); p3_rank_norms(F, p); REFRESH(); p3_conv_gates(F, p); } SEAM(3);
    if (IN(4)) REP(4) {   REFRESH();
        { pg8::DenseSched S; S.T.init(NTOK / 256, 1536 / 256, F.G, (int)blockIdx.x); S.A = (const char*)(ws + WS_CQN); S.Bt = (const char*)(ws + WS_WUQ); S.tstepB = (size_t)256 * 512 * 2; S.row0 = 0;
          EpiBf E{(bf16*)(ws + WS_QRAW), 1536};
          pg8::gemm_phase<EpiBf, pg8::DenseSched, false>(F.lds, 2 * 512, S, E); }
        REFRESH();
        { pg8::DenseSched S; S.T.init(NTOK / 256, 2048 / 256, F.G, (int)blockIdx.x); S.A = (const char*)(ws + WS_CKVN); S.Bt = (const char*)(ws + WS_WUKV); S.tstepB = (size_t)256 * 512 * 2; S.row0 = 0;
          EpiBf E{(bf16*)(ws + WS_KVRAW), 2048};
          pg8::gemm_phase<EpiBf, pg8::DenseSched, false>(F.lds, 2 * 512, S, E); }
        REFRESH(); scan_pass_b(F);
    } SEAM(4);
    if (IN(5)) REP(5) { REFRESH(); p5_mla_finalize(F, p); scan_pass_c(F); } SEAM(5);
    if (IN(6)) REP(6) { REFRESH(); p6_mla_attention(F); REFRESH(); scan_pass_d(F); } SEAM(6);
    if (IN(7)) REP(7) {   REFRESH();
        pg8::DenseSched S; S.T.init(NTOK / 256, DM / 256, F.G, (int)blockIdx.x); S.A = (const char*)(ws + WS_YC); S.Bt = (const char*)(ws + WS_WOUT0); S.tstepB = TS2048; S.row0 = 0;
        EpiRes E{p.in[I_CTX], p.in[I_X], (float*)(ws + WS_XA), (const float*)(ws + WS_MOD) + 2 * DM, 0};
        pg8::gemm_phase<EpiRes, pg8::DenseSched, false>(F.lds, 2 * DM, S, E);
    } SEAM(7);

#if MOE_FP8
#define MOE_GEMM1() do { EpiSwiglu8 E{ws + WS_ACT}; pg8::gemm_phase<EpiSwiglu8, pg8::MoeSched, true>(F.lds, DM, S, E); } while (0)
#else
#define MOE_GEMM1() do { EpiSwiglu E{(bf16*)(ws + WS_ACT)}; pg8::gemm_phase<EpiSwiglu, pg8::MoeSched, false>(F.lds, 2 * DM, S, E); } while (0)
#endif
#define MOE_PHASES(l) do { \
        constexpr int pb = (l) ? 17 : 8, rbase = (l) ? NCTX : 0, nsh = (l) ? NLAT / 256 : NTOK / 256; \
        if (IN(pb + 0)) REP(pb + 0) { REFRESH(); p8_h2_route(F, p, (l), (const float*)(ws + WS_XA), rbase); } SEAM(pb + 0); \
        if (IN(pb + 1)) REP(pb + 1) { REFRESH(); p9_scatter(F, (l), rbase); } SEAM(pb + 1); \
        if (IN(pb + 2)) REP(pb + 2) { REFRESH(); \
            int ntot; moe_tiles(F, (l), nsh, tile_e, ntot); \
            pg8::MoeSched S; S.T.init(ntot, 11, F.G, (int)blockIdx.x); S.A = (const char*)(ws + WS_H); S.Bt = (const char*)(ws + WS_W1 + (size_t)(l) * 17 * W1_E); S.tstepB = W1_E / 11; S.estride = W1_E; \
            S.rowmap = (const int*)(ws + WS_SLOTTOK); S.tile_e = tile_e; \
            MOE_GEMM1(); \
        } SEAM(pb + 2); \
        if (IN(pb + 3)) REP(pb + 3) { REFRESH(); \
            int ntot; moe_tiles(F, (l), nsh, tile_e, ntot); \
            pg8::MoeSched S; S.T.init(ntot, 8, F.G, (int)blockIdx.x); S.A = (const char*)(ws + WS_ACT); S.Bt = (const char*)(ws + WS_W2 + (size_t)(l) * 17 * W2_E); S.tstepB = W2_E / 8; S.estride = W2_E; \
            S.rowmap = nullptr; S.tile_e = tile_e; \
            EpiBf E{(bf16*)(ws + WS_Y), DM}; \
            pg8::gemm_phase<EpiBf, pg8::MoeSched, MOE_FP8 != 0>(F.lds, ACT_LD * ACT_ES, S, E); \
        } SEAM(pb + 3); \
        if (IN(pb + 4)) REP(pb + 4) { REFRESH(); \
            int ntot; const int ntr = moe_tiles(F, (l), nsh, tile_e, ntot); \
            p12_combine(F, p, (l), (const float*)(ws + WS_XA), (l) ? p.out : (float*)(ws + WS_XB), rbase, ntr * 256); \
        } SEAM(pb + 4); \
    } while (0)
    MOE_PHASES(0);
    if (IN(13)) REP(13) {   REFRESH();
        pg8::DenseSched S; S.T.init(NTOK / 256, 6144 / 256, F.G, (int)blockIdx.x); S.A = (const char*)(ws + WS_H); S.Bt = (const char*)(ws + WS_WQKV); S.tstepB = TS2048; S.row0 = 0;
        EpiBf E{(bf16*)(ws + WS_QKV), 6144};
        pg8::gemm_phase<EpiBf, pg8::DenseSched, false>(F.lds, 2 * DM, S, E);
    } SEAM(13);
    if (IN(14)) REP(14) { REFRESH(); p15_na_finalize(F, p); } SEAM(14);
    if (IN(15)) REP(15) { REFRESH(); p16_na_attention(F, p); } SEAM(15);
    if (IN(16)) REP(16) {   REFRESH();
        pg8::DenseSched S; S.T.init(NLAT / 256, DM / 256, F.G, (int)blockIdx.x); S.A = (const char*)(ws + WS_ATT2); S.Bt = (const char*)(ws + WS_WOUT1); S.tstepB = TS2048; S.row0 = NCTX;
        EpiRes E{(const float*)(ws + WS_XB), (const float*)(ws + WS_XB) + (size_t)NCTX * DM, (float*)(ws + WS_XA), (const float*)(ws + WS_MOD) + (size_t)5 * 12288 + 2 * DM, NCTX};
        pg8::gemm_phase<EpiRes, pg8::DenseSched, false>(F.lds, 2 * DM, S, E);
    } SEAM(16);
    MOE_PHASES(1);
#undef MOE_PHASES
#undef IN
#undef SEAM
}

extern "C" void kernel_launch(void* const* d_in, const int* in_sizes, int n_in, void* d_out, int out_size, void* d_ws, size_t ws_size, hipStream_t stream) {
    static int grid = 0;
    if (grid == 0) {
        if (n_in != 36 || in_sizes[0] != NLAT * DM || out_size != NLAT * DM || ws_size < WS_END) {
            fprintf(stderr, "kernel_launch: shape mismatch: n_in %d in0 %d out %d ws %zu (need %zu)\n", n_in, n_in > 0 ? in_sizes[0] : -1, out_size, ws_size, (size_t)WS_END); grid = -1; return; }
        int dev = 0, cus = 0, per_cu = 0;
        if (hipGetDevice(&dev) != hipSuccess || hipDeviceGetAttribute(&cus, hipDeviceAttributeMultiprocessorCount, dev) != hipSuccess) { grid = -1; return; }
        if (hipFuncSetAttribute((const void*)mega_fwd, hipFuncAttributeMaxDynamicSharedMemorySize, LDS_BYTES) != hipSuccess) { fprintf(stderr, "kernel_launch: hipFuncSetAttribute failed\n"); grid = -1; return; }
        if (hipOccupancyMaxActiveBlocksPerMultiprocessor(&per_cu, (const void*)mega_fwd, NTHR, LDS_BYTES) != hipSuccess || per_cu < 1) { fprintf(stderr, "kernel_launch: occupancy query says %d\n", per_cu); }
        (void)hipGetLastError();
        grid = cus;
    }
    if (grid < 0) return;
    if (hipMemsetAsync((char*)d_ws + WS_CTL, 0, CTL_BYTES, stream) != hipSuccess) return;
    Params P{};
    for (int i = 0; i < 36; ++i) P.in[i] = (const float*)d_in[i];
    P.out = (float*)d_out; P.ws = (unsigned char*)d_ws;
#if MK_N_LAUNCHES == 1
    P.ph_lo = 0; P.ph_hi = NPHASE;
    hipLaunchKernelGGL(mega_fwd, dim3(grid), dim3(NTHR), LDS_BYTES, stream, P);
#else
    for (int k = 0; k < NPHASE; ++k) { P.ph_lo = k; P.ph_hi = k + 1; hipLaunchKernelGGL(mega_fwd, dim3(grid), dim3(NTHR), LDS_BYTES, stream, P); }
#endif
    const hipError_t le = hipPeekAtLastError();
    if (le != hipSuccess) fprintf(stderr, "kernel_launch: launch failed: %s\n", hipGetErrorName(le));
}
```

```cpp
#include <hip/hip_runtime.h>
#include <cstdio>
#include <cstdint>

#ifndef MK_N_LAUNCHES
#define MK_N_LAUNCHES 1
#endif

#define GAS __attribute__((address_space(1)))
#define LAS __attribute__((address_space(3)))
typedef unsigned short bf16;
typedef short bf16x8 __attribute__((ext_vector_type(8)));
typedef short s16x4 __attribute__((ext_vector_type(4)));
typedef float f32x2 __attribute__((ext_vector_type(2)));
typedef float f32x4 __attribute__((ext_vector_type(4)));
typedef float f32x16 __attribute__((ext_vector_type(16)));
typedef unsigned u32x2 __attribute__((ext_vector_type(2)));
typedef unsigned u32x4 __attribute__((ext_vector_type(4)));
#define LDS_WAIT() asm volatile("s_waitcnt lgkmcnt(0)" ::: "memory")
#define VM_WAIT() asm volatile("s_waitcnt vmcnt(0)" ::: "memory")
#define RLX_AGENT __ATOMIC_RELAXED, __HIP_MEMORY_SCOPE_AGENT

constexpr int DM = 2048, NB = 4, SEQ = 4096, CTXL = 256, GW = 64;
constexpr int NCTX = NB * CTXL, NLAT = NB * SEQ, NTOK = NCTX + NLAT;
constexpr int DRNN = 1024, QRK = 512, KVRK = 512, MROPE = 64, MNOPE = 128, MQK = 192, MV = 128, MH = 8;
constexpr int ABIN = 3136, ABINP = 3328;
constexpr int NAH = 16, NAD = 128;
constexpr int NE = 16, DE = 1408, NG = 4;
constexpr int NCHUNK = 68;
constexpr float EPS = 1e-6f;
constexpr float LOG2E = 1.4426950408889634f;
constexpr int MAXSLOT = 56320;

constexpr size_t al256(size_t x) { return (x + 255) / 256 * 256; }
constexpr size_t WS_CTL = 0, CTL_BYTES = 1u << 20;
constexpr int CW_TMO = 0, CW_BAR = 4096, CW_CNT = 16384;
constexpr size_t WS_MODP = CTL_BYTES;
constexpr size_t WS_MOD = WS_MODP + al256((size_t)8 * 2 * 5 * 12288 * 4);
constexpr size_t WS_ROPE = WS_MOD + al256((size_t)2 * 5 * 12288 * 4);
constexpr size_t WS_AGG = WS_ROPE + al256(64 * 16 * 8);
constexpr size_t WS_CARRY = WS_AGG + al256((size_t)2 * 4 * NCHUNK * 1024 * 8);
constexpr size_t WS_TOKE = WS_CARRY + al256((size_t)2 * 4 * NCHUNK * 1024 * 4);
constexpr size_t WS_TOKW = WS_TOKE + al256((size_t)NTOK * 8);
constexpr size_t WS_TOKP = WS_TOKW + al256((size_t)NTOK * 8);
constexpr size_t WS_TOKS = WS_TOKP + al256((size_t)NTOK * 8);
constexpr size_t WS_SLOTTOK = WS_TOKS + al256((size_t)NTOK * 8);
constexpr size_t WS_WIN = al256(WS_SLOTTOK + (size_t)MAXSLOT * 4);
constexpr size_t WS_WOUT0 = WS_WIN + (size_t)ABINP * DM * 2;
constexpr size_t WS_WUQ = WS_WOUT0 + (size_t)DM * DM * 2;
constexpr size_t WS_WUKV = WS_WUQ + (size_t)1536 * 512 * 2;
constexpr size_t WS_WG = WS_WUKV + (size_t)2048 * 512 * 2;
constexpr size_t WS_WQKV = WS_WG + (size_t)4 * 8 * 128 * 128 * 2;
constexpr size_t WS_WOUT1 = WS_WQKV + (size_t)6144 * DM * 2;
#ifndef MOE_FP8
#define MOE_FP8 1
#endif
#ifndef DFP8_IN
#define DFP8_IN 0
#endif
#ifndef DFP8_QKV
#define DFP8_QKV 1
#endif
#ifndef DFP8_OUT0
#define DFP8_OUT0 0
#endif
#ifndef DFP8_OUT1
#define DFP8_OUT1 1
#endif
constexpr int DEP = 1536;
#if MOE_FP8
constexpr size_t W1_E = (size_t)2816 * DM, W2_E = (size_t)DM * DEP;
constexpr int ACT_LD = DEP, ACT_ES = 1;
#else
constexpr size_t W1_E = (size_t)2816 * DM * 2, W2_E = (size_t)DM * DE * 2;
constexpr int ACT_LD = DE, ACT_ES = 2;
#endif
constexpr size_t WS_W1 = WS_WOUT1 + (size_t)DM * DM * 2;
constexpr size_t WS_W2 = WS_W1 + 2 * 17 * W1_E;
constexpr size_t WS_XA = WS_W2 + 2 * 17 * W2_E;
constexpr size_t XBYTES = (size_t)NTOK * DM * 4;
constexpr size_t WS_XB = WS_XA + XBYTES;
constexpr size_t WS_H = WS_XB + XBYTES;
constexpr size_t WS_D = WS_H + (size_t)NTOK * DM * 2;
constexpr size_t WS_U = WS_D;
constexpr size_t WS_AB = WS_U + al256((size_t)NTOK * ABIN * 2);
constexpr size_t ABSZ = (size_t)NTOK * DRNN * 4;
constexpr size_t WS_CQN = WS_AB + 4 * ABSZ;
constexpr size_t WS_CKVN = WS_CQN + (size_t)NTOK * 512 * 2;
constexpr size_t WS_YC = WS_CKVN + (size_t)NTOK * 512 * 2;
constexpr size_t WS_D_END0 = WS_YC + (size_t)NTOK * DM * 2;
constexpr size_t WS_QRAW = WS_XA;
constexpr size_t WS_KVRAW = WS_QRAW + al256((size_t)NTOK * 1536 * 2);
constexpr size_t WS_QF = WS_XB;
constexpr size_t WS_KF = WS_QF + al256((size_t)NTOK * 1536 * 2);
static_assert(WS_KVRAW + (size_t)NTOK * 2048 * 2 <= WS_XB && WS_KF + (size_t)NTOK * 1536 * 2 <= WS_H, "mixer overlays");
constexpr size_t WS_ACT = WS_D;
constexpr size_t WS_Y = WS_ACT + al256((size_t)MAXSLOT * ACT_LD * ACT_ES);
constexpr size_t WS_D_END1 = WS_Y + (size_t)MAXSLOT * DM * 2;
constexpr size_t WS_QKV = WS_D;
constexpr size_t WS_ATT2 = WS_QKV + (size_t)NTOK * 6144 * 2;
constexpr size_t WS_D_END2 = WS_ATT2 + (size_t)NTOK * DM * 2;
constexpr size_t WS_END = (WS_D_END0 > WS_D_END1 ? (WS_D_END0 > WS_D_END2 ? WS_D_END0 : WS_D_END2) : (WS_D_END1 > WS_D_END2 ? WS_D_END1 : WS_D_END2));

constexpr int RING_BYTES = 131072;
constexpr int MISC_OFF = RING_BYTES;
constexpr int LDS_BYTES = 147456;
constexpr int NWAVES = 8, NTHR = 512;

__device__ __forceinline__ unsigned f2bf(float f) { unsigned u = __builtin_bit_cast(unsigned, f); return (u + 0x7fffu + ((u >> 16) & 1u)) >> 16; }
__device__ __forceinline__ unsigned pk2(float lo, float hi) { return f2bf(lo) | (f2bf(hi) << 16); }
__device__ __forceinline__ float bf2f(unsigned short b) { return __builtin_bit_cast(float, (unsigned)b << 16); }
__device__ __forceinline__ float bflo(unsigned w) { return __builtin_bit_cast(float, w << 16); }
__device__ __forceinline__ float bfhi(unsigned w) { return __builtin_bit_cast(float, w & 0xffff0000u); }
__device__ __forceinline__ unsigned cvt_pk_bf16(float lo, float hi) { unsigned r; asm volatile("v_cvt_pk_bf16_f32 %0, %1, %2" : "=v"(r) : "v"(lo), "v"(hi)); return r; }
__device__ __forceinline__ float clamp_e4m3(float x) { return __builtin_amdgcn_fmed3f(x, -448.0f, 448.0f); }
__device__ __forceinline__ unsigned pk4_fp8(float a, float b, float c, float d) { int w = 0; w = __builtin_amdgcn_cvt_pk_fp8_f32(clamp_e4m3(a), clamp_e4m3(b), w, false); w = __builtin_amdgcn_cvt_pk_fp8_f32(clamp_e4m3(c), clamp_e4m3(d), w, true); return (unsigned)w; }
__device__ __forceinline__ float wave_sum(float v) {
#pragma unroll
    for (int o = 1; o < 64; o <<= 1) v += __shfl_xor(v, o);
    return v;
}
__device__ __forceinline__ float sigmoidf_(float x) { return 1.0f / (1.0f + __expf(-x)); }
__device__ __forceinline__ float gelu_tanh(float x) { const float u = 0.7978845608028654f * (x + 0.044715f * x * x * x); const float th = 1.0f - 2.0f / (1.0f + __expf(2.0f * u)); return 0.5f * x * (1.0f + th); }
__device__ __forceinline__ int vec_of_row(int row) { return row < NCTX ? 4 : (row - NCTX) / SEQ; }

#define XB_TMO      128
#define XB_XCNT(j)  (256  + 64 * (j))
#define XB_XSUB(j)  (1280 + 64 * (j))
#define XB_XGEN(j)  (2304 + 64 * (j))
#define XB_TOP      3328
#define XB_TOPGEN   3392
#define XCD_BAR_WORDS 3456
#define XB_SPIN_CAP (1u << 18)
__device__ __forceinline__ unsigned xb_ld(unsigned* p)              { return __hip_atomic_load(p, __ATOMIC_RELAXED, __HIP_MEMORY_SCOPE_AGENT); }
__device__ __forceinline__ unsigned xb_add(unsigned* p, unsigned v) { return __hip_atomic_fetch_add(p, v, __ATOMIC_RELAXED, __HIP_MEMORY_SCOPE_AGENT); }
__device__ __forceinline__ unsigned xb_xcc_id() { return (unsigned)__builtin_amdgcn_s_getreg((3 << 11) | 20) & 0xFu; }
#define XB_SPIN(cond, bar) do { unsigned _sp = 0; while (cond) { __builtin_amdgcn_s_sleep(1); \
    if ((++_sp & 255u) == 0u) { if (xb_ld(&(bar)[XB_TMO])) break; if (_sp > XB_SPIN_CAP) { atomicAdd(&(bar)[XB_TMO], 1u); break; } } } } while (0)
struct XcdBarrier { unsigned* bar; unsigned x; volatile LAS unsigned* st; };
__device__ __forceinline__ XcdBarrier xcd_barrier_post(unsigned* bar, volatile LAS unsigned* st) {
    XcdBarrier b; b.bar = bar; b.x = xb_xcc_id(); b.st = st;
    if (threadIdx.x == 0) (void)xb_add(&bar[XB_XCNT(b.x)], 1u);
    return b;
}
__device__ __forceinline__ void xcd_barrier_complete(unsigned* bar, unsigned x, unsigned& nloc, unsigned& nx) {
    const unsigned G = gridDim.x * gridDim.y * gridDim.z;
    unsigned sum, cnt, mine, sp = 0u;
    for (;;) {
        sum = 0u; cnt = 0u; mine = 0u;
#pragma unroll
        for (unsigned j = 0; j < 16; ++j) { const unsigned c = xb_ld(&bar[XB_XCNT(j)]); sum += c; cnt += (c > 0u) ? 1u : 0u; mine = (j == x) ? c : mine; }
        if (sum == G) break;
        __builtin_amdgcn_s_sleep(1);
        if ((++sp & 255u) == 0u) { if (xb_ld(&bar[XB_TMO])) break; if (sp > XB_SPIN_CAP) { atomicAdd(&bar[XB_TMO], 1u); break; } }
    }
    nloc = mine > 0u ? mine : 1u; nx = cnt > 0u ? cnt : 1u;
}
__device__ __forceinline__ void xcd_barrier(const XcdBarrier& b) {
    asm volatile("s_waitcnt vmcnt(0)" ::: "memory");
    __syncthreads();
    if (threadIdx.x == 0) {
        unsigned* bar = b.bar;
        __builtin_amdgcn_s_waitcnt(0);
        unsigned nloc = b.st[0], nx = b.st[1];
        if (nloc == 0u) { xcd_barrier_complete(bar, b.x, nloc, nx); b.st[0] = nloc; b.st[1] = nx; }
        const unsigned old = xb_add(&bar[XB_XSUB(b.x)], 1u);
        const unsigned gen = old / nloc;
        if (old + 1u == (gen + 1u) * nloc) {
            __builtin_amdgcn_fence(__ATOMIC_RELEASE, "agent");
            asm volatile("s_waitcnt vmcnt(0)" ::: "memory");
            const unsigned og = xb_add(&bar[XB_TOP], 1u);
            const unsigned tg = og / nx;
            if (og + 1u == (tg + 1u) * nx) xb_add(&bar[XB_TOPGEN], 1u);
            else XB_SPIN(xb_ld(&bar[XB_TOPGEN]) == tg, bar);
            __builtin_amdgcn_fence(__ATOMIC_ACQUIRE, "agent");
            xb_add(&bar[XB_XGEN(b.x)], 1u);
            asm volatile("s_waitcnt vmcnt(0)" ::: "memory");
        } else {
            XB_SPIN(xb_ld(&bar[XB_XGEN(b.x)]) == gen, bar);
            __builtin_amdgcn_fence(__ATOMIC_ACQUIRE, "agent");
            asm volatile("s_waitcnt vmcnt(0)" ::: "memory");
        }
    }
    __syncthreads();
}

namespace pg8 {
constexpr int BM = 256, BK = 64, HALF = 128, HTB = HALF * BK * 2, STAGE_BYTES = 8 * HTB, NXCD = 8, WGM = 8;
__device__ __forceinline__ int lds_byte(int r, int c) { const int st = (r >> 4) * 2 + (c >> 5), rr = r & 15, cc = c & 31, ob = rr * 64 + cc * 2; return st * 1024 + (ob ^ (((ob >> 9) & 1) << 5)); }
__device__ __forceinline__ void stage_rc(int b, int& R, int& C) { const int st = b / 1024, sb = b % 1024, swz = sb ^ (((sb >> 9) & 1) << 5); R = (st >> 1) * 16 + swz / 64; C = (st & 1) * 32 + (swz % 64) / 2; }
__device__ __forceinline__ int perm32(int rho) { const int n = rho >> 4, i = rho & 15; return 8 * (i >> 2) + 4 * n + (i & 3); }

__device__ __forceinline__ void dma16(unsigned lds_dst, const void* sbase, unsigned voff) {
    unsigned keep;
    asm volatile("s_mov_b32 %0, m0\n\ts_mov_b32 m0, %3\n\ts_nop 0\n\tglobal_load_lds_dwordx4 %1, %2\n\ts_mov_b32 m0, %0" : "=&s"(keep) : "v"(voff), "s"(sbase), "s"(lds_dst) : "memory");
}
struct Unit {
    const char* ap;
    const char* bp;
    const int* rowmap;
    int arow0;
    int pm, pn, grp;
};
struct TileOrder {
    int nM, nN, nwg, G, c;
    __device__ __forceinline__ void init(int nM_, int nN_, int G_, int c_) { nM = nM_; nN = nN_; nwg = nM * nN; G = G_; c = c_; }
    __device__ __forceinline__ bool tile(int i, int& pm, int& pn) const {
        const long L = (long)i * G + c; if (L >= nwg) return false;
        int wgid = (int)L; { const int q = nwg / NXCD, r = nwg % NXCD, xcd = wgid % NXCD, off = wgid / NXCD; wgid = (xcd < r ? xcd * (q + 1) : r * (q + 1) + (xcd - r) * q) + off; }
        const int nig = WGM * nN, gid = wgid / nig, fm = gid * WGM, gsz = (nM - fm) < WGM ? (nM - fm) : WGM;
        pm = fm + ((wgid % nig) % gsz); pn = (wgid % nig) / gsz; return true;
    }
};
struct DenseSched {
    TileOrder T; const char* A; const char* Bt; size_t tstepB; int row0;
    __device__ __forceinline__ bool next(int i, Unit& u) const {
        int pm, pn; if (!T.tile(i, pm, pn)) return false;
        u.ap = A; u.bp = Bt + (size_t)pn * tstepB; u.rowmap = nullptr; u.arow0 = row0 + pm * BM; u.pm = pm; u.pn = pn; u.grp = 0; return true;
    }
};
struct MoeSched {
    TileOrder T; const char* A; const char* Bt; size_t tstepB, estride; const int* rowmap; const volatile LAS int* tile_e;
    __device__ __forceinline__ bool next(int i, Unit& u) const {
        int pm, pn; if (!T.tile(i, pm, pn)) return false;
        const int e = __builtin_amdgcn_readfirstlane(tile_e[pm]);
        u.ap = A; u.bp = Bt + (size_t)e * estride + (size_t)pn * tstepB; u.rowmap = rowmap; u.arow0 = pm * BM; u.pm = pm; u.pn = pn; u.grp = e; return true;
    }
};

typedef int v8i __attribute__((ext_vector_type(8)));
template <class Epi, class Sched, bool FP8>
__device__ __forceinline__ void gemm_phase(LAS unsigned char* lds, const int rowBytes, const Sched& S, const Epi& E, const unsigned sclA = 0x7f7f7f7fu) {
    const int tid = threadIdx.x, wid = __builtin_amdgcn_readfirstlane(tid >> 6), lane = tid & 63, wr = wid >> 2, wc = wid & 3, fr = lane & 15, fq = lane >> 4;
    const int nt = rowBytes / 128;
    int sR[2]; unsigned sC2[2], voffB[2];
#pragma unroll
    for (int i = 0; i < 2; ++i) { int R, C; stage_rc(tid * 16 + i * 8192, R, C); const int Rb = Epi::PERM ? ((R & ~31) + perm32(R & 31)) : R;
        sR[i] = R; sC2[i] = (unsigned)C * 2u; voffB[i] = (unsigned)Rb * (unsigned)rowBytes + (unsigned)C * 2u; }
    const size_t kstep = 128;
    const size_t hstepB = (size_t)HALF * rowBytes;
    const unsigned rowB = (unsigned)rowBytes;
    const unsigned ldsw = (unsigned)wid * 1024u;
    const int aoff = FP8 ? lds_byte(wr * 64 + fr, fq * 16) : lds_byte(wr * 64 + fr, fq * 8), boff = FP8 ? lds_byte(wc * 32 + fr, fq * 16) : lds_byte(wc * 32 + fr, fq * 8);
#define PG8_SA(b, h) (((b) * 2 + (h)) * HTB)
#define PG8_SB(b, h) ((4 + (b) * 2 + (h)) * HTB)
#define PG8_STAGE(bufoff, gbase, voff) do { _Pragma("unroll") for (int _i = 0; _i < 2; ++_i) \
        dma16((unsigned)((bufoff) + _i * 8192) + ldsw, (const void*)(gbase), (voff)[_i]); } while (0)
#define PG8_LDA(dst, b, h) do { if constexpr (FP8) { _Pragma("unroll") for (int m = 0; m < 4; ++m) dst##8[m] = *(const LAS v8i*)(lds + PG8_SA(b, h) + aoff + m * 2048); } \
        else { _Pragma("unroll") for (int m = 0; m < 4; ++m) _Pragma("unroll") for (int k = 0; k < 2; ++k) dst[m][k] = *(const LAS bf16x8*)(lds + PG8_SA(b, h) + aoff + m * 2048 + k * 1024); } } while (0)
#define PG8_LDB(dst, b, h) do { if constexpr (FP8) { _Pragma("unroll") for (int n = 0; n < 2; ++n) dst##8[n] = *(const LAS v8i*)(lds + PG8_SB(b, h) + boff + n * 2048); } \
        else { _Pragma("unroll") for (int n = 0; n < 2; ++n) _Pragma("unroll") for (int k = 0; k < 2; ++k) dst[n][k] = *(const LAS bf16x8*)(lds + PG8_SB(b, h) + boff + n * 2048 + k * 1024); } } while (0)
#define PG8_MMA(ai, bj, At, Bt) do { __builtin_amdgcn_s_setprio(1); \
        if constexpr (FP8) { _Pragma("unroll") for (int m = 0; m < 4; ++m) _Pragma("unroll") for (int n = 0; n < 2; ++n) \
            asm volatile("v_mfma_scale_f32_16x16x128_f8f6f4 %0, %1, %2, %0, %3, %4 op_sel_hi:[0,0,0]" : "+v"(acc[ai][bj][m][n]) : "v"(Bt##8[n]), "v"(At##8[m]), "v"(sclW), "v"(sclA)); } \
        else { _Pragma("unroll") for (int m = 0; m < 4; ++m) _Pragma("unroll") for (int n = 0; n < 2; ++n) _Pragma("unroll") for (int k = 0; k < 2; ++k) \
            acc[ai][bj][m][n] = __builtin_amdgcn_mfma_f32_16x16x32_bf16(Bt[n][k], At[m][k], acc[ai][bj][m][n], 0, 0, 0); } \
        __builtin_amdgcn_s_setprio(0); } while (0)
#define PG8_WAIT_V(n) asm volatile("s_waitcnt vmcnt(" #n ")" ::: "memory")
#define PG8_WAIT_L(n) asm volatile("s_waitcnt lgkmcnt(" #n ")" ::: "memory")
#define PG8_BAR __builtin_amdgcn_s_barrier()
#define PG8_SCHED __builtin_amdgcn_sched_barrier(0)
#define PG8_MKOFF(u, o0, o1) do { _Pragma("unroll") for (int _i = 0; _i < 2; ++_i) { const int _r0 = (u).arow0 + sR[_i], _r1 = _r0 + HALF; \
        const int _g0 = (u).rowmap ? (u).rowmap[_r0] : _r0, _g1 = (u).rowmap ? (u).rowmap[_r1] : _r1; \
        o0[_i] = (unsigned)_g0 * rowB + sC2[_i]; o1[_i] = (unsigned)_g1 * rowB + sC2[_i]; } } while (0)
    Unit cur, nxt; int ui = 0;
    if (!S.next(0, cur)) return;
    f32x4 acc[2][2][4][2];
#pragma unroll
    for (int a = 0; a < 2; ++a)
#pragma unroll
        for (int b = 0; b < 2; ++b)
#pragma unroll
            for (int m = 0; m < 4; ++m)
#pragma unroll
                for (int n = 0; n < 2; ++n) acc[a][b][m][n] = (f32x4){0.f, 0.f, 0.f, 0.f};
    bf16x8 At[4][2], B0[2][2], B1[2][2]; v8i At8[4], B08[2], B18[2];
    const unsigned sclW = 0x79797979u;
    unsigned oc0[2], oc1[2], on0[2], on1[2];
    PG8_MKOFF(cur, oc0, oc1);
    on0[0] = oc0[0]; on0[1] = oc0[1]; on1[0] = oc1[0]; on1[1] = oc1[1];
    const char* cA = cur.ap; const char* cB = cur.bp;
    PG8_STAGE(PG8_SB(0, 0), cB, voffB); PG8_STAGE(PG8_SB(0, 1), cB + hstepB, voffB); PG8_STAGE(PG8_SA(0, 0), cA, oc0); PG8_STAGE(PG8_SA(0, 1), cA, oc1);
    if (wr == 1) PG8_BAR;
    PG8_WAIT_V(2); PG8_BAR;
    PG8_STAGE(PG8_SB(1, 0), cB + kstep, voffB); PG8_STAGE(PG8_SA(1, 0), cA + kstep, oc0); PG8_STAGE(PG8_SB(1, 1), cB + hstepB + kstep, voffB);
    PG8_WAIT_V(6); PG8_BAR;
    for (;;) {
        const bool has_next = S.next(ui + 1, nxt);
        const char* nA = has_next ? nxt.ap : cA; const char* nB = has_next ? nxt.bp : cB;
        for (int t = 0; t < nt; t += 2) {
            const bool last = (t == nt - 2);
            if (last && has_next) { PG8_MKOFF(nxt, on0, on1); }
            const char* a1 = cA + (size_t)(t + 1) * kstep;
            const char* a2 = last ? nA : cA + (size_t)(t + 2) * kstep; const char* b2 = last ? nB : cB + (size_t)(t + 2) * kstep;
            const char* a3 = a2 + kstep; const char* b3 = b2 + kstep;
            unsigned o20[2], o21[2];
            o20[0] = last ? on0[0] : oc0[0]; o20[1] = last ? on0[1] : oc0[1]; o21[0] = last ? on1[0] : oc1[0]; o21[1] = last ? on1[1] : oc1[1];
            PG8_LDB(B0, 0, 0); PG8_LDB(B1, 0, 1); PG8_SCHED; PG8_LDA(At, 0, 0); PG8_STAGE(PG8_SA(1, 1), a1, oc1);
            PG8_WAIT_V(8); PG8_WAIT_L(0); PG8_BAR; PG8_MMA(0, 0, At, B0); PG8_MMA(0, 1, At, B1); PG8_BAR; PG8_SCHED;
            PG8_LDA(At, 0, 1); PG8_STAGE(PG8_SB(0, 0), b2, voffB); PG8_STAGE(PG8_SB(0, 1), b2 + hstepB, voffB); PG8_STAGE(PG8_SA(0, 0), a2, o20);
            PG8_WAIT_V(8); PG8_WAIT_L(0); PG8_BAR; PG8_MMA(1, 0, At, B0); PG8_MMA(1, 1, At, B1); PG8_BAR; PG8_SCHED;
            PG8_LDB(B0, 1, 0); PG8_LDB(B1, 1, 1); PG8_SCHED; PG8_LDA(At, 1, 0); PG8_STAGE(PG8_SA(0, 1), a2, o21);
            PG8_WAIT_V(8); PG8_WAIT_L(0); PG8_BAR; PG8_MMA(0, 0, At, B0); PG8_MMA(0, 1, At, B1); PG8_BAR; PG8_SCHED;
            PG8_LDA(At, 1, 1); PG8_STAGE(PG8_SB(1, 0), b3, voffB); PG8_STAGE(PG8_SB(1, 1), b3 + hstepB, voffB); PG8_STAGE(PG8_SA(1, 0), a3, o20);
            PG8_WAIT_V(8); PG8_WAIT_L(0); PG8_BAR; PG8_MMA(1, 0, At, B0); PG8_MMA(1, 1, At, B1); PG8_BAR; PG8_SCHED;
        }
        if (wr == 0) PG8_BAR;
        if constexpr (FP8) asm volatile("s_nop 15\n\ts_nop 15" ::: "memory");
        E(acc, cur, wr, wc, fr, fq);
        if (!has_next) break;
#pragma unroll
        for (int a = 0; a < 2; ++a)
#pragma unroll
            for (int b = 0; b < 2; ++b)
#pragma unroll
                for (int m = 0; m < 4; ++m)
#pragma unroll
                    for (int n = 0; n < 2; ++n) acc[a][b][m][n] = (f32x4){0.f, 0.f, 0.f, 0.f};
        cur = nxt; cA = nA; cB = nB; ++ui;
        oc0[0] = on0[0]; oc0[1] = on0[1]; oc1[0] = on1[0]; oc1[1] = on1[1];
        if (wr == 1) PG8_BAR;
    }
    PG8_WAIT_V(0);
    PG8_BAR;
#undef PG8_SA
#undef PG8_SB
#undef PG8_STAGE
#undef PG8_LDA
#undef PG8_LDB
#undef PG8_MMA
#undef PG8_WAIT_V
#undef PG8_WAIT_L
#undef PG8_BAR
#undef PG8_SCHED
#undef PG8_MKOFF
}
}

struct Params { const float* in[36]; float* out; unsigned char* ws; int ph_lo, ph_hi; };
enum { I_X = 0, I_C, I_CTX, I_CCTX, I_ADAW, I_ADAB, I_NMIXG, I_NFFNG, I_ABWIN, I_ABWOUT, I_CONVW, I_CONVB, I_LWA, I_LBA, I_LWI, I_LBI, I_LAM,
       I_QNG, I_WUQ, I_KVNG, I_WUKV, I_QHG, I_KHG, I_NAWQKV, I_NAWOUT, I_NAQHG, I_NAKHG, I_RPB, I_RW, I_RB, I_MWG, I_MWU, I_MWD, I_MSG, I_MSU, I_MSD };

using pg8::Unit;
struct EpiU {
    static constexpr bool PERM = true;
    bf16* U;
    __device__ __forceinline__ void operator()(const f32x4 (&acc)[2][2][4][2], const Unit& u, int wr, int wc, int fr, int fq) const {
        const int row0 = u.pm * 256 + wr * 64 + fr, col0 = u.pn * 256 + wc * 32 + 8 * fq;
        const bool gel = (u.pn >= 4 && u.pn < 8);
#pragma unroll
        for (int ai = 0; ai < 2; ++ai)
#pragma unroll
            for (int m = 0; m < 4; ++m) { bf16* rowp = U + (size_t)(row0 + ai * 128 + m * 16) * ABIN + col0;
#pragma unroll
                for (int bj = 0; bj < 2; ++bj) { if (col0 + bj * 128 >= ABIN) continue;
                    f32x4 v0 = acc[ai][bj][m][0], v1 = acc[ai][bj][m][1];
                    if (gel) {
#pragma unroll
                        for (int j = 0; j < 4; ++j) { v0[j] = gelu_tanh(v0[j]); v1[j] = gelu_tanh(v1[j]); } }
                    u32x4 w; w.x = cvt_pk_bf16(v0[0], v0[1]); w.y = cvt_pk_bf16(v0[2], v0[3]); w.z = cvt_pk_bf16(v1[0], v1[1]); w.w = cvt_pk_bf16(v1[2], v1[3]);
                    *(u32x4*)(rowp + bj * 128) = w; } }
    }
};
struct EpiBf {
    static constexpr bool PERM = true;
    bf16* O; int ldc;
    __device__ __forceinline__ void operator()(const f32x4 (&acc)[2][2][4][2], const Unit& u, int wr, int wc, int fr, int fq) const {
        const int row0 = u.pm * 256 + wr * 64 + fr, col0 = u.pn * 256 + wc * 32 + 8 * fq;
#pragma unroll
        for (int ai = 0; ai < 2; ++ai)
#pragma unroll
            for (int m = 0; m < 4; ++m) { bf16* rowp = O + (size_t)(row0 + ai * 128 + m * 16) * ldc + col0;
#pragma unroll
                for (int bj = 0; bj < 2; ++bj) { const f32x4 v0 = acc[ai][bj][m][0], v1 = acc[ai][bj][m][1];
                    u32x4 w; w.x = cvt_pk_bf16(v0[0], v0[1]); w.y = cvt_pk_bf16(v0[2], v0[3]); w.z = cvt_pk_bf16(v1[0], v1[1]); w.w = cvt_pk_bf16(v1[2], v1[3]);
                    *(u32x4*)(rowp + bj * 128) = w; } }
    }
};
struct EpiRes {
    static constexpr bool PERM = false;
    const float* xin_ctx; const float* xin_lat;
    float* xout; const float* gate; int row0;
    __device__ __forceinline__ void operator()(const f32x4 (&acc)[2][2][4][2], const Unit& u, int wr, int wc, int fr, int fq) const {
        const int r0 = row0 + u.pm * 256 + wr * 64 + fr, col0 = u.pn * 256 + wc * 32 + 4 * fq;
        const int v = vec_of_row(row0 + u.pm * 256);
        f32x4 g[2][2];
#pragma unroll
        for (int bj = 0; bj < 2; ++bj)
#pragma unroll
            for (int n = 0; n < 2; ++n) g[bj][n] = *(const f32x4*)(gate + (size_t)v * 12288 + col0 + bj * 128 + n * 16);
#pragma unroll
        for (int ai = 0; ai < 2; ++ai)
#pragma unroll
            for (int m = 0; m < 4; ++m) { const int row = r0 + ai * 128 + m * 16;
                const float* xi = (row < NCTX ? xin_ctx + (size_t)row * DM : xin_lat + (size_t)(row - NCTX) * DM) + col0; float* xo = xout + (size_t)row * DM + col0;
#pragma unroll
                for (int bj = 0; bj < 2; ++bj)
#pragma unroll
                    for (int n = 0; n < 2; ++n) { const f32x4 xv = *(const f32x4*)(xi + bj * 128 + n * 16); *(f32x4*)(xo + bj * 128 + n * 16) = xv + g[bj][n] * acc[ai][bj][m][n]; } }
    }
};
struct EpiSwiglu {
    static constexpr bool PERM = true;
    bf16* ACT;
    __device__ __forceinline__ void operator()(const f32x4 (&acc)[2][2][4][2], const Unit& u, int wr, int wc, int fr, int fq) const {
        const int row0 = u.pm * 256 + wr * 64 + fr, col0 = u.pn * 128 + wc * 32 + 8 * fq;
#pragma unroll
        for (int ai = 0; ai < 2; ++ai)
#pragma unroll
            for (int m = 0; m < 4; ++m) { bf16* rowp = ACT + (size_t)(row0 + ai * 128 + m * 16) * DE + col0;
                float o[8];
#pragma unroll
                for (int n = 0; n < 2; ++n)
#pragma unroll
                    for (int j = 0; j < 4; ++j) { const float gv = acc[ai][0][m][n][j], uv = acc[ai][1][m][n][j]; o[n * 4 + j] = gv / (1.0f + __expf(-gv)) * uv; }
                u32x4 w; w.x = cvt_pk_bf16(o[0], o[1]); w.y = cvt_pk_bf16(o[2], o[3]); w.z = cvt_pk_bf16(o[4], o[5]); w.w = cvt_pk_bf16(o[6], o[7]);
                *(u32x4*)rowp = w; }
    }
};

struct EpiSwiglu8 {
    static constexpr bool PERM = true;
    unsigned char* ACT;
    __device__ __forceinline__ void operator()(const f32x4 (&acc)[2][2][4][2], const Unit& u, int wr, int wc, int fr, int fq) const {
        const int row0 = u.pm * 256 + wr * 64 + fr, col0 = u.pn * 128 + wc * 32 + 8 * fq;
#pragma unroll
        for (int ai = 0; ai < 2; ++ai)
#pragma unroll
            for (int m = 0; m < 4; ++m) { unsigned char* rowp = ACT + (size_t)(row0 + ai * 128 + m * 16) * DEP + col0;
                float o[8];
#pragma unroll
                for (int n = 0; n < 2; ++n)
#pragma unroll
                    for (int j = 0; j < 4; ++j) { const float gv = acc[ai][0][m][n][j], uv = acc[ai][1][m][n][j]; o[n * 4 + j] = gv / (1.0f + __expf(-gv)) * uv; }
                u32x2 w; w.x = pk4_fp8(o[0], o[1], o[2], o[3]); w.y = pk4_fp8(o[4], o[5], o[6], o[7]);
                *(u32x2*)rowp = w;
                if (u.pn == 10) *(u32x2*)(rowp + 128) = (u32x2){0u, 0u}; }
    }
};

struct Frame {
    LAS unsigned char* lds; volatile LAS unsigned* MISC; unsigned* ctl; unsigned char* ws;
    int tid, lane, wave, vcu, G;
};

__device__ __forceinline__ void xpose_item(const float* W, int ldw, bf16* WT, int ldt, int k0, int n0, int drow0, LAS float* scr, int lane) {
#pragma unroll 8
    for (int i = 0; i < 32; ++i) { const int kk = 2 * i + (lane >> 5); scr[kk * 33 + (lane & 31)] = W[(size_t)(k0 + kk) * ldw + n0 + (lane & 31)]; }
    LDS_WAIT(); asm volatile("" ::: "memory");
    const int c = lane & 7;
#pragma unroll
    for (int j = 0; j < 4; ++j) { const int n = (lane >> 3) + 8 * j; const LAS float* s = scr + (8 * c) * 33 + n;
        u32x4 o; o.x = pk2(s[0 * 33], s[1 * 33]); o.y = pk2(s[2 * 33], s[3 * 33]); o.z = pk2(s[4 * 33], s[5 * 33]); o.w = pk2(s[6 * 33], s[7 * 33]);
        *(u32x4*)(WT + (size_t)(drow0 + n) * ldt + k0 + 8 * c) = o; }
    LDS_WAIT(); asm volatile("" ::: "memory");
}
__device__ __forceinline__ void xpose_job(const float* W, int K, int N, bf16* WT, int r, LAS float* scr, int lane) {
    const int nblk = N / 32, kb = r / nblk, nb = r % nblk;
    xpose_item(W, N, WT, K, 64 * kb, 32 * nb, 32 * nb, scr, lane);
}
__device__ __forceinline__ void xpose_item8(const float* W, int ldw, unsigned char* WT, int ldt, int k0, int n0, int drow0, float sc, LAS float* scr, int lane) {
#pragma unroll 8
    for (int i = 0; i < 32; ++i) { const int kk = 2 * i + (lane >> 5); scr[kk * 33 + (lane & 31)] = W[(size_t)(k0 + kk) * ldw + n0 + (lane & 31)]; }
    LDS_WAIT(); asm volatile("" ::: "memory");
    const int c = lane & 3;
#pragma unroll
    for (int j = 0; j < 2; ++j) { const int n = (lane >> 2) + 16 * j; const LAS float* s = scr + (16 * c) * 33 + n;
        u32x4 o; o.x = pk4_fp8(s[0 * 33] * sc, s[1 * 33] * sc, s[2 * 33] * sc, s[3 * 33] * sc); o.y = pk4_fp8(s[4 * 33] * sc, s[5 * 33] * sc, s[6 * 33] * sc, s[7 * 33] * sc);
        o.z = pk4_fp8(s[8 * 33] * sc, s[9 * 33] * sc, s[10 * 33] * sc, s[11 * 33] * sc); o.w = pk4_fp8(s[12 * 33] * sc, s[13 * 33] * sc, s[14 * 33] * sc, s[15 * 33] * sc);
        *(u32x4*)(WT + (size_t)(drow0 + n) * ldt + k0 + 16 * c) = o; }
    LDS_WAIT(); asm volatile("" ::: "memory");
}
__device__ __forceinline__ void xpose_job8(const float* W, int K, int N, unsigned char* WT, int r, LAS float* scr, int lane) {
    const int nblk = N / 32, kb = r / nblk, nb = r % nblk;
    xpose_item8(W, N, WT, K, 64 * kb, 32 * nb, 32 * nb, 64.0f, scr, lane);
}
__device__ __forceinline__ void p0_prologue(Frame& F, const Params& p) {
    unsigned char* ws = F.ws;
    LAS float* sil = (LAS float*)(F.lds + 69632);
    for (int i = F.tid; i < 5 * DM; i += NTHR) { const int v = i / DM, k = i % DM; const float x = v < 4 ? p.in[I_C][v * DM + k] : p.in[I_CCTX][k]; sil[i] = x / (1.0f + __expf(-x)); }
    { const int gt = blockIdx.x * NTHR + F.tid;
      if (gt < 1024) { const int pos = gt >> 4, i = gt & 15; const float inv = powf(10000.0f, -(float)(2 * i) / 32.0f); const float ang = (float)pos * inv;
          ((f32x2*)(ws + WS_ROPE))[gt] = (f32x2){cosf(ang), sinf(ang)}; } }
    { constexpr int WIN_ES = DFP8_IN ? 1 : 2; u32x4* z = (u32x4*)(ws + WS_WIN + (size_t)ABIN * DM * WIN_ES); const int n16 = (ABINP - ABIN) * DM * WIN_ES / 16;
      for (int i = blockIdx.x * NTHR + F.tid; i < n16; i += F.G * NTHR) z[i] = (u32x4){0u, 0u, 0u, 0u}; }
    __syncthreads();
    if (F.wave < 3) {
        for (int item = blockIdx.x * 3 + F.wave; item < 768; item += F.G * 3) {
            const int l = item / 384, rem = item % 384, cg = rem >> 3, kc = rem & 7;
            const float* wp = p.in[I_ADAW] + ((size_t)l * DM + kc * 256) * 12288 + cg * 256 + F.lane * 4;
            f32x4 a0 = {0.f, 0.f, 0.f, 0.f}, a1 = a0, a2 = a0, a3 = a0, a4 = a0;
#pragma unroll 8
            for (int kk = 0; kk < 256; ++kk) { const f32x4 w = *(const f32x4*)(wp + (size_t)kk * 12288); const int k = kc * 256 + kk;
                a0 += w * sil[k]; a1 += w * sil[DM + k]; a2 += w * sil[2 * DM + k]; a3 += w * sil[3 * DM + k]; a4 += w * sil[4 * DM + k]; }
            float* o = (float*)(ws + WS_MODP) + ((size_t)(kc * 2 + l) * 5) * 12288 + cg * 256 + F.lane * 4;
            *(f32x4*)(o) = a0; *(f32x4*)(o + 12288) = a1; *(f32x4*)(o + 2 * 12288) = a2; *(f32x4*)(o + 3 * 12288) = a3; *(f32x4*)(o + 4 * 12288) = a4;
        }
    }
    LAS float* scr = (LAS float*)(F.lds + F.wave * 8448);
    const int gw = F.vcu * NWAVES + F.wave, NGW = F.G * NWAVES;
    constexpr int I_WIN = (DM / 64) * (ABIN / 32), I_WO = (DM / 64) * (DM / 32), I_UQ = (512 / 64) * (1536 / 32), I_UKV = (512 / 64) * (2048 / 32);
    constexpr int I_G1 = 8, I_GALL = 32 * I_G1, I_QKV = (DM / 64) * (6144 / 32), I_MOE1 = 1408;
    constexpr int NITEMS = I_WIN + I_WO + I_UQ + I_UKV + I_GALL + I_QKV + I_WO + 102 * I_MOE1;
    for (int it = gw; it < NITEMS; it += NGW) {
        int r = it;
#if DFP8_IN
        if (r < I_WIN) { xpose_job8(p.in[I_ABWIN], DM, ABIN, ws + WS_WIN, r, scr, F.lane); continue; } r -= I_WIN;
#else
        if (r < I_WIN) { xpose_job(p.in[I_ABWIN], DM, ABIN, (bf16*)(ws + WS_WIN), r, scr, F.lane); continue; } r -= I_WIN;
#endif
#if DFP8_OUT0
        if (r < I_WO) { xpose_job8(p.in[I_ABWOUT], DM, DM, ws + WS_WOUT0, r, scr, F.lane); continue; } r -= I_WO;
#else
        if (r < I_WO) { xpose_job(p.in[I_ABWOUT], DM, DM, (bf16*)(ws + WS_WOUT0), r, scr, F.lane); continue; } r -= I_WO;
#endif
        if (r < I_UQ) { xpose_job(p.in[I_WUQ], 512, 1536, (bf16*)(ws + WS_WUQ), r, scr, F.lane); continue; } r -= I_UQ;
        if (r < I_UKV) { xpose_job(p.in[I_WUKV], 512, 2048, (bf16*)(ws + WS_WUKV), r, scr, F.lane); continue; } r -= I_UKV;
        if (r < I_GALL) { const int mi = r / I_G1, rr = r % I_G1;
            const int g = mi >> 3, blk = mi & 7, dir = g >> 1, ty = g & 1;
            const float* src = (ty ? p.in[I_LWI] : p.in[I_LWA]) + (size_t)(dir * 8 + blk) * 128 * 128;
            xpose_job(src, 128, 128, (bf16*)(ws + WS_WG) + (size_t)mi * 128 * 128, rr, scr, F.lane); continue; } r -= I_GALL;
#if DFP8_QKV
        if (r < I_QKV) { xpose_job8(p.in[I_NAWQKV], DM, 6144, ws + WS_WQKV, r, scr, F.lane); continue; } r -= I_QKV;
#else
        if (r < I_QKV) { xpose_job(p.in[I_NAWQKV], DM, 6144, (bf16*)(ws + WS_WQKV), r, scr, F.lane); continue; } r -= I_QKV;
#endif
#if DFP8_OUT1
        if (r < I_WO) { xpose_job8(p.in[I_NAWOUT], DM, DM, ws + WS_WOUT1, r, scr, F.lane); continue; } r -= I_WO;
#else
        if (r < I_WO) { xpose_job(p.in[I_NAWOUT], DM, DM, (bf16*)(ws + WS_WOUT1), r, scr, F.lane); continue; } r -= I_WO;
#endif
        { const int m = r / I_MOE1, rr = r % I_MOE1, l = m / 51, mm = m % 51, which = mm / 17, e = mm % 17;
          if (which < 2) {
              const float* src = which == 0 ? (e < 16 ? p.in[I_MWG] + (size_t)(l * 16 + e) * DM * DE : p.in[I_MSG] + (size_t)l * DM * DE)
                                            : (e < 16 ? p.in[I_MWU] + (size_t)(l * 16 + e) * DM * DE : p.in[I_MSU] + (size_t)l * DM * DE);
              const int kb = rr / 44, nb = rr % 44, n0 = 32 * nb;
#if MOE_FP8
              xpose_item8(src, DE, ws + WS_W1 + (size_t)(l * 17 + e) * W1_E, DM, 64 * kb, n0, (n0 / 128) * 256 + (n0 % 128) + (which ? 128 : 0), 64.0f, scr, F.lane);
#else
              xpose_item(src, DE, (bf16*)(ws + WS_W1 + (size_t)(l * 17 + e) * W1_E), DM, 64 * kb, n0, (n0 / 128) * 256 + (n0 % 128) + (which ? 128 : 0), scr, F.lane);
#endif
          } else {
              const float* src = e < 16 ? p.in[I_MWD] + (size_t)(l * 16 + e) * DE * DM : p.in[I_MSD] + (size_t)l * DE * DM;
              const int kb = rr / 64, nb = rr % 64;
#if MOE_FP8
              xpose_item8(src, DM, ws + WS_W2 + (size_t)(l * 17 + e) * W2_E, DEP, 64 * kb, 32 * nb, 32 * nb, 64.0f, scr, F.lane);
#else
              xpose_item(src, DM, (bf16*)(ws + WS_W2 + (size_t)(l * 17 + e) * W2_E), DE, 64 * kb, 32 * nb, 32 * nb, scr, F.lane);
#endif
          } }
    }
#if MOE_FP8
    for (int i = blockIdx.x * NTHR + F.tid; i < 2 * 17 * DM * 8; i += F.G * NTHR) { const int row = i >> 3, c = i & 7; *(u32x4*)(ws + WS_W2 + (size_t)row * DEP + DE + 16 * c) = (u32x4){0u, 0u, 0u, 0u}; }
#endif
}

__device__ __forceinline__ void load_row_f32(const float* xrow, int lane, f32x4 (&v)[8]) {
#pragma unroll
    for (int j = 0; j < 8; ++j) v[j] = *(const f32x4*)(xrow + 4 * lane + 256 * j);
}
__device__ __forceinline__ float row_rstd(const f32x4 (&v)[8]) {
    float s = 0.f;
#pragma unroll
    for (int j = 0; j < 8; ++j) s += (v[j].x * v[j].x + v[j].y * v[j].y) + (v[j].z * v[j].z + v[j].w * v[j].w);
    return rsqrtf(wave_sum(s) * (1.0f / DM) + EPS);
}
__device__ __forceinline__ void store_row_bf16(bf16* orow, int lane, const f32x4 (&h)[8]) {
#pragma unroll
    for (int j = 0; j < 8; ++j) { u32x2 w; w.x = pk2(h[j].x, h[j].y); w.y = pk2(h[j].z, h[j].w); *(u32x2*)(orow + 4 * lane + 256 * j) = w; }
}
__device__ __forceinline__ void store_row_fp8(unsigned char* orow, int lane, const f32x4 (&h)[8]) {
#pragma unroll
    for (int j = 0; j < 8; ++j) *(unsigned*)(orow + 4 * lane + 256 * j) = pk4_fp8(h[j].x, h[j].y, h[j].z, h[j].w);
}
__device__ __forceinline__ void p1_modulate0(Frame& F, const Params& p) {
    unsigned char* ws = F.ws;
    const float* modp = (const float*)(ws + WS_MODP);
    { float* mod = (float*)(ws + WS_MOD);
      for (int i = blockIdx.x * NTHR + F.tid; i < 2 * 5 * 12288; i += F.G * NTHR) { const int l = i / (5 * 12288), n = i % 12288; float s = p.in[I_ADAB][l * 12288 + n];
#pragma unroll
          for (int kc = 0; kc < 8; ++kc) s += modp[(size_t)kc * (2 * 5 * 12288) + i];
          mod[i] = s; } }
    LAS float* gs = (LAS float*)F.lds; LAS float* sh = gs + DM;
    for (int g = blockIdx.x; g < NTOK / 64; g += F.G) {
        const int row0 = 64 * g, v = vec_of_row(row0);
        for (int n = F.tid; n < DM; n += NTHR) { float sc = p.in[I_ADAB][DM + n], sf = p.in[I_ADAB][n];
#pragma unroll
            for (int kc = 0; kc < 8; ++kc) { const float* mp = modp + ((size_t)(kc * 2 + 0) * 5 + v) * 12288; sf += mp[n]; sc += mp[DM + n]; }
            gs[n] = p.in[I_NMIXG][n] * (1.0f + sc); sh[n] = sf; }
        __syncthreads();
        for (int i = 0; i < 8; ++i) { const int row = row0 + F.wave + 8 * i;
            const float* xr = row < NCTX ? p.in[I_CTX] + (size_t)row * DM : p.in[I_X] + (size_t)(row - NCTX) * DM;
            f32x4 x[8]; load_row_f32(xr, F.lane, x); const float rstd = row_rstd(x);
#pragma unroll
            for (int j = 0; j < 8; ++j) { const f32x4 gg = *(const LAS f32x4*)(gs + 4 * F.lane + 256 * j), ss = *(const LAS f32x4*)(sh + 4 * F.lane + 256 * j); x[j] = x[j] * rstd * gg + ss; }
#if DFP8_IN
            store_row_fp8(ws + WS_H + (size_t)row * DM, F.lane, x); }
#else
            store_row_bf16((bf16*)(ws + WS_H) + (size_t)row * DM, F.lane, x); }
#endif
        __syncthreads();
    }
}

__device__ __forceinline__ void p3_rank_norms(Frame& F, const Params& p) {
    const bf16* U = (const bf16*)(F.ws + WS_U); bf16* CQN = (bf16*)(F.ws + WS_CQN); bf16* CKVN = (bf16*)(F.ws + WS_CKVN);
    const int gw = blockIdx.x * NWAVES + F.wave, NGW = F.G * NWAVES;
    for (int row = gw; row < NTOK; row += NGW) {
#pragma unroll
        for (int w = 0; w < 2; ++w) {
            const u32x4 v = *(const u32x4*)(U + (size_t)row * ABIN + 2048 + 512 * w + 8 * F.lane);
            float x[8] = {bflo(v.x), bfhi(v.x), bflo(v.y), bfhi(v.y), bflo(v.z), bfhi(v.z), bflo(v.w), bfhi(v.w)};
            float s = 0.f;
#pragma unroll
            for (int j = 0; j < 8; ++j) s += x[j] * x[j];
            const float rstd = rsqrtf(wave_sum(s) * (1.0f / 512.0f) + EPS);
            const float* g = (w ? p.in[I_KVNG] : p.in[I_QNG]) + 8 * F.lane;
            const f32x4 g0 = *(const f32x4*)g, g1 = *(const f32x4*)(g + 4);
            u32x4 o; o.x = pk2(x[0] * rstd * g0.x, x[1] * rstd * g0.y); o.y = pk2(x[2] * rstd * g0.z, x[3] * rstd * g0.w);
            o.z = pk2(x[4] * rstd * g1.x, x[5] * rstd * g1.y); o.w = pk2(x[6] * rstd * g1.z, x[7] * rstd * g1.w);
            *(u32x4*)((w ? CKVN : CQN) + (size_t)row * 512 + 8 * F.lane) = o;
        }
    }
}
struct ScanSt { float A, H; };
__device__ __forceinline__ ScanSt scan_comb(ScanSt s1, ScanSt s2) { return ScanSt{s1.A * s2.A, s1.H * s2.A + s2.H}; }
__device__ __forceinline__ void p3_conv_gates(Frame& F, const Params& p) {
    const bf16* U = (const bf16*)(F.ws + WS_U);
    unsigned* HA = (unsigned*)(F.ws + WS_AB);
    f32x2* AGG = (f32x2*)(F.ws + WS_AGG);
    const bf16* WG = (const bf16*)(F.ws + WS_WG);
    LAS float* xcf = (LAS float*)F.lds;
    LAS unsigned char* xab = F.lds + 64 * 129 * 4;
    LAS unsigned* ot = (LAS unsigned*)(F.lds + 51200);
    const int tid = F.tid, lane = F.lane, w = F.wave, g4 = lane >> 4;
    for (int item = blockIdx.x; item < (NTOK / 64) * 8; item += F.G) {
        const int tt = item >> 3, n = item & 7;
        int row0, pos0, slen, bb_, pc;
        if (tt < 16) { bb_ = tt >> 2; pc = tt & 3; pos0 = 64 * pc; slen = CTXL; row0 = bb_ * CTXL + pos0; }
        else { const int tl = tt - 16; bb_ = tl >> 6; pc = 4 + (tl & 63); pos0 = 64 * (tl & 63); slen = SEQ; row0 = NCTX + bb_ * SEQ + pos0; }
        { const int i = tid >> 3, cg = tid & 7, ch0 = 128 * n + 16 * cg;
          float accv[16];
#pragma unroll
          for (int c = 0; c < 16; ++c) accv[c] = p.in[I_CONVB][ch0 + c];
#pragma unroll
          for (int j = 0; j < 4; ++j) { const int pos = pos0 + i + j - 2;
              if (pos >= 0 && pos < slen) {
                  const bf16* up = U + (size_t)(row0 + i + j - 2) * ABIN + ch0;
                  const u32x4 v0 = *(const u32x4*)up, v1 = *(const u32x4*)(up + 8);
                  const float x[16] = {bflo(v0.x), bfhi(v0.x), bflo(v0.y), bfhi(v0.y), bflo(v0.z), bfhi(v0.z), bflo(v0.w), bfhi(v0.w),
                                       bflo(v1.x), bfhi(v1.x), bflo(v1.y), bfhi(v1.y), bflo(v1.z), bfhi(v1.z), bflo(v1.w), bfhi(v1.w)};
                  const float* cw = p.in[I_CONVW] + j * DRNN + ch0;
#pragma unroll
                  for (int c = 0; c < 16; ++c) accv[c] += cw[c] * x[c]; } }
#pragma unroll
          for (int c = 0; c < 16; ++c) xcf[i * 129 + 16 * cg + c] = accv[c];
          u32x4 o0, o1; o0.x = pk2(accv[0], accv[1]); o0.y = pk2(accv[2], accv[3]); o0.z = pk2(accv[4], accv[5]); o0.w = pk2(accv[6], accv[7]);
          o1.x = pk2(accv[8], accv[9]); o1.y = pk2(accv[10], accv[11]); o1.z = pk2(accv[12], accv[13]); o1.w = pk2(accv[14], accv[15]);
          *(LAS u32x4*)(xab + i * 272 + 32 * cg) = o0; *(LAS u32x4*)(xab + i * 272 + 32 * cg + 16) = o1; }
        __syncthreads();
        bf16x8 af[4][4];
#pragma unroll
        for (int m = 0; m < 4; ++m)
#pragma unroll
            for (int ks = 0; ks < 4; ++ks) af[m][ks] = *(const LAS bf16x8*)(xab + (16 * m + (lane & 15)) * 272 + (32 * ks + 8 * g4) * 2);
        const int chl = 16 * w + (lane & 15), gch = 128 * n + chl;
#pragma unroll
        for (int d = 0; d < 2; ++d) {
            f32x4 ca[4], ci[4];
#pragma unroll
            for (int m = 0; m < 4; ++m) { ca[m] = (f32x4){0.f, 0.f, 0.f, 0.f}; ci[m] = ca[m]; }
#pragma unroll
            for (int ks = 0; ks < 4; ++ks) {
                const bf16x8 ba = *(const bf16x8*)(WG + ((size_t)((2 * d + 0) * 8 + n) * 128 + chl) * 128 + 32 * ks + 8 * g4);
                const bf16x8 bi = *(const bf16x8*)(WG + ((size_t)((2 * d + 1) * 8 + n) * 128 + chl) * 128 + 32 * ks + 8 * g4);
#pragma unroll
                for (int m = 0; m < 4; ++m) { ca[m] = __builtin_amdgcn_mfma_f32_16x16x32_bf16(af[m][ks], ba, ca[m], 0, 0, 0); ci[m] = __builtin_amdgcn_mfma_f32_16x16x32_bf16(af[m][ks], bi, ci[m], 0, 0, 0); }
            }
            const float ba_ = p.in[I_LBA][d * DRNN + gch], bi_ = p.in[I_LBI][d * DRNN + gch], lam = p.in[I_LAM][d * DRNN + gch];
            const float sp = log1pf(expf(-lam));
            ScanSt el[4][4];
#pragma unroll
            for (int m = 0; m < 4; ++m)
#pragma unroll
                for (int r = 0; r < 4; ++r) { const int i = 16 * m + 4 * g4 + r;
                    const float rg = __builtin_amdgcn_rcpf(1.0f + __expf(-(ca[m][r] + ba_))), ig = __builtin_amdgcn_rcpf(1.0f + __expf(-(ci[m][r] + bi_)));
                    const float la = -8.0f * rg * sp, x2 = 2.0f * la;
                    const float em = -x2 * (1.0f + x2 * (0.5f + x2 * (0.16666667f + x2 * (0.041666668f + x2 * 0.0083333333f))));
                    el[m][r].A = __expf(la); el[m][r].H = __builtin_amdgcn_sqrtf(em) * ig * xcf[i * 129 + chl]; }
#pragma unroll
            for (int m = 0; m < 4; ++m) {
                if (d == 0) { el[m][1] = scan_comb(el[m][0], el[m][1]); el[m][2] = scan_comb(el[m][1], el[m][2]); el[m][3] = scan_comb(el[m][2], el[m][3]); }
                else        { el[m][2] = scan_comb(el[m][3], el[m][2]); el[m][1] = scan_comb(el[m][2], el[m][1]); el[m][0] = scan_comb(el[m][1], el[m][0]); }
            }
            ScanSt pre = ScanSt{1.0f, 0.0f};
#pragma unroll
            for (int mm = 0; mm < 4; ++mm) { const int m = d == 0 ? mm : 3 - mm;
                const ScanSt T = d == 0 ? el[m][3] : el[m][0];
                ScanSt Tg[4];
#pragma unroll
                for (int q = 0; q < 4; ++q) { Tg[q].A = __shfl(T.A, (lane & 15) + 16 * q); Tg[q].H = __shfl(T.H, (lane & 15) + 16 * q); }
                ScanSt ex = pre, tot = pre;
#pragma unroll
                for (int qq = 0; qq < 4; ++qq) { const int q = d == 0 ? qq : 3 - qq;
                    const bool before = d == 0 ? (q < g4) : (q > g4);
                    const ScanSt nx = scan_comb(tot, Tg[q]); tot = nx; if (before) ex = nx; }
#pragma unroll
                for (int r = 0; r < 4; ++r) { const ScanSt f = scan_comb(ex, el[m][r]); const int i = 16 * m + 4 * g4 + r;
                    ot[(d * 64 + i) * 132 + chl] = pk2(f.H, f.A); }
                pre = tot; }
            if (g4 == 0) { const int c = d == 0 ? pc : (pc < 4 ? 3 - pc : 71 - pc); AGG[((size_t)(d * NB + bb_) * NCHUNK + c) * DRNN + gch] = (f32x2){pre.A, pre.H}; }
        }
        __syncthreads();
#pragma unroll
        for (int k = 0; k < 8; ++k) { const int q = tid + NTHR * k, d = q >> 11, rr = (q >> 5) & 63, c4 = (q & 31) * 4;
            const u32x4 v = *(const LAS u32x4*)(ot + (d * 64 + rr) * 132 + c4);
            *(u32x4*)(HA + ((size_t)d * NTOK + row0 + rr) * DRNN + 128 * n + c4) = v; }
        __syncthreads();
    }
}
__device__ __forceinline__ void scan_pass_c(Frame& F) {
    const f32x2* AGG = (const f32x2*)(F.ws + WS_AGG); float* CAR = (float*)(F.ws + WS_CARRY);
    for (int t = blockIdx.x * NTHR + F.tid; t < 2 * NB * DRNN; t += F.G * NTHR) {
        const int ch = t % DRNN, db = t / DRNN;
        float carry = 0.0f;
        for (int c = 0; c < NCHUNK; ++c) { const size_t idx = ((size_t)db * NCHUNK + c) * DRNN + ch; CAR[idx] = carry; const f32x2 ag = AGG[idx]; carry = ag.x * carry + ag.y; }
    }
}
__device__ __forceinline__ void scan_pass_d(Frame& F) {
    const unsigned* HA = (const unsigned*)(F.ws + WS_AB); const float* CAR = (const float*)(F.ws + WS_CARRY);
    const bf16* U = (const bf16*)(F.ws + WS_U); bf16* YC = (bf16*)(F.ws + WS_YC);
    for (int row = blockIdx.x * NWAVES + F.wave; row < NTOK; row += F.G * NWAVES) {
        int b, pc;
        if (row < NCTX) { b = row >> 8; pc = (row & 255) >> 6; } else { const int rl = row - NCTX; b = rl >> 12; pc = 4 + ((rl & 4095) >> 6); }
        const int cb = pc < 4 ? 3 - pc : 71 - pc;
        const float* cf = CAR + ((size_t)(0 * NB + b) * NCHUNK + pc) * DRNN; const float* cbk = CAR + ((size_t)(1 * NB + b) * NCHUNK + cb) * DRNN;
#pragma unroll
        for (int j = 0; j < 4; ++j) { const int c = 4 * F.lane + 256 * j;
            const u32x4 f = *(const u32x4*)(HA + (size_t)row * DRNN + c), bk = *(const u32x4*)(HA + ((size_t)NTOK + row) * DRNN + c);
            const f32x4 c0 = *(const f32x4*)(cf + c), c1 = *(const f32x4*)(cbk + c);
            const u32x2 gt = *(const u32x2*)(U + (size_t)row * ABIN + DRNN + c);
            const float o0 = (bflo(f.x) + bfhi(f.x) * c0.x + bflo(bk.x) + bfhi(bk.x) * c1.x) * bflo(gt.x);
            const float o1 = (bflo(f.y) + bfhi(f.y) * c0.y + bflo(bk.y) + bfhi(bk.y) * c1.y) * bfhi(gt.x);
            const float o2 = (bflo(f.z) + bfhi(f.z) * c0.z + bflo(bk.z) + bfhi(bk.z) * c1.z) * bflo(gt.y);
            const float o3 = (bflo(f.w) + bfhi(f.w) * c0.w + bflo(bk.w) + bfhi(bk.w) * c1.w) * bfhi(gt.y);
#if DFP8_OUT0
            *(unsigned*)((unsigned char*)YC + (size_t)row * DM + c) = pk4_fp8(4.0f * o0, 4.0f * o1, 4.0f * o2, 4.0f * o3); }
#else
            u32x2 o; o.x = pk2(o0, o1); o.y = pk2(o2, o3);
            *(u32x2*)(YC + (size_t)row * DM + c) = o; }
#endif
    }
}

__device__ __forceinline__ void p5_mla_finalize(Frame& F, const Params& p) {
    const bf16* QRAW = (const bf16*)(F.ws + WS_QRAW); const bf16* KVRAW = (const bf16*)(F.ws + WS_KVRAW); const bf16* U = (const bf16*)(F.ws + WS_U);
    bf16* QF = (bf16*)(F.ws + WS_QF); bf16* KF = (bf16*)(F.ws + WS_KF);
    const f32x2* rope = (const f32x2*)(F.ws + WS_ROPE);
    const int lane = F.lane;
    const float gq0 = p.in[I_QHG][lane], gq1 = p.in[I_QHG][64 + lane], gq2 = p.in[I_QHG][128 + lane];
    const float gk0 = p.in[I_KHG][lane], gk1 = p.in[I_KHG][64 + lane], gk2 = p.in[I_KHG][128 + lane];
    const float qs = 0.07216878364870322f * LOG2E;
    const int gw = blockIdx.x * NWAVES + F.wave, NGW = F.G * NWAVES;
    for (int row = gw; row < NTOK; row += NGW) {
        const bool lat = row >= NCTX;
        float cs = 1.0f, sn = 0.0f;
        if (lat) { const int t = (row - NCTX) % SEQ; const int pos = (lane < 32) ? (t / GW) : (t % GW); const f32x2 r = rope[pos * 16 + (lane & 15)]; cs = r.x; sn = r.y; }
        const float kr = bf2f(U[(size_t)row * ABIN + 3072 + lane]);
        const float kr2 = kr * kr;
#pragma unroll
        for (int h = 0; h < MH; ++h) {
            { const bf16* q = QRAW + (size_t)row * 1536 + h * MQK;
              const float v0 = bf2f(q[lane]), v1 = bf2f(q[64 + lane]), v2 = bf2f(q[128 + lane]);
              const float rstd = rsqrtf(wave_sum(v0 * v0 + v1 * v1 + v2 * v2) * (1.0f / MQK) + EPS);
              const float o0 = v0 * rstd * gq0, o1 = v1 * rstd * gq1; float o2 = v2 * rstd * gq2;
              const float pr = __shfl_xor(o2, 16);
              if (lat) o2 = (lane & 16) ? (pr * sn + o2 * cs) : (o2 * cs - pr * sn);
              bf16* qo = QF + ((size_t)row * MH + h) * MQK;
              qo[lane] = (bf16)f2bf(o0 * qs); qo[64 + lane] = (bf16)f2bf(o1 * qs); qo[128 + lane] = (bf16)f2bf(o2 * qs); }
            { const bf16* k = KVRAW + (size_t)row * 2048 + h * 256;
              const float v0 = bf2f(k[lane]), v1 = bf2f(k[64 + lane]);
              const float rstd = rsqrtf(wave_sum(v0 * v0 + v1 * v1 + kr2) * (1.0f / MQK) + EPS);
              const float o0 = v0 * rstd * gk0, o1 = v1 * rstd * gk1; float o2 = kr * rstd * gk2;
              const float pr = __shfl_xor(o2, 16);
              if (lat) o2 = (lane & 16) ? (pr * sn + o2 * cs) : (o2 * cs - pr * sn);
              bf16* ko = KF + ((size_t)row * MH + h) * MQK;
              ko[lane] = (bf16)f2bf(o0); ko[64 + lane] = (bf16)f2bf(o1); ko[128 + lane] = (bf16)f2bf(o2); }
        }
    }
}

__device__ __forceinline__ int crow(int r, int hi) { return (r & 3) + 8 * (r >> 2) + 4 * hi; }
__device__ __forceinline__ int v_st(int k, int c) { const int kk = (k & ~0xC) | ((k & 4) << 1) | ((k & 8) >> 1); return ((kk >> 3) * 4 + (c >> 5)) * 512 + ((kk & 7) * 32 + (c & 31)) * 2; }
__device__ __forceinline__ int v_rd_base(int lane) { return ((lane & 3) << 3) | (((lane >> 2) & 3) << 6) | (((lane >> 4) & 1) << 5) | (((lane >> 5) & 1) << 8); }
constexpr int v_rd_off(int d0, int ks, int half) { return d0 * 512 + ks * 4096 + half * 2048; }
template <int OFF> __device__ __forceinline__ s16x4 tr_read(int vb) {
    s16x4 r; asm volatile("ds_read_b64_tr_b16 %0, %1 offset:%2" : "=&v"(r) : "v"(vb), "i"(OFF) : "memory"); return r;
}
template <int D0> __device__ __forceinline__ void pv_load(s16x4 (&v)[8], int vb) {
    v[0] = tr_read<v_rd_off(D0, 0, 0)>(vb); v[1] = tr_read<v_rd_off(D0, 0, 1)>(vb); v[2] = tr_read<v_rd_off(D0, 1, 0)>(vb); v[3] = tr_read<v_rd_off(D0, 1, 1)>(vb);
    v[4] = tr_read<v_rd_off(D0, 2, 0)>(vb); v[5] = tr_read<v_rd_off(D0, 2, 1)>(vb); v[6] = tr_read<v_rd_off(D0, 3, 0)>(vb); v[7] = tr_read<v_rd_off(D0, 3, 1)>(vb);
}
__device__ __forceinline__ void pv_mma(f32x16& od, const s16x4 (&v)[8], bf16x8 pa0, bf16x8 pa1, bf16x8 pa2, bf16x8 pa3) {
#define PKV(L, H) (bf16x8){L[0], L[1], L[2], L[3], H[0], H[1], H[2], H[3]}
    od = __builtin_amdgcn_mfma_f32_32x32x16_bf16(pa0, PKV(v[0], v[1]), od, 0, 0, 0);
    od = __builtin_amdgcn_mfma_f32_32x32x16_bf16(pa1, PKV(v[2], v[3]), od, 0, 0, 0);
    od = __builtin_amdgcn_mfma_f32_32x32x16_bf16(pa2, PKV(v[4], v[5]), od, 0, 0, 0);
    od = __builtin_amdgcn_mfma_f32_32x32x16_bf16(pa3, PKV(v[6], v[7]), od, 0, 0, 0);
#undef PKV
}
__device__ __forceinline__ void pv_d0(f32x16* o, int vb, bf16x8 pa0, bf16x8 pa1, bf16x8 pa2, bf16x8 pa3) {
    s16x4 va[8], vbb[8];
    pv_load<0>(va, vb);
    pv_load<1>(vbb, vb); asm volatile("s_waitcnt lgkmcnt(8)" ::: "memory"); __builtin_amdgcn_sched_barrier(0);
    pv_mma(o[0], va, pa0, pa1, pa2, pa3); __builtin_amdgcn_sched_barrier(0);
    pv_load<2>(va, vb); asm volatile("s_waitcnt lgkmcnt(8)" ::: "memory"); __builtin_amdgcn_sched_barrier(0);
    pv_mma(o[1], vbb, pa0, pa1, pa2, pa3); __builtin_amdgcn_sched_barrier(0);
    pv_load<3>(vbb, vb); asm volatile("s_waitcnt lgkmcnt(8)" ::: "memory"); __builtin_amdgcn_sched_barrier(0);
    pv_mma(o[2], va, pa0, pa1, pa2, pa3); __builtin_amdgcn_sched_barrier(0);
    asm volatile("s_waitcnt lgkmcnt(0)" ::: "memory"); __builtin_amdgcn_sched_barrier(0);
    pv_mma(o[3], vbb, pa0, pa1, pa2, pa3);
}
__device__ __forceinline__ void pack_p(const f32x16& p0, const f32x16& p1, bf16x8& pa0, bf16x8& pa1, bf16x8& pa2, bf16x8& pa3) {
#define PK4(P, BASE, OUT) do { unsigned a0 = cvt_pk_bf16(P[BASE + 0], P[BASE + 1]), a1 = cvt_pk_bf16(P[BASE + 2], P[BASE + 3]);   \
    unsigned b0 = cvt_pk_bf16(P[BASE + 4], P[BASE + 5]), b1 = cvt_pk_bf16(P[BASE + 6], P[BASE + 7]);                              \
    auto r0 = __builtin_amdgcn_permlane32_swap(a0, b0, false, false); auto r1 = __builtin_amdgcn_permlane32_swap(a1, b1, false, false); \
    u32x4 w = {r0[0], r1[0], r0[1], r1[1]}; OUT = __builtin_bit_cast(bf16x8, w); } while (0)
    PK4(p0, 0, pa0); PK4(p0, 8, pa1); PK4(p1, 0, pa2); PK4(p1, 8, pa3);
#undef PK4
}
template <int DQK> struct AttnG {
    static constexpr int CPR = DQK / 8, KSTR = DQK * 2 + 16, KBYTES = 64 * KSTR, NKCH = (64 * CPR) / 512, ND0 = DQK / 16;
    static constexpr int VOFF = 2 * KBYTES, LIOFF = VOFF + 2 * 16384, END = LIOFF + 8 * 128;
};
template <int DQK> __device__ __forceinline__ void attn_tile_load(bf16x8 (&kreg)[AttnG<DQK>::NKCH], bf16x8 (&vreg)[2], const bf16* kt, int ldk, const bf16* vt, int ldv, int tid) {
    using G = AttnG<DQK>;
#pragma unroll
    for (int i = 0; i < G::NKCH; ++i) { const int q = tid + 512 * i, row = q / G::CPR, ch = q % G::CPR; kreg[i] = *(const bf16x8*)(kt + (size_t)row * ldk + ch * 8); }
    const int sr = tid >> 4, sc = (tid & 15) * 8;
    vreg[0] = *(const bf16x8*)(vt + (size_t)sr * ldv + sc); vreg[1] = *(const bf16x8*)(vt + (size_t)(32 + sr) * ldv + sc);
}
template <int DQK> __device__ __forceinline__ void attn_tile_write(const bf16x8 (&kreg)[AttnG<DQK>::NKCH], const bf16x8 (&vreg)[2], LAS unsigned char* kb, LAS unsigned char* vbuf, int tid) {
    using G = AttnG<DQK>;
#pragma unroll
    for (int i = 0; i < G::NKCH; ++i) { const int q = tid + 512 * i, row = q / G::CPR, ch = q % G::CPR; *(LAS bf16x8*)(kb + row * G::KSTR + ch * 16) = kreg[i]; }
    const int sr = tid >> 4, sc = (tid & 15) * 8;
    *(LAS bf16x8*)(vbuf + v_st(sr, sc)) = vreg[0]; *(LAS bf16x8*)(vbuf + v_st(32 + sr, sc)) = vreg[1];
}
template <int DQK> __device__ __forceinline__ void attn_qkt(f32x16& p0, f32x16& p1, const LAS unsigned char* kb, const bf16x8 (&qr)[AttnG<DQK>::ND0], int r32, int hi) {
    using G = AttnG<DQK>;
    constexpr int NGRP = G::ND0 / 2;
#pragma unroll
    for (int r = 0; r < 16; ++r) { p0[r] = 0.f; p1[r] = 0.f; }
    const LAS unsigned char* k0 = kb + r32 * G::KSTR + hi * 16; const LAS unsigned char* k1 = k0 + 32 * G::KSTR;
    bf16x8 fa[4], fb[4];
#define QK_LOAD(f, g) do { f[0] = *(const LAS bf16x8*)(k0 + (2 * (g)) * 32); f[1] = *(const LAS bf16x8*)(k1 + (2 * (g)) * 32); \
        f[2] = *(const LAS bf16x8*)(k0 + (2 * (g) + 1) * 32); f[3] = *(const LAS bf16x8*)(k1 + (2 * (g) + 1) * 32); } while (0)
#define QK_MMA(f, g) do { p0 = __builtin_amdgcn_mfma_f32_32x32x16_bf16(f[0], qr[2 * (g)], p0, 0, 0, 0); p1 = __builtin_amdgcn_mfma_f32_32x32x16_bf16(f[1], qr[2 * (g)], p1, 0, 0, 0); \
        p0 = __builtin_amdgcn_mfma_f32_32x32x16_bf16(f[2], qr[2 * (g) + 1], p0, 0, 0, 0); p1 = __builtin_amdgcn_mfma_f32_32x32x16_bf16(f[3], qr[2 * (g) + 1], p1, 0, 0, 0); } while (0)
    QK_LOAD(fa, 0);
#pragma unroll
    for (int g = 0; g < NGRP; g += 2) {
        if (g + 1 < NGRP) { QK_LOAD(fb, g + 1); asm volatile("s_waitcnt lgkmcnt(4)" ::: "memory"); } else asm volatile("s_waitcnt lgkmcnt(0)" ::: "memory");
        __builtin_amdgcn_sched_barrier(0); QK_MMA(fa, g); __builtin_amdgcn_sched_barrier(0);
        if (g + 1 < NGRP) {
            if (g + 2 < NGRP) { QK_LOAD(fa, g + 2); asm volatile("s_waitcnt lgkmcnt(4)" ::: "memory"); } else asm volatile("s_waitcnt lgkmcnt(0)" ::: "memory");
            __builtin_amdgcn_sched_barrier(0); QK_MMA(fb, g + 1); __builtin_amdgcn_sched_barrier(0);
        }
    }
#undef QK_LOAD
#undef QK_MMA
}
template <bool F8, int SC> __device__ __forceinline__ void attn_store(const f32x16 (&o)[4], float lsum, LAS float* li, void* orow0v, int ldo, int r32, int hi) {
    lsum += __shfl_xor(lsum, 32);
    if (hi == 0) li[r32] = lsum;
    LDS_WAIT();
    float rli[16];
#pragma unroll
    for (int r = 0; r < 16; ++r) rli[r] = (float)SC / li[crow(r, hi)];
    if constexpr (F8) { unsigned char* orow0 = (unsigned char*)orow0v;
#pragma unroll
        for (int r = 0; r < 16; ++r) { unsigned char* op = orow0 + (size_t)crow(r, hi) * ldo + r32;
#pragma unroll
            for (int d0 = 0; d0 < 4; ++d0) op[d0 * 32] = (unsigned char)(pk4_fp8(o[d0][r] * rli[r], 0.f, 0.f, 0.f) & 0xffu); }
    } else { bf16* orow0 = (bf16*)orow0v;
#pragma unroll
        for (int r = 0; r < 16; ++r) { bf16* op = orow0 + (size_t)crow(r, hi) * ldo + r32;
#pragma unroll
            for (int d0 = 0; d0 < 4; ++d0) op[d0 * 32] = (bf16)f2bf(o[d0][r] * rli[r]); } }
    LDS_WAIT();
}

__device__ __forceinline__ void mla_unit(Frame& F, int b, int h, int qrow0, int ntile) {
    using G = AttnG<MQK>;
    const bf16* QF = (const bf16*)(F.ws + WS_QF); const bf16* KF = (const bf16*)(F.ws + WS_KF); const bf16* KVRAW = (const bf16*)(F.ws + WS_KVRAW);
    bf16* YC = (bf16*)(F.ws + WS_YC);
    const int tid = F.tid, lane = F.lane, r32 = lane & 31, hi = lane >> 5, wid = F.wave;
    LAS unsigned char* lds = F.lds;
    LAS float* li = (LAS float*)(lds + G::LIOFF + wid * 128);
    bf16x8 qr[G::ND0];
    { const bf16* qp = QF + ((size_t)(qrow0 + wid * 32 + r32) * MH + h) * MQK + hi * 8;
#pragma unroll
      for (int d0 = 0; d0 < G::ND0; ++d0) qr[d0] = *(const bf16x8*)(qp + d0 * 16); }
    f32x16 o[4];
#pragma unroll
    for (int d = 0; d < 4; ++d)
#pragma unroll
        for (int r = 0; r < 16; ++r) o[d][r] = 0.f;
    float lsum = 0.f;
    const int vb0 = (int)(unsigned)(uintptr_t)(lds + G::VOFF) + v_rd_base(lane);
    bf16x8 kreg[G::NKCH], vreg[2];
#define MLA_TROW(j) ((j) < 4 ? b * CTXL + 64 * (j) : NCTX + b * SEQ + 64 * ((j) - 4))
    { const int tr = MLA_TROW(0); attn_tile_load<MQK>(kreg, vreg, KF + ((size_t)tr * MH + h) * MQK, MH * MQK, KVRAW + (size_t)tr * 2048 + h * 256 + 128, 2048, tid); }
    attn_tile_write<MQK>(kreg, vreg, lds, lds + G::VOFF, tid);
    __syncthreads();
    for (int j = 0; j < ntile; ++j) {
        const int cur = j & 1;
        if (j + 1 < ntile) { const int tr = MLA_TROW(j + 1); attn_tile_load<MQK>(kreg, vreg, KF + ((size_t)tr * MH + h) * MQK, MH * MQK, KVRAW + (size_t)tr * 2048 + h * 256 + 128, 2048, tid); }
        f32x16 p0, p1;
        attn_qkt<MQK>(p0, p1, lds + cur * G::KBYTES, qr, r32, hi);
#pragma unroll
        for (int r = 0; r < 16; ++r) { p0[r] = __builtin_amdgcn_exp2f(p0[r]); p1[r] = __builtin_amdgcn_exp2f(p1[r]); }
        float ps = 0.f;
#pragma unroll
        for (int r = 0; r < 16; ++r) ps += p0[r] + p1[r];
        lsum += ps;
        bf16x8 pa0, pa1, pa2, pa3; pack_p(p0, p1, pa0, pa1, pa2, pa3);
        pv_d0(o, vb0 + cur * 16384, pa0, pa1, pa2, pa3);
        if (j + 1 < ntile) attn_tile_write<MQK>(kreg, vreg, lds + (cur ^ 1) * G::KBYTES, lds + G::VOFF + (cur ^ 1) * 16384, tid);
        __syncthreads();
    }
#undef MLA_TROW
#if DFP8_OUT0
    attn_store<true, 4>(o, lsum, li, (unsigned char*)YC + (size_t)(qrow0 + wid * 32) * DM + DRNN + h * MV, DM, r32, hi);
#else
    attn_store<false, 1>(o, lsum, li, YC + (size_t)(qrow0 + wid * 32) * DM + DRNN + h * MV, DM, r32, hi);
#endif
    __syncthreads();
}
__device__ __forceinline__ void p6_mla_attention(Frame& F) {
    for (int U = F.vcu; U < 544; U += F.G) {
        int b, h, qrow0, ntile;
        if (U < 512) { const int bh = U >> 4, qb = U & 15; b = bh >> 3; h = bh & 7; qrow0 = NCTX + b * SEQ + qb * 256; ntile = 68; }
        else { const int bh = U - 512; b = bh >> 3; h = bh & 7; qrow0 = b * CTXL; ntile = 4; }
        mla_unit(F, b, h, qrow0, ntile);
    }
}

__device__ __forceinline__ void p15_na_finalize(Frame& F, const Params& p) {
    bf16* QKV = (bf16*)(F.ws + WS_QKV);
    const int lane = F.lane;
    const float gq0 = p.in[I_NAQHG][lane], gq1 = p.in[I_NAQHG][64 + lane], gk0 = p.in[I_NAKHG][lane], gk1 = p.in[I_NAKHG][64 + lane];
    const float qs = 0.08838834764831845f * LOG2E;
    const int gw = blockIdx.x * NWAVES + F.wave, NGW = F.G * NWAVES;
    for (int row = gw; row < NTOK; row += NGW) {
        bf16* rp = QKV + (size_t)row * 6144;
        if (row >= NCTX) {
#pragma unroll 4
            for (int h = 0; h < NAH; ++h) { bf16* q = rp + h * NAD; const float v0 = bf2f(q[lane]), v1 = bf2f(q[64 + lane]);
                const float rstd = rsqrtf(wave_sum(v0 * v0 + v1 * v1) * (1.0f / NAD) + EPS);
                q[lane] = (bf16)f2bf(v0 * rstd * gq0 * qs); q[64 + lane] = (bf16)f2bf(v1 * rstd * gq1 * qs); } }
#pragma unroll 4
        for (int h = 0; h < NAH; ++h) { bf16* k = rp + DM + h * NAD; const float v0 = bf2f(k[lane]), v1 = bf2f(k[64 + lane]);
            const float rstd = rsqrtf(wave_sum(v0 * v0 + v1 * v1) * (1.0f / NAD) + EPS);
            k[lane] = (bf16)f2bf(v0 * rstd * gk0); k[64 + lane] = (bf16)f2bf(v1 * rstd * gk1); }
    }
}
__device__ __forceinline__ void na_unit(Frame& F, const Params& p, int b, int h, int R0) {
    using G = AttnG<NAD>;
    const bf16* QKV = (const bf16*)(F.ws + WS_QKV); bf16* ATT = (bf16*)(F.ws + WS_ATT2);
    const int tid = F.tid, lane = F.lane, r32 = lane & 31, hi = lane >> 5, wid = F.wave;
    LAS unsigned char* lds = F.lds;
    LAS float* li = (LAS float*)(lds + G::LIOFF + wid * 128);
    LAS float* rpbl = (LAS float*)(lds + G::END);
    for (int i = tid; i < 15 * 32; i += NTHR) { const int dr = i >> 5, dc = i & 31; rpbl[i] = dc < 31 ? p.in[I_RPB][(h * 15 + dr) * 31 + dc] * LOG2E : 0.f; }
    const int rq = R0 + (wid >> 1), qc = 32 * (wid & 1) + r32;
    const int qrow = NCTX + b * SEQ + rq * GW + qc;
    bf16x8 qr[G::ND0];
    { const bf16* qp = QKV + (size_t)qrow * 6144 + h * NAD + hi * 8;
#pragma unroll
      for (int d0 = 0; d0 < G::ND0; ++d0) qr[d0] = *(const bf16x8*)(qp + d0 * 16); }
    f32x16 o[4];
#pragma unroll
    for (int d = 0; d < 4; ++d)
#pragma unroll
        for (int r = 0; r < 16; ++r) o[d][r] = 0.f;
    float lsum = 0.f;
    const int vb0 = (int)(unsigned)(uintptr_t)(lds + G::VOFF) + v_rd_base(lane);
    const int klo = min(max(R0 - 4, 0), 56), khi = min(max(R0 + 3 - 4, 0), 56) + 7, nloc = khi - klo + 1, ntile = nloc + 4;
    const int w0 = min(max(rq - 4, 0), 56);
    const int cst = min(max(qc - 8, 0), 48);
    bf16x8 kreg[G::NKCH], vreg[2];
#define NA_TROW(j) ((j) < nloc ? NCTX + b * SEQ + (klo + (j)) * GW : b * CTXL + 64 * ((j) - nloc))
    { const int tr = NA_TROW(0); attn_tile_load<NAD>(kreg, vreg, QKV + (size_t)tr * 6144 + DM + h * NAD, 6144, QKV + (size_t)tr * 6144 + 2 * DM + h * NAD, 6144, tid); }
    attn_tile_write<NAD>(kreg, vreg, lds, lds + G::VOFF, tid);
    __syncthreads();
    for (int j = 0; j < ntile; ++j) {
        const int cur = j & 1;
        if (j + 1 < ntile) { const int tr = NA_TROW(j + 1); attn_tile_load<NAD>(kreg, vreg, QKV + (size_t)tr * 6144 + DM + h * NAD, 6144, QKV + (size_t)tr * 6144 + 2 * DM + h * NAD, 6144, tid); }
        const bool local = j < nloc; const int krow = klo + j;
        if (!local || (krow >= w0 && krow < w0 + 8)) {
            f32x16 p0, p1;
            attn_qkt<NAD>(p0, p1, lds + cur * G::KBYTES, qr, r32, hi);
            if (local) {
                const LAS float* brow = rpbl + (krow - rq + 7) * 32 + (15 - qc);
#pragma unroll
                for (int r = 0; r < 16; ++r) {
                    const int kc0 = crow(r, hi), kc1 = 32 + kc0;
                    const bool ok0 = kc0 >= cst && kc0 < cst + 16, ok1 = kc1 >= cst && kc1 < cst + 16;
                    const float b0 = ok0 ? brow[kc0] : 0.f, b1 = ok1 ? brow[kc1] : 0.f;
                    p0[r] = ok0 ? __builtin_amdgcn_exp2f(p0[r] + b0) : 0.f; p1[r] = ok1 ? __builtin_amdgcn_exp2f(p1[r] + b1) : 0.f; }
            } else {
#pragma unroll
                for (int r = 0; r < 16; ++r) { p0[r] = __builtin_amdgcn_exp2f(p0[r]); p1[r] = __builtin_amdgcn_exp2f(p1[r]); }
            }
            float ps = 0.f;
#pragma unroll
            for (int r = 0; r < 16; ++r) ps += p0[r] + p1[r];
            lsum += ps;
            bf16x8 pa0, pa1, pa2, pa3; pack_p(p0, p1, pa0, pa1, pa2, pa3);
            pv_d0(o, vb0 + cur * 16384, pa0, pa1, pa2, pa3);
        }
        if (j + 1 < ntile) attn_tile_write<NAD>(kreg, vreg, lds + (cur ^ 1) * G::KBYTES, lds + G::VOFF + (cur ^ 1) * 16384, tid);
        __syncthreads();
    }
#undef NA_TROW
#if DFP8_OUT1
    attn_store<true, 8>(o, lsum, li, (unsigned char*)ATT + (size_t)(NCTX + b * SEQ + rq * GW + 32 * (wid & 1)) * DM + h * NAD, DM, r32, hi);
#else
    attn_store<false, 1>(o, lsum, li, ATT + (size_t)(NCTX + b * SEQ + rq * GW + 32 * (wid & 1)) * DM + h * NAD, DM, r32, hi);
#endif
    __syncthreads();
}
__device__ __forceinline__ void p16_na_attention(Frame& F, const Params& p) {
    for (int rnd = 0; rnd < 4; ++rnd)
        for (int U = rnd * 256 + F.vcu; U < rnd * 256 + 256; U += F.G) { const int bh = U >> 4, rg = U & 15, b = bh >> 4, h = bh & 15; na_unit(F, p, b, h, 4 * rg); }
}

__device__ __forceinline__ void p8_h2_route(Frame& F, const Params& p, int l, const float* X, int rbase) {
    unsigned char* ws = F.ws;
    LAS float* wt = (LAS float*)F.lds;
    for (int i = F.tid; i < DM * NE; i += NTHR) { const int k = i >> 4, e = i & 15; wt[e * DM + k] = p.in[I_RW][i]; }
    volatile LAS unsigned* lcnt = F.MISC + 16; volatile LAS unsigned* lbase = F.MISC + 32;
    LAS int* lrec = (LAS int*)(F.MISC + 64);
    if (F.tid < 16) lcnt[F.tid] = 0u;
    __syncthreads();
    const float* mod = (const float*)(ws + WS_MOD) + (size_t)l * 5 * 12288;
    const float* gn = p.in[I_NFFNG] + l * DM;
    float rb[16];
#pragma unroll
    for (int e = 0; e < 16; ++e) rb[e] = p.in[I_RB][e];
    int it = 0;
    for (int row = rbase + blockIdx.x * NWAVES + F.wave; row < NTOK; row += F.G * NWAVES, ++it) {
        const int v = vec_of_row(row);
        f32x4 x[8]; load_row_f32(X + (size_t)row * DM, F.lane, x); const float rstd = row_rstd(x);
        const float* mv = mod + (size_t)v * 12288;
#pragma unroll
        for (int j = 0; j < 8; ++j) { const int c = 4 * F.lane + 256 * j; const f32x4 g = *(const f32x4*)(gn + c), sc = *(const f32x4*)(mv + 4 * DM + c), sh = *(const f32x4*)(mv + 3 * DM + c);
            x[j] = x[j] * rstd * g * (1.0f + sc) + sh; }
#if MOE_FP8
#pragma unroll
        for (int j = 0; j < 8; ++j) *(unsigned*)(ws + WS_H + (size_t)row * DM + 4 * F.lane + 256 * j) = pk4_fp8(x[j].x, x[j].y, x[j].z, x[j].w);
#else
        store_row_bf16((bf16*)(ws + WS_H) + (size_t)row * DM, F.lane, x);
#endif
        float lg[16];
#pragma unroll
        for (int e = 0; e < 16; ++e) { float s = 0.f; if ((e & 3) == 0) __builtin_amdgcn_sched_barrier(0);
#pragma unroll
            for (int j = 0; j < 8; ++j) { const f32x4 w = *(const LAS f32x4*)(wt + e * DM + 4 * F.lane + 256 * j); s += (x[j].x * w.x + x[j].y * w.y) + (x[j].z * w.z + x[j].w * w.w); }
            lg[e] = wave_sum(s); }
        float sc[16], sel[16];
#pragma unroll
        for (int e = 0; e < 16; ++e) { sc[e] = 1.0f / (1.0f + expf(-lg[e])); sel[e] = sc[e] + rb[e]; }
        int best = 0; float bestv = -3.0e38f;
#pragma unroll
        for (int g = 0; g < 4; ++g) { float m1 = -3.0e38f, m2 = -3.0e38f;
#pragma unroll
            for (int k = 0; k < 4; ++k) { const float s = sel[4 * g + k]; if (s > m1) { m2 = m1; m1 = s; } else if (s > m2) m2 = s; }
            const float gs = m1 + m2; if (gs > bestv) { bestv = gs; best = g; } }
        int e0 = 0, e1 = 0; float s0 = -3.0e38f, s1 = -3.0e38f, w0 = 0.f, w1 = 0.f;
#pragma unroll
        for (int e = 0; e < 16; ++e) { if ((e >> 2) == best) { const float s = sel[e];
                if (s > s0) { s1 = s0; e1 = e0; w1 = w0; s0 = s; e0 = e; w0 = sc[e]; } else if (s > s1) { s1 = s; e1 = e; w1 = sc[e]; } } }
        const float wn = 1.0f / (w0 + w1);
        if (F.lane == 0) {
            const int lp0 = (int)__hip_atomic_fetch_add((LAS unsigned*)(lcnt + e0), 1u, __ATOMIC_RELAXED, __HIP_MEMORY_SCOPE_WORKGROUP);
            const int lp1 = (int)__hip_atomic_fetch_add((LAS unsigned*)(lcnt + e1), 1u, __ATOMIC_RELAXED, __HIP_MEMORY_SCOPE_WORKGROUP);
            if (it < 64) { LAS int* r = lrec + (F.wave * 64 + it) * 4; r[0] = e0; r[1] = e1; r[2] = lp0; r[3] = lp1; }
            ((int*)(ws + WS_TOKE))[2 * row] = e0; ((int*)(ws + WS_TOKE))[2 * row + 1] = e1;
            ((float*)(ws + WS_TOKW))[2 * row] = w0 * wn; ((float*)(ws + WS_TOKW))[2 * row + 1] = w1 * wn;
        }
    }
    __syncthreads();
    if (F.tid < 16) { const unsigned n = lcnt[F.tid]; lbase[F.tid] = n ? __hip_atomic_fetch_add(F.ctl + CW_CNT + (l * 16 + F.tid) * 64, n, RLX_AGENT) : 0u; }
    __syncthreads();
    if (F.lane == 0) { it = 0;
        for (int row = rbase + blockIdx.x * NWAVES + F.wave; row < NTOK; row += F.G * NWAVES, ++it) { if (it >= 64) break;
            const LAS int* r = lrec + (F.wave * 64 + it) * 4;
            ((int*)(ws + WS_TOKP))[2 * row] = (int)lbase[r[0]] + r[2]; ((int*)(ws + WS_TOKP))[2 * row + 1] = (int)lbase[r[1]] + r[3]; } }
    __syncthreads();
}
__device__ __forceinline__ int moe_tiles(Frame& F, int l, int nsh, volatile LAS int* tile_e, int& ntot) {
    int nt_r = 0;
    if (F.tid == 0) { int t = 0;
        for (int e = 0; e < 16; ++e) { const int c = (int)__hip_atomic_load(F.ctl + CW_CNT + (l * 16 + e) * 64, RLX_AGENT); const int n = (c + 255) >> 8; for (int i = 0; i < n; ++i) tile_e[t++] = e; }
        for (int i = 0; i < nsh; ++i) tile_e[t + i] = 16;
        tile_e[255] = t; }
    __syncthreads();
    nt_r = __builtin_amdgcn_readfirstlane(tile_e[255]); ntot = nt_r + nsh;
    return nt_r;
}
__device__ __forceinline__ void p9_scatter(Frame& F, int l, int rbase) {
    unsigned char* ws = F.ws;
    int off[17]; { int t = 0;
#pragma unroll
        for (int e = 0; e < 16; ++e) { off[e] = t * 256; const int c = (int)__hip_atomic_load(F.ctl + CW_CNT + (l * 16 + e) * 64, RLX_AGENT); t += (c + 255) >> 8; }
        off[16] = t * 256; }
    const int* toke = (const int*)(ws + WS_TOKE); const int* tokp = (const int*)(ws + WS_TOKP); int* toks = (int*)(ws + WS_TOKS); int* slottok = (int*)(ws + WS_SLOTTOK);
    for (int i = blockIdx.x * NTHR + F.tid; i < (NTOK - rbase) * 2; i += F.G * NTHR) { const int row = rbase + (i >> 1), k = i & 1;
        const int e = toke[2 * row + k]; int o = 0;
#pragma unroll
        for (int q = 0; q < 16; ++q) o = (e == q) ? off[q] : o;
        const int slot = o + tokp[2 * row + k]; slottok[slot] = row; toks[2 * row + k] = slot; }
    for (int i = blockIdx.x * NTHR + F.tid; i < NTOK - rbase; i += F.G * NTHR) slottok[off[16] + i] = rbase + i;
    for (int i = blockIdx.x * NTHR + F.tid; i < 16 * 256; i += F.G * NTHR) { const int e = i >> 8, j = i & 255; int o = 0, on = 0;
#pragma unroll
        for (int q = 0; q < 16; ++q) { o = (e == q) ? off[q] : o; on = (e == q) ? off[q + 1] : on; }
        const int c = (int)__hip_atomic_load(F.ctl + CW_CNT + (l * 16 + e) * 64, RLX_AGENT);
        if (o + c + j < on) slottok[o + c + j] = rbase; }
}
__device__ __forceinline__ void p12_combine(Frame& F, const Params& p, int l, const float* Xin, float* Xout, int rbase, int sr_off) {
    unsigned char* ws = F.ws;
    const bf16* Y = (const bf16*)(ws + WS_Y);
    const float* mod = (const float*)(ws + WS_MOD) + (size_t)l * 5 * 12288;
    const int* toks = (const int*)(ws + WS_TOKS); const float* tokw = (const float*)(ws + WS_TOKW);
    for (int row = rbase + blockIdx.x * NWAVES + F.wave; row < NTOK; row += F.G * NWAVES) {
        const int v = vec_of_row(row);
        const int s0 = toks[2 * row], s1 = toks[2 * row + 1]; const float w0 = tokw[2 * row], w1 = tokw[2 * row + 1];
        const bf16* y0 = Y + (size_t)s0 * DM; const bf16* y1 = Y + (size_t)s1 * DM; const bf16* ys = Y + (size_t)(sr_off + row - rbase) * DM;
        const float* g5 = mod + (size_t)v * 12288 + 5 * DM;
        f32x4 x[8];
#pragma unroll
        for (int j = 0; j < 8; ++j) { const int c = 4 * F.lane + 256 * j;
            const f32x4 xi = *(const f32x4*)(Xin + (size_t)row * DM + c), g = *(const f32x4*)(g5 + c);
            const u32x2 a = *(const u32x2*)(ys + c), b0 = *(const u32x2*)(y0 + c), b1 = *(const u32x2*)(y1 + c);
            f32x4 m;
            m.x = bflo(a.x) + w0 * bflo(b0.x) + w1 * bflo(b1.x); m.y = bfhi(a.x) + w0 * bfhi(b0.x) + w1 * bfhi(b1.x);
            m.z = bflo(a.y) + w0 * bflo(b0.y) + w1 * bflo(b1.y); m.w = bfhi(a.y) + w0 * bfhi(b0.y) + w1 * bfhi(b1.y);
            x[j] = xi + g * m; }
        if (l == 0) {
#pragma unroll
            for (int j = 0; j < 8; ++j) *(f32x4*)(Xout + (size_t)row * DM + 4 * F.lane + 256 * j) = x[j];
            const float rstd = row_rstd(x);
            const float* m1 = (const float*)(ws + WS_MOD) + (size_t)(5 + v) * 12288; const float* gn = p.in[I_NMIXG] + DM;
#pragma unroll
            for (int j = 0; j < 8; ++j) { const int c = 4 * F.lane + 256 * j; const f32x4 g = *(const f32x4*)(gn + c), sc = *(const f32x4*)(m1 + DM + c), sh = *(const f32x4*)(m1 + c);
                x[j] = x[j] * rstd * g * (1.0f + sc) + sh; }
#if DFP8_QKV
            store_row_fp8(ws + WS_H + (size_t)row * DM, F.lane, x);
#else
            store_row_bf16((bf16*)(ws + WS_H) + (size_t)row * DM, F.lane, x);
#endif
        } else {
#pragma unroll
            for (int j = 0; j < 8; ++j) *(f32x4*)(Xout + (size_t)(row - NCTX) * DM + 4 * F.lane + 256 * j) = x[j];
        }
    }
}

constexpr int NPHASE = 22;
__global__ void __launch_bounds__(NTHR, 2) mega_fwd(Params p) {
    extern __shared__ __attribute__((aligned(16))) unsigned char lds_raw[];
    Frame F;
    F.lds = (LAS unsigned char*)lds_raw; F.MISC = (volatile LAS unsigned*)(F.lds + MISC_OFF);
    F.tid = threadIdx.x; F.lane = F.tid & 63; F.wave = __builtin_amdgcn_readfirstlane(F.tid >> 6);
    F.G = gridDim.x; { const int bx = blockIdx.x; F.vcu = (F.G % 8 == 0) ? (bx % 8) * (F.G / 8) + bx / 8 : bx; }
    F.ws = p.ws; F.ctl = (unsigned*)(p.ws + WS_CTL);
    unsigned char* ws = p.ws;
    for (int u = F.tid; u < (LDS_BYTES - MISC_OFF) / 4; u += NTHR) ((LAS unsigned*)(F.lds + MISC_OFF))[u] = 0u;
    __syncthreads();
    const int lo = p.ph_lo, hi = p.ph_hi;
    XcdBarrier bar; bar.bar = F.ctl + CW_BAR; bar.x = 0; bar.st = F.MISC;
    if (hi - lo > 1) bar = xcd_barrier_post(F.ctl + CW_BAR, F.MISC);
#ifdef ONLY_PHASE
#define IN(k) ((k) == ONLY_PHASE && lo <= (k) && (k) < hi)
#else
#define IN(k) (lo <= (k) && (k) < hi)
#endif
#define SEAM(k) do { if (IN(k) && IN((k) + 1)) xcd_barrier(bar); } while (0)
#ifndef PROBE_DUP
#define PROBE_DUP (-1)
#endif
#ifndef PROBE_DUP2
#define PROBE_DUP2 (-1)
#endif
#define REP(k) for (int _rep = 0; _rep < ((PROBE_DUP == (k) || PROBE_DUP2 == (k)) ? 2 : 1); ++_rep)
    volatile LAS int* tile_e = (volatile LAS int*)(F.MISC + 2112);
#define REFRESH() do { int _tz = threadIdx.x; asm volatile("" : "+v"(_tz)); F.tid = _tz; F.lane = _tz & 63; F.wave = __builtin_amdgcn_readfirstlane(_tz >> 6); } while (0)
    const size_t TS2048 = (size_t)256 * 2048 * 2;

    if (IN(0)) REP(0) { REFRESH(); p0_prologue(F, p); } SEAM(0);
    if (IN(1)) REP(1) { REFRESH(); p1_modulate0(F, p); } SEAM(1);
    if (IN(2)) REP(2) {   REFRESH();
        pg8::DenseSched S; S.T.init(NTOK / 256, ABINP / 256, F.G, (int)blockIdx.x); S.A = (const char*)(ws + WS_H); S.Bt = (const char*)(ws + WS_WIN); S.tstepB = DFP8_IN ? TS2048 / 2 : TS2048; S.row0 = 0;
        EpiU E{(bf16*)(ws + WS_U)};
        pg8::gemm_phase<EpiU, pg8::DenseSched, DFP8_IN != 0>(F.lds, DFP8_IN ? DM : 2 * DM, S, E);
    } SEAM(2);
    if (IN(3)) REP(3) { REFRESH(); p3_rank_norms(F, p); REFRESH(); p3_conv_gates(F, p); } SEAM(3);
    if (IN(4)) REP(4) {   REFRESH();
        { pg8::DenseSched S; S.T.init(NTOK / 256, 1536 / 256, F.G, (int)blockIdx.x); S.A = (const char*)(ws + WS_CQN); S.Bt = (const char*)(ws + WS_WUQ); S.tstepB = (size_t)256 * 512 * 2; S.row0 = 0;
          EpiBf E{(bf16*)(ws + WS_QRAW), 1536};
          pg8::gemm_phase<EpiBf, pg8::DenseSched, false>(F.lds, 2 * 512, S, E); }
        REFRESH();
        { pg8::DenseSched S; S.T.init(NTOK / 256, 2048 / 256, F.G, (int)blockIdx.x); S.A = (const char*)(ws + WS_CKVN); S.Bt = (const char*)(ws + WS_WUKV); S.tstepB = (size_t)256 * 512 * 2; S.row0 = 0;
          EpiBf E{(bf16*)(ws + WS_KVRAW), 2048};
          pg8::gemm_phase<EpiBf, pg8::DenseSched, false>(F.lds, 2 * 512, S, E); }
    } SEAM(4);
    if (IN(5)) REP(5) { REFRESH(); p5_mla_finalize(F, p); scan_pass_c(F); } SEAM(5);
    if (IN(6)) REP(6) { REFRESH(); p6_mla_attention(F); REFRESH(); scan_pass_d(F); } SEAM(6);
    if (IN(7)) REP(7) {   REFRESH();
        pg8::DenseSched S; S.T.init(NTOK / 256, DM / 256, F.G, (int)blockIdx.x); S.A = (const char*)(ws + WS_YC); S.Bt = (const char*)(ws + WS_WOUT0); S.tstepB = DFP8_OUT0 ? TS2048 / 2 : TS2048; S.row0 = 0;
        EpiRes E{p.in[I_CTX], p.in[I_X], (float*)(ws + WS_XA), (const float*)(ws + WS_MOD) + 2 * DM, 0};
        pg8::gemm_phase<EpiRes, pg8::DenseSched, DFP8_OUT0 != 0>(F.lds, DFP8_OUT0 ? DM : 2 * DM, S, E, 0x7d7d7d7du);
    } SEAM(7);

#if MOE_FP8
#define MOE_GEMM1() do { EpiSwiglu8 E{ws + WS_ACT}; pg8::gemm_phase<EpiSwiglu8, pg8::MoeSched, true>(F.lds, DM, S, E); } while (0)
#else
#define MOE_GEMM1() do { EpiSwiglu E{(bf16*)(ws + WS_ACT)}; pg8::gemm_phase<EpiSwiglu, pg8::MoeSched, false>(F.lds, 2 * DM, S, E); } while (0)
#endif
#define MOE_PHASES(l) do { \
        constexpr int pb = (l) ? 17 : 8, rbase = (l) ? NCTX : 0, nsh = (l) ? NLAT / 256 : NTOK / 256; \
        if (IN(pb + 0)) REP(pb + 0) { REFRESH(); p8_h2_route(F, p, (l), (const float*)(ws + WS_XA), rbase); } SEAM(pb + 0); \
        if (IN(pb + 1)) REP(pb + 1) { REFRESH(); p9_scatter(F, (l), rbase); } SEAM(pb + 1); \
        if (IN(pb + 2)) REP(pb + 2) { REFRESH(); \
            int ntot; moe_tiles(F, (l), nsh, tile_e, ntot); \
            pg8::MoeSched S; S.T.init(ntot, 11, F.G, (int)blockIdx.x); S.A = (const char*)(ws + WS_H); S.Bt = (const char*)(ws + WS_W1 + (size_t)(l) * 17 * W1_E); S.tstepB = W1_E / 11; S.estride = W1_E; \
            S.rowmap = (const int*)(ws + WS_SLOTTOK); S.tile_e = tile_e; \
            MOE_GEMM1(); \
        } SEAM(pb + 2); \
        if (IN(pb + 3)) REP(pb + 3) { REFRESH(); \
            int ntot; moe_tiles(F, (l), nsh, tile_e, ntot); \
            pg8::MoeSched S; S.T.init(ntot, 8, F.G, (int)blockIdx.x); S.A = (const char*)(ws + WS_ACT); S.Bt = (const char*)(ws + WS_W2 + (size_t)(l) * 17 * W2_E); S.tstepB = W2_E / 8; S.estride = W2_E; \
            S.rowmap = nullptr; S.tile_e = tile_e; \
            EpiBf E{(bf16*)(ws + WS_Y), DM}; \
            pg8::gemm_phase<EpiBf, pg8::MoeSched, MOE_FP8 != 0>(F.lds, ACT_LD * ACT_ES, S, E); \
        } SEAM(pb + 3); \
        if (IN(pb + 4)) REP(pb + 4) { REFRESH(); \
            int ntot; const int ntr = moe_tiles(F, (l), nsh, tile_e, ntot); \
            p12_combine(F, p, (l), (const float*)(ws + WS_XA), (l) ? p.out : (float*)(ws + WS_XB), rbase, ntr * 256); \
        } SEAM(pb + 4); \
    } while (0)
    MOE_PHASES(0);
    if (IN(13)) REP(13) {   REFRESH();
        pg8::DenseSched S; S.T.init(NTOK / 256, 6144 / 256, F.G, (int)blockIdx.x); S.A = (const char*)(ws + WS_H); S.Bt = (const char*)(ws + WS_WQKV); S.tstepB = DFP8_QKV ? TS2048 / 2 : TS2048; S.row0 = 0;
        EpiBf E{(bf16*)(ws + WS_QKV), 6144};
        pg8::gemm_phase<EpiBf, pg8::DenseSched, DFP8_QKV != 0>(F.lds, DFP8_QKV ? DM : 2 * DM, S, E);
    } SEAM(13);
    if (IN(14)) REP(14) { REFRESH(); p15_na_finalize(F, p); } SEAM(14);
    if (IN(15)) REP(15) { REFRESH(); p16_na_attention(F, p); } SEAM(15);
    if (IN(16)) REP(16) {   REFRESH();
        pg8::DenseSched S; S.T.init(NLAT / 256, DM / 256, F.G, (int)blockIdx.x); S.A = (const char*)(ws + WS_ATT2); S.Bt = (const char*)(ws + WS_WOUT1); S.tstepB = DFP8_OUT1 ? TS2048 / 2 : TS2048; S.row0 = NCTX;
        EpiRes E{(const float*)(ws + WS_XB), (const float*)(ws + WS_XB) + (size_t)NCTX * DM, (float*)(ws + WS_XA), (const float*)(ws + WS_MOD) + (size_t)5 * 12288 + 2 * DM, NCTX};
        pg8::gemm_phase<EpiRes, pg8::DenseSched, DFP8_OUT1 != 0>(F.lds, DFP8_OUT1 ? DM : 2 * DM, S, E, 0x7c7c7c7cu);
    } SEAM(16);
    MOE_PHASES(1);
#undef MOE_PHASES
#undef IN
#undef SEAM
}

extern "C" void kernel_launch(void* const* d_in, const int* in_sizes, int n_in, void* d_out, int out_size, void* d_ws, size_t ws_size, hipStream_t stream) {
    static int grid = 0;
    if (grid == 0) {
        if (n_in != 36 || in_sizes[0] != NLAT * DM || out_size != NLAT * DM || ws_size < WS_END) {
            fprintf(stderr, "kernel_launch: shape mismatch: n_in %d in0 %d out %d ws %zu (need %zu)\n", n_in, n_in > 0 ? in_sizes[0] : -1, out_size, ws_size, (size_t)WS_END); grid = -1; return; }
        int dev = 0, cus = 0, per_cu = 0;
        if (hipGetDevice(&dev) != hipSuccess || hipDeviceGetAttribute(&cus, hipDeviceAttributeMultiprocessorCount, dev) != hipSuccess) { grid = -1; return; }
        if (hipFuncSetAttribute((const void*)mega_fwd, hipFuncAttributeMaxDynamicSharedMemorySize, LDS_BYTES) != hipSuccess) { fprintf(stderr, "kernel_launch: hipFuncSetAttribute failed\n"); grid = -1; return; }
        if (hipOccupancyMaxActiveBlocksPerMultiprocessor(&per_cu, (const void*)mega_fwd, NTHR, LDS_BYTES) != hipSuccess || per_cu < 1) { fprintf(stderr, "kernel_launch: occupancy query says %d\n", per_cu); }
        (void)hipGetLastError();
        grid = cus;
    }
    if (grid < 0) return;
    if (hipMemsetAsync((char*)d_ws + WS_CTL, 0, CTL_BYTES, stream) != hipSuccess) return;
    Params P{};
    for (int i = 0; i < 36; ++i) P.in[i] = (const float*)d_in[i];
    P.out = (float*)d_out; P.ws = (unsigned char*)d_ws;
#if MK_N_LAUNCHES == 1
    P.ph_lo = 0; P.ph_hi = NPHASE;
    hipLaunchKernelGGL(mega_fwd, dim3(grid), dim3(NTHR), LDS_BYTES, stream, P);
#else
    for (int k = 0; k < NPHASE; ++k) { P.ph_lo = k; P.ph_hi = k + 1; hipLaunchKernelGGL(mega_fwd, dim3(grid), dim3(NTHR), LDS_BYTES, stream, P); }
#endif
    const hipError_t le = hipPeekAtLastError();
    if (le != hipSuccess) fprintf(stderr, "kernel_launch: launch failed: %s\n", hipGetErrorName(le));
}
```

```cpp
#include <hip/hip_runtime.h>
#include <cstdio>
#include <cstdint>

#ifndef MK_N_LAUNCHES
#define MK_N_LAUNCHES 1
#endif

#define GAS __attribute__((address_space(1)))
#define LAS __attribute__((address_space(3)))
typedef unsigned short bf16;
typedef short bf16x8 __attribute__((ext_vector_type(8)));
typedef short s16x4 __attribute__((ext_vector_type(4)));
typedef float f32x2 __attribute__((ext_vector_type(2)));
typedef float f32x4 __attribute__((ext_vector_type(4)));
typedef float f32x16 __attribute__((ext_vector_type(16)));
typedef unsigned u32x2 __attribute__((ext_vector_type(2)));
typedef unsigned u32x4 __attribute__((ext_vector_type(4)));
#define LDS_WAIT() asm volatile("s_waitcnt lgkmcnt(0)" ::: "memory")
#define VM_WAIT() asm volatile("s_waitcnt vmcnt(0)" ::: "memory")
#define RLX_AGENT __ATOMIC_RELAXED, __HIP_MEMORY_SCOPE_AGENT

constexpr int DM = 2048, NB = 4, SEQ = 4096, CTXL = 256, GW = 64;
constexpr int NCTX = NB * CTXL, NLAT = NB * SEQ, NTOK = NCTX + NLAT;
constexpr int DRNN = 1024, QRK = 512, KVRK = 512, MROPE = 64, MNOPE = 128, MQK = 192, MV = 128, MH = 8;
constexpr int ABIN = 3136, ABINP = 3328;
constexpr int NAH = 16, NAD = 128;
constexpr int NE = 16, DE = 1408, NG = 4;
constexpr int NCHUNK = 68;
constexpr float EPS = 1e-6f;
constexpr float LOG2E = 1.4426950408889634f;
constexpr int MAXSLOT = 56320;

constexpr size_t al256(size_t x) { return (x + 255) / 256 * 256; }
constexpr size_t WS_CTL = 0, CTL_BYTES = 1u << 20;
constexpr int CW_TMO = 0, CW_BAR = 4096, CW_CNT = 16384;
constexpr size_t WS_MODP = CTL_BYTES;
constexpr size_t WS_MOD = WS_MODP + al256((size_t)8 * 2 * 5 * 12288 * 4);
constexpr size_t WS_ROPE = WS_MOD + al256((size_t)2 * 5 * 12288 * 4);
constexpr size_t WS_AGG = WS_ROPE + al256(64 * 16 * 8);
constexpr size_t WS_CARRY = WS_AGG + al256((size_t)2 * 4 * NCHUNK * 1024 * 8);
constexpr size_t WS_TOKE = WS_CARRY + al256((size_t)2 * 4 * NCHUNK * 1024 * 4);
constexpr size_t WS_TOKW = WS_TOKE + al256((size_t)NTOK * 8);
constexpr size_t WS_TOKP = WS_TOKW + al256((size_t)NTOK * 8);
constexpr size_t WS_TOKS = WS_TOKP + al256((size_t)NTOK * 8);
constexpr size_t WS_SLOTTOK = WS_TOKS + al256((size_t)NTOK * 8);
constexpr size_t WS_WIN = al256(WS_SLOTTOK + (size_t)MAXSLOT * 4);
constexpr size_t WS_WOUT0 = WS_WIN + (size_t)ABINP * DM * 2;
constexpr size_t WS_WUQ = WS_WOUT0 + (size_t)DM * DM * 2;
constexpr size_t WS_WUKV = WS_WUQ + (size_t)1536 * 512 * 2;
constexpr size_t WS_WG = WS_WUKV + (size_t)2048 * 512 * 2;
constexpr size_t WS_WQKV = WS_WG + (size_t)4 * 8 * 128 * 128 * 2;
constexpr size_t WS_WOUT1 = WS_WQKV + (size_t)6144 * DM * 2;
#ifndef MOE_FP8
#define MOE_FP8 1
#endif
#ifndef DFP8_IN
#define DFP8_IN 0
#endif
#ifndef DFP8_QKV
#define DFP8_QKV 1
#endif
#ifndef DFP8_OUT0
#define DFP8_OUT0 0
#endif
#ifndef DFP8_OUT1
#define DFP8_OUT1 1
#endif
constexpr int DEP = 1536;
#if MOE_FP8
constexpr size_t W1_E = (size_t)2816 * DM, W2_E = (size_t)DM * DEP;
constexpr int ACT_LD = DEP, ACT_ES = 1;
#else
constexpr size_t W1_E = (size_t)2816 * DM * 2, W2_E = (size_t)DM * DE * 2;
constexpr int ACT_LD = DE, ACT_ES = 2;
#endif
constexpr size_t WS_W1 = WS_WOUT1 + (size_t)DM * DM * 2;
constexpr size_t WS_W2 = WS_W1 + 2 * 17 * W1_E;
constexpr size_t WS_XA = WS_W2 + 2 * 17 * W2_E;
constexpr size_t XBYTES = (size_t)NTOK * DM * 4;
constexpr size_t WS_XB = WS_XA + XBYTES;
constexpr size_t WS_H = WS_XB + XBYTES;
constexpr size_t WS_D = WS_H + (size_t)NTOK * DM * 2;
constexpr size_t WS_U = WS_D;
constexpr size_t WS_AB = WS_U + al256((size_t)NTOK * ABIN * 2);
constexpr size_t ABSZ = (size_t)NTOK * DRNN * 4;
constexpr size_t WS_CQN = WS_AB + 4 * ABSZ;
constexpr size_t WS_CKVN = WS_CQN + (size_t)NTOK * 512 * 2;
constexpr size_t WS_YC = WS_CKVN + (size_t)NTOK * 512 * 2;
constexpr size_t WS_D_END0 = WS_YC + (size_t)NTOK * DM * 2;
constexpr size_t WS_QRAW = WS_XA;
constexpr size_t WS_KVRAW = WS_QRAW + al256((size_t)NTOK * 1536 * 2);
constexpr size_t WS_QF = WS_XB;
constexpr size_t WS_KF = WS_QF + al256((size_t)NTOK * 1536 * 2);
static_assert(WS_KVRAW + (size_t)NTOK * 2048 * 2 <= WS_XB && WS_KF + (size_t)NTOK * 1536 * 2 <= WS_H, "mixer overlays");
constexpr size_t WS_ACT = WS_D;
constexpr size_t WS_Y = WS_ACT + al256((size_t)MAXSLOT * ACT_LD * ACT_ES);
constexpr size_t WS_D_END1 = WS_Y + (size_t)MAXSLOT * DM * 2;
constexpr size_t WS_QKV = WS_D;
constexpr size_t WS_ATT2 = WS_QKV + (size_t)NTOK * 6144 * 2;
constexpr size_t WS_D_END2 = WS_ATT2 + (size_t)NTOK * DM * 2;
constexpr size_t WS_END = (WS_D_END0 > WS_D_END1 ? (WS_D_END0 > WS_D_END2 ? WS_D_END0 : WS_D_END2) : (WS_D_END1 > WS_D_END2 ? WS_D_END1 : WS_D_END2));

constexpr int RING_BYTES = 131072;
constexpr int MISC_OFF = RING_BYTES;
constexpr int LDS_BYTES = 147456;
constexpr int NWAVES = 8, NTHR = 512;

__device__ __forceinline__ unsigned f2bf(float f) { unsigned u = __builtin_bit_cast(unsigned, f); return (u + 0x7fffu + ((u >> 16) & 1u)) >> 16; }
__device__ __forceinline__ unsigned pk2(float lo, float hi) { return f2bf(lo) | (f2bf(hi) << 16); }
__device__ __forceinline__ float bf2f(unsigned short b) { return __builtin_bit_cast(float, (unsigned)b << 16); }
__device__ __forceinline__ float bflo(unsigned w) { return __builtin_bit_cast(float, w << 16); }
__device__ __forceinline__ float bfhi(unsigned w) { return __builtin_bit_cast(float, w & 0xffff0000u); }
__device__ __forceinline__ unsigned cvt_pk_bf16(float lo, float hi) { unsigned r; asm volatile("v_cvt_pk_bf16_f32 %0, %1, %2" : "=v"(r) : "v"(lo), "v"(hi)); return r; }
__device__ __forceinline__ float clamp_e4m3(float x) { return __builtin_amdgcn_fmed3f(x, -448.0f, 448.0f); }
__device__ __forceinline__ unsigned pk4_fp8(float a, float b, float c, float d) { int w = 0; w = __builtin_amdgcn_cvt_pk_fp8_f32(clamp_e4m3(a), clamp_e4m3(b), w, false); w = __builtin_amdgcn_cvt_pk_fp8_f32(clamp_e4m3(c), clamp_e4m3(d), w, true); return (unsigned)w; }
__device__ __forceinline__ float wave_sum(float v) {
#pragma unroll
    for (int o = 1; o < 64; o <<= 1) v += __shfl_xor(v, o);
    return v;
}
__device__ __forceinline__ float sigmoidf_(float x) { return 1.0f / (1.0f + __expf(-x)); }
__device__ __forceinline__ float gelu_tanh(float x) { const float u = 0.7978845608028654f * (x + 0.044715f * x * x * x); const float th = 1.0f - 2.0f / (1.0f + __expf(2.0f * u)); return 0.5f * x * (1.0f + th); }
__device__ __forceinline__ int vec_of_row(int row) { return row < NCTX ? 4 : (row - NCTX) / SEQ; }

#define XB_TMO      128
#define XB_XCNT(j)  (256  + 64 * (j))
#define XB_XSUB(j)  (1280 + 64 * (j))
#define XB_XGEN(j)  (2304 + 64 * (j))
#define XB_TOP      3328
#define XB_TOPGEN   3392
#define XCD_BAR_WORDS 3456
#define XB_SPIN_CAP (1u << 18)
__device__ __forceinline__ unsigned xb_ld(unsigned* p)              { return __hip_atomic_load(p, __ATOMIC_RELAXED, __HIP_MEMORY_SCOPE_AGENT); }
__device__ __forceinline__ unsigned xb_add(unsigned* p, unsigned v) { return __hip_atomic_fetch_add(p, v, __ATOMIC_RELAXED, __HIP_MEMORY_SCOPE_AGENT); }
__device__ __forceinline__ unsigned xb_xcc_id() { return (unsigned)__builtin_amdgcn_s_getreg((3 << 11) | 20) & 0xFu; }
#define XB_SPIN(cond, bar) do { unsigned _sp = 0; while (cond) { __builtin_amdgcn_s_sleep(1); \
    if ((++_sp & 255u) == 0u) { if (xb_ld(&(bar)[XB_TMO])) break; if (_sp > XB_SPIN_CAP) { atomicAdd(&(bar)[XB_TMO], 1u); break; } } } } while (0)
struct XcdBarrier { unsigned* bar; unsigned x; volatile LAS unsigned* st; };
__device__ __forceinline__ XcdBarrier xcd_barrier_post(unsigned* bar, volatile LAS unsigned* st) {
    XcdBarrier b; b.bar = bar; b.x = xb_xcc_id(); b.st = st;
    if (threadIdx.x == 0) (void)xb_add(&bar[XB_XCNT(b.x)], 1u);
    return b;
}
__device__ __forceinline__ void xcd_barrier_complete(unsigned* bar, unsigned x, unsigned& nloc, unsigned& nx) {
    const unsigned G = gridDim.x * gridDim.y * gridDim.z;
    unsigned sum, cnt, mine, sp = 0u;
    for (;;) {
        sum = 0u; cnt = 0u; mine = 0u;
#pragma unroll
        for (unsigned j = 0; j < 16; ++j) { const unsigned c = xb_ld(&bar[XB_XCNT(j)]); sum += c; cnt += (c > 0u) ? 1u : 0u; mine = (j == x) ? c : mine; }
        if (sum == G) break;
        __builtin_amdgcn_s_sleep(1);
        if ((++sp & 255u) == 0u) { if (xb_ld(&bar[XB_TMO])) break; if (sp > XB_SPIN_CAP) { atomicAdd(&bar[XB_TMO], 1u); break; } }
    }
    nloc = mine > 0u ? mine : 1u; nx = cnt > 0u ? cnt : 1u;
}
__device__ __forceinline__ void xcd_barrier(const XcdBarrier& b) {
    asm volatile("s_waitcnt vmcnt(0)" ::: "memory");
    __syncthreads();
    if (threadIdx.x == 0) {
        unsigned* bar = b.bar;
        __builtin_amdgcn_s_waitcnt(0);
        unsigned nloc = b.st[0], nx = b.st[1];
        if (nloc == 0u) { xcd_barrier_complete(bar, b.x, nloc, nx); b.st[0] = nloc; b.st[1] = nx; }
        const unsigned old = xb_add(&bar[XB_XSUB(b.x)], 1u);
        const unsigned gen = old / nloc;
        if (old + 1u == (gen + 1u) * nloc) {
            __builtin_amdgcn_fence(__ATOMIC_RELEASE, "agent");
            asm volatile("s_waitcnt vmcnt(0)" ::: "memory");
            const unsigned og = xb_add(&bar[XB_TOP], 1u);
            const unsigned tg = og / nx;
            if (og + 1u == (tg + 1u) * nx) xb_add(&bar[XB_TOPGEN], 1u);
            else XB_SPIN(xb_ld(&bar[XB_TOPGEN]) == tg, bar);
            __builtin_amdgcn_fence(__ATOMIC_ACQUIRE, "agent");
            xb_add(&bar[XB_XGEN(b.x)], 1u);
            asm volatile("s_waitcnt vmcnt(0)" ::: "memory");
        } else {
            XB_SPIN(xb_ld(&bar[XB_XGEN(b.x)]) == gen, bar);
            __builtin_amdgcn_fence(__ATOMIC_ACQUIRE, "agent");
            asm volatile("s_waitcnt vmcnt(0)" ::: "memory");
        }
    }
    __syncthreads();
}

namespace pg8 {
constexpr int BM = 256, BK = 64, HALF = 128, HTB = HALF * BK * 2, STAGE_BYTES = 8 * HTB, NXCD = 8, WGM = 8;
__device__ __forceinline__ int lds_byte(int r, int c) { const int st = (r >> 4) * 2 + (c >> 5), rr = r & 15, cc = c & 31, ob = rr * 64 + cc * 2; return st * 1024 + (ob ^ (((ob >> 9) & 1) << 5)); }
__device__ __forceinline__ void stage_rc(int b, int& R, int& C) { const int st = b / 1024, sb = b % 1024, swz = sb ^ (((sb >> 9) & 1) << 5); R = (st >> 1) * 16 + swz / 64; C = (st & 1) * 32 + (swz % 64) / 2; }
__device__ __forceinline__ int perm32(int rho) { const int n = rho >> 4, i = rho & 15; return 8 * (i >> 2) + 4 * n + (i & 3); }

__device__ __forceinline__ void dma16(unsigned lds_dst, const void* sbase, unsigned voff) {
    unsigned keep;
    asm volatile("s_mov_b32 %0, m0\n\ts_mov_b32 m0, %3\n\ts_nop 0\n\tglobal_load_lds_dwordx4 %1, %2\n\ts_mov_b32 m0, %0" : "=&s"(keep) : "v"(voff), "s"(sbase), "s"(lds_dst) : "memory");
}
struct Unit {
    const char* ap;
    const char* bp;
    const int* rowmap;
    int arow0;
    int pm, pn, grp;
};
struct TileOrder {
    int nM, nN, nwg, G, c;
    __device__ __forceinline__ void init(int nM_, int nN_, int G_, int c_) { nM = nM_; nN = nN_; nwg = nM * nN; G = G_; c = c_; }
    __device__ __forceinline__ bool tile(int i, int& pm, int& pn) const {
        const long L = (long)i * G + c; if (L >= nwg) return false;
        int wgid = (int)L; { const int q = nwg / NXCD, r = nwg % NXCD, xcd = wgid % NXCD, off = wgid / NXCD; wgid = (xcd < r ? xcd * (q + 1) : r * (q + 1) + (xcd - r) * q) + off; }
        const int nig = WGM * nN, gid = wgid / nig, fm = gid * WGM, gsz = (nM - fm) < WGM ? (nM - fm) : WGM;
        pm = fm + ((wgid % nig) % gsz); pn = (wgid % nig) / gsz; return true;
    }
};
struct DenseSched {
    TileOrder T; const char* A; const char* Bt; size_t tstepB; int row0;
    __device__ __forceinline__ bool next(int i, Unit& u) const {
        int pm, pn; if (!T.tile(i, pm, pn)) return false;
        u.ap = A; u.bp = Bt + (size_t)pn * tstepB; u.rowmap = nullptr; u.arow0 = row0 + pm * BM; u.pm = pm; u.pn = pn; u.grp = 0; return true;
    }
};
struct MoeSched {
    TileOrder T; const char* A; const char* Bt; size_t tstepB, estride; const int* rowmap; const volatile LAS int* tile_e;
    __device__ __forceinline__ bool next(int i, Unit& u) const {
        int pm, pn; if (!T.tile(i, pm, pn)) return false;
        const int e = __builtin_amdgcn_readfirstlane(tile_e[pm]);
        u.ap = A; u.bp = Bt + (size_t)e * estride + (size_t)pn * tstepB; u.rowmap = rowmap; u.arow0 = pm * BM; u.pm = pm; u.pn = pn; u.grp = e; return true;
    }
};

typedef int v8i __attribute__((ext_vector_type(8)));
template <class Epi, class Sched, bool FP8>
__device__ __forceinline__ void gemm_phase(LAS unsigned char* lds, const int rowBytes, const Sched& S, const Epi& E, const unsigned sclA = 0x7f7f7f7fu) {
    const int tid = threadIdx.x, wid = __builtin_amdgcn_readfirstlane(tid >> 6), lane = tid & 63, wr = wid >> 2, wc = wid & 3, fr = lane & 15, fq = lane >> 4;
    const int nt = rowBytes / 128;
    int sR[2]; unsigned sC2[2], voffB[2];
#pragma unroll
    for (int i = 0; i < 2; ++i) { int R, C; stage_rc(tid * 16 + i * 8192, R, C); const int Rb = Epi::PERM ? ((R & ~31) + perm32(R & 31)) : R;
        sR[i] = R; sC2[i] = (unsigned)C * 2u; voffB[i] = (unsigned)Rb * (unsigned)rowBytes + (unsigned)C * 2u; }
    const size_t kstep = 128;
    const size_t hstepB = (size_t)HALF * rowBytes;
    const unsigned rowB = (unsigned)rowBytes;
    const unsigned ldsw = (unsigned)wid * 1024u;
    const int aoff = FP8 ? lds_byte(wr * 64 + fr, fq * 16) : lds_byte(wr * 64 + fr, fq * 8), boff = FP8 ? lds_byte(wc * 32 + fr, fq * 16) : lds_byte(wc * 32 + fr, fq * 8);
#define PG8_SA(b, h) (((b) * 2 + (h)) * HTB)
#define PG8_SB(b, h) ((4 + (b) * 2 + (h)) * HTB)
#define PG8_STAGE(bufoff, gbase, voff) do { _Pragma("unroll") for (int _i = 0; _i < 2; ++_i) \
        dma16((unsigned)((bufoff) + _i * 8192) + ldsw, (const void*)(gbase), (voff)[_i]); } while (0)
#define PG8_LDA(dst, b, h) do { if constexpr (FP8) { _Pragma("unroll") for (int m = 0; m < 4; ++m) dst##8[m] = *(const LAS v8i*)(lds + PG8_SA(b, h) + aoff + m * 2048); } \
        else { _Pragma("unroll") for (int m = 0; m < 4; ++m) _Pragma("unroll") for (int k = 0; k < 2; ++k) dst[m][k] = *(const LAS bf16x8*)(lds + PG8_SA(b, h) + aoff + m * 2048 + k * 1024); } } while (0)
#define PG8_LDB(dst, b, h) do { if constexpr (FP8) { _Pragma("unroll") for (int n = 0; n < 2; ++n) dst##8[n] = *(const LAS v8i*)(lds + PG8_SB(b, h) + boff + n * 2048); } \
        else { _Pragma("unroll") for (int n = 0; n < 2; ++n) _Pragma("unroll") for (int k = 0; k < 2; ++k) dst[n][k] = *(const LAS bf16x8*)(lds + PG8_SB(b, h) + boff + n * 2048 + k * 1024); } } while (0)
#define PG8_MMA(ai, bj, At, Bt) do { __builtin_amdgcn_s_setprio(1); \
        if constexpr (FP8) { _Pragma("unroll") for (int m = 0; m < 4; ++m) _Pragma("unroll") for (int n = 0; n < 2; ++n) \
            asm volatile("v_mfma_scale_f32_16x16x128_f8f6f4 %0, %1, %2, %0, %3, %4 op_sel_hi:[0,0,0]" : "+v"(acc[ai][bj][m][n]) : "v"(Bt##8[n]), "v"(At##8[m]), "v"(sclW), "v"(sclA)); } \
        else { _Pragma("unroll") for (int m = 0; m < 4; ++m) _Pragma("unroll") for (int n = 0; n < 2; ++n) _Pragma("unroll") for (int k = 0; k < 2; ++k) \
            acc[ai][bj][m][n] = __builtin_amdgcn_mfma_f32_16x16x32_bf16(Bt[n][k], At[m][k], acc[ai][bj][m][n], 0, 0, 0); } \
        __builtin_amdgcn_s_setprio(0); } while (0)
#define PG8_WAIT_V(n) asm volatile("s_waitcnt vmcnt(" #n ")" ::: "memory")
#define PG8_WAIT_L(n) asm volatile("s_waitcnt lgkmcnt(" #n ")" ::: "memory")
#define PG8_BAR __builtin_amdgcn_s_barrier()
#define PG8_SCHED __builtin_amdgcn_sched_barrier(0)
#define PG8_MKOFF(u, o0, o1) do { _Pragma("unroll") for (int _i = 0; _i < 2; ++_i) { const int _r0 = (u).arow0 + sR[_i], _r1 = _r0 + HALF; \
        const int _g0 = (u).rowmap ? (u).rowmap[_r0] : _r0, _g1 = (u).rowmap ? (u).rowmap[_r1] : _r1; \
        o0[_i] = (unsigned)_g0 * rowB + sC2[_i]; o1[_i] = (unsigned)_g1 * rowB + sC2[_i]; } } while (0)
    Unit cur, nxt; int ui = 0;
    if (!S.next(0, cur)) return;
    f32x4 acc[2][2][4][2];
#pragma unroll
    for (int a = 0; a < 2; ++a)
#pragma unroll
        for (int b = 0; b < 2; ++b)
#pragma unroll
            for (int m = 0; m < 4; ++m)
#pragma unroll
                for (int n = 0; n < 2; ++n) acc[a][b][m][n] = (f32x4){0.f, 0.f, 0.f, 0.f};
    bf16x8 At[4][2], B0[2][2], B1[2][2]; v8i At8[4], B08[2], B18[2];
    const unsigned sclW = 0x79797979u;
    unsigned oc0[2], oc1[2], on0[2], on1[2];
    PG8_MKOFF(cur, oc0, oc1);
    on0[0] = oc0[0]; on0[1] = oc0[1]; on1[0] = oc1[0]; on1[1] = oc1[1];
    const char* cA = cur.ap; const char* cB = cur.bp;
    PG8_STAGE(PG8_SB(0, 0), cB, voffB); PG8_STAGE(PG8_SB(0, 1), cB + hstepB, voffB); PG8_STAGE(PG8_SA(0, 0), cA, oc0); PG8_STAGE(PG8_SA(0, 1), cA, oc1);
    if (wr == 1) PG8_BAR;
    PG8_WAIT_V(2); PG8_BAR;
    PG8_STAGE(PG8_SB(1, 0), cB + kstep, voffB); PG8_STAGE(PG8_SA(1, 0), cA + kstep, oc0); PG8_STAGE(PG8_SB(1, 1), cB + hstepB + kstep, voffB);
    PG8_WAIT_V(6); PG8_BAR;
    for (;;) {
        const bool has_next = S.next(ui + 1, nxt);
        const char* nA = has_next ? nxt.ap : cA; const char* nB = has_next ? nxt.bp : cB;
        for (int t = 0; t < nt; t += 2) {
            const bool last = (t == nt - 2);
            if (last && has_next) { PG8_MKOFF(nxt, on0, on1); }
            const char* a1 = cA + (size_t)(t + 1) * kstep;
            const char* a2 = last ? nA : cA + (size_t)(t + 2) * kstep; const char* b2 = last ? nB : cB + (size_t)(t + 2) * kstep;
            const char* a3 = a2 + kstep; const char* b3 = b2 + kstep;
            unsigned o20[2], o21[2];
            o20[0] = last ? on0[0] : oc0[0]; o20[1] = last ? on0[1] : oc0[1]; o21[0] = last ? on1[0] : oc1[0]; o21[1] = last ? on1[1] : oc1[1];
            PG8_LDB(B0, 0, 0); PG8_LDB(B1, 0, 1); PG8_SCHED; PG8_LDA(At, 0, 0); PG8_STAGE(PG8_SA(1, 1), a1, oc1);
            PG8_WAIT_V(8); PG8_WAIT_L(0); PG8_BAR; PG8_MMA(0, 0, At, B0); PG8_MMA(0, 1, At, B1); PG8_BAR; PG8_SCHED;
            PG8_LDA(At, 0, 1); PG8_STAGE(PG8_SB(0, 0), b2, voffB); PG8_STAGE(PG8_SB(0, 1), b2 + hstepB, voffB); PG8_STAGE(PG8_SA(0, 0), a2, o20);
            PG8_WAIT_V(8); PG8_WAIT_L(0); PG8_BAR; PG8_MMA(1, 0, At, B0); PG8_MMA(1, 1, At, B1); PG8_BAR; PG8_SCHED;
            PG8_LDB(B0, 1, 0); PG8_LDB(B1, 1, 1); PG8_SCHED; PG8_LDA(At, 1, 0); PG8_STAGE(PG8_SA(0, 1), a2, o21);
            PG8_WAIT_V(8); PG8_WAIT_L(0); PG8_BAR; PG8_MMA(0, 0, At, B0); PG8_MMA(0, 1, At, B1); PG8_BAR; PG8_SCHED;
            PG8_LDA(At, 1, 1); PG8_STAGE(PG8_SB(1, 0), b3, voffB); PG8_STAGE(PG8_SB(1, 1), b3 + hstepB, voffB); PG8_STAGE(PG8_SA(1, 0), a3, o20);
            PG8_WAIT_V(8); PG8_WAIT_L(0); PG8_BAR; PG8_MMA(1, 0, At, B0); PG8_MMA(1, 1, At, B1); PG8_BAR; PG8_SCHED;
        }
        if (wr == 0) PG8_BAR;
        if constexpr (FP8) asm volatile("s_nop 15\n\ts_nop 15" ::: "memory");
        E(acc, cur, wr, wc, fr, fq);
        if (!has_next) break;
#pragma unroll
        for (int a = 0; a < 2; ++a)
#pragma unroll
            for (int b = 0; b < 2; ++b)
#pragma unroll
                for (int m = 0; m < 4; ++m)
#pragma unroll
                    for (int n = 0; n < 2; ++n) acc[a][b][m][n] = (f32x4){0.f, 0.f, 0.f, 0.f};
        cur = nxt; cA = nA; cB = nB; ++ui;
        oc0[0] = on0[0]; oc0[1] = on0[1]; oc1[0] = on1[0]; oc1[1] = on1[1];
        if (wr == 1) PG8_BAR;
    }
    PG8_WAIT_V(0);
    PG8_BAR;
#undef PG8_SA
#undef PG8_SB
#undef PG8_STAGE
#undef PG8_LDA
#undef PG8_LDB
#undef PG8_MMA
#undef PG8_WAIT_V
#undef PG8_WAIT_L
#undef PG8_BAR
#undef PG8_SCHED
#undef PG8_MKOFF
}
}

struct Params { const float* in[36]; float* out; unsigned char* ws; int ph_lo, ph_hi; };
enum { I_X = 0, I_C, I_CTX, I_CCTX, I_ADAW, I_ADAB, I_NMIXG, I_NFFNG, I_ABWIN, I_ABWOUT, I_CONVW, I_CONVB, I_LWA, I_LBA, I_LWI, I_LBI, I_LAM,
       I_QNG, I_WUQ, I_KVNG, I_WUKV, I_QHG, I_KHG, I_NAWQKV, I_NAWOUT, I_NAQHG, I_NAKHG, I_RPB, I_RW, I_RB, I_MWG, I_MWU, I_MWD, I_MSG, I_MSU, I_MSD };

using pg8::Unit;
struct EpiU {
    static constexpr bool PERM = true;
    bf16* U;
    __device__ __forceinline__ void operator()(const f32x4 (&acc)[2][2][4][2], const Unit& u, int wr, int wc, int fr, int fq) const {
        const int row0 = u.pm * 256 + wr * 64 + fr, col0 = u.pn * 256 + wc * 32 + 8 * fq;
        const bool gel = (u.pn >= 4 && u.pn < 8);
#pragma unroll
        for (int ai = 0; ai < 2; ++ai)
#pragma unroll
            for (int m = 0; m < 4; ++m) { bf16* rowp = U + (size_t)(row0 + ai * 128 + m * 16) * ABIN + col0;
#pragma unroll
                for (int bj = 0; bj < 2; ++bj) { if (col0 + bj * 128 >= ABIN) continue;
                    f32x4 v0 = acc[ai][bj][m][0], v1 = acc[ai][bj][m][1];
                    if (gel) {
#pragma unroll
                        for (int j = 0; j < 4; ++j) { v0[j] = gelu_tanh(v0[j]); v1[j] = gelu_tanh(v1[j]); } }
                    u32x4 w; w.x = cvt_pk_bf16(v0[0], v0[1]); w.y = cvt_pk_bf16(v0[2], v0[3]); w.z = cvt_pk_bf16(v1[0], v1[1]); w.w = cvt_pk_bf16(v1[2], v1[3]);
                    *(u32x4*)(rowp + bj * 128) = w; } }
    }
};
struct EpiBf {
    static constexpr bool PERM = true;
    bf16* O; int ldc;
    __device__ __forceinline__ void operator()(const f32x4 (&acc)[2][2][4][2], const Unit& u, int wr, int wc, int fr, int fq) const {
        const int row0 = u.pm * 256 + wr * 64 + fr, col0 = u.pn * 256 + wc * 32 + 8 * fq;
#pragma unroll
        for (int ai = 0; ai < 2; ++ai)
#pragma unroll
            for (int m = 0; m < 4; ++m) { bf16* rowp = O + (size_t)(row0 + ai * 128 + m * 16) * ldc + col0;
#pragma unroll
                for (int bj = 0; bj < 2; ++bj) { const f32x4 v0 = acc[ai][bj][m][0], v1 = acc[ai][bj][m][1];
                    u32x4 w; w.x = cvt_pk_bf16(v0[0], v0[1]); w.y = cvt_pk_bf16(v0[2], v0[3]); w.z = cvt_pk_bf16(v1[0], v1[1]); w.w = cvt_pk_bf16(v1[2], v1[3]);
                    *(u32x4*)(rowp + bj * 128) = w; } }
    }
};
template <bool INF32> struct EpiRes {
    static constexpr bool PERM = true;
    const void* xin_ctx; const void* xin_lat;
    bf16* xout; const float* gate; int row0;
    __device__ __forceinline__ void operator()(const f32x4 (&acc)[2][2][4][2], const Unit& u, int wr, int wc, int fr, int fq) const {
        const int r0 = row0 + u.pm * 256 + wr * 64 + fr, col0 = u.pn * 256 + wc * 32 + 8 * fq;
        const int v = vec_of_row(row0 + u.pm * 256);
        f32x4 g[2][2];
#pragma unroll
        for (int bj = 0; bj < 2; ++bj)
#pragma unroll
            for (int n = 0; n < 2; ++n) g[bj][n] = *(const f32x4*)(gate + (size_t)v * 12288 + col0 + bj * 128 + n * 4);
#pragma unroll
        for (int ai = 0; ai < 2; ++ai)
#pragma unroll
            for (int m = 0; m < 4; ++m) { const int row = r0 + ai * 128 + m * 16; bf16* xo = xout + (size_t)row * DM + col0;
#pragma unroll
                for (int bj = 0; bj < 2; ++bj) { f32x4 x0, x1;
                    if constexpr (INF32) { const float* xi = (row < NCTX ? (const float*)xin_ctx + (size_t)row * DM : (const float*)xin_lat + (size_t)(row - NCTX) * DM) + col0 + bj * 128;
                        x0 = *(const f32x4*)xi; x1 = *(const f32x4*)(xi + 4); }
                    else { const u32x4 w = *(const u32x4*)((const bf16*)xin_ctx + (size_t)row * DM + col0 + bj * 128);
                        x0 = (f32x4){bflo(w.x), bfhi(w.x), bflo(w.y), bfhi(w.y)}; x1 = (f32x4){bflo(w.z), bfhi(w.z), bflo(w.w), bfhi(w.w)}; }
                    x0 = x0 + g[bj][0] * acc[ai][bj][m][0]; x1 = x1 + g[bj][1] * acc[ai][bj][m][1];
                    u32x4 o; o.x = cvt_pk_bf16(x0[0], x0[1]); o.y = cvt_pk_bf16(x0[2], x0[3]); o.z = cvt_pk_bf16(x1[0], x1[1]); o.w = cvt_pk_bf16(x1[2], x1[3]);
                    *(u32x4*)(xo + bj * 128) = o; } }
    }
};
struct EpiSwiglu {
    static constexpr bool PERM = true;
    bf16* ACT;
    __device__ __forceinline__ void operator()(const f32x4 (&acc)[2][2][4][2], const Unit& u, int wr, int wc, int fr, int fq) const {
        const int row0 = u.pm * 256 + wr * 64 + fr, col0 = u.pn * 128 + wc * 32 + 8 * fq;
#pragma unroll
        for (int ai = 0; ai < 2; ++ai)
#pragma unroll
            for (int m = 0; m < 4; ++m) { bf16* rowp = ACT + (size_t)(row0 + ai * 128 + m * 16) * DE + col0;
                float o[8];
#pragma unroll
                for (int n = 0; n < 2; ++n)
#pragma unroll
                    for (int j = 0; j < 4; ++j) { const float gv = acc[ai][0][m][n][j], uv = acc[ai][1][m][n][j]; o[n * 4 + j] = gv / (1.0f + __expf(-gv)) * uv; }
                u32x4 w; w.x = cvt_pk_bf16(o[0], o[1]); w.y = cvt_pk_bf16(o[2], o[3]); w.z = cvt_pk_bf16(o[4], o[5]); w.w = cvt_pk_bf16(o[6], o[7]);
                *(u32x4*)rowp = w; }
    }
};

struct EpiSwiglu8 {
    static constexpr bool PERM = true;
    unsigned char* ACT;
    __device__ __forceinline__ void operator()(const f32x4 (&acc)[2][2][4][2], const Unit& u, int wr, int wc, int fr, int fq) const {
        const int row0 = u.pm * 256 + wr * 64 + fr, col0 = u.pn * 128 + wc * 32 + 8 * fq;
#pragma unroll
        for (int ai = 0; ai < 2; ++ai)
#pragma unroll
            for (int m = 0; m < 4; ++m) { unsigned char* rowp = ACT + (size_t)(row0 + ai * 128 + m * 16) * DEP + col0;
                float o[8];
#pragma unroll
                for (int n = 0; n < 2; ++n)
#pragma unroll
                    for (int j = 0; j < 4; ++j) { const float gv = acc[ai][0][m][n][j], uv = acc[ai][1][m][n][j]; o[n * 4 + j] = gv / (1.0f + __expf(-gv)) * uv; }
                u32x2 w; w.x = pk4_fp8(o[0], o[1], o[2], o[3]); w.y = pk4_fp8(o[4], o[5], o[6], o[7]);
                *(u32x2*)rowp = w;
                if (u.pn == 10) *(u32x2*)(rowp + 128) = (u32x2){0u, 0u}; }
    }
};

struct Frame {
    LAS unsigned char* lds; volatile LAS unsigned* MISC; unsigned* ctl; unsigned char* ws;
    int tid, lane, wave, vcu, G;
};

__device__ __forceinline__ void xpose_item(const float* W, int ldw, bf16* WT, int ldt, int k0, int n0, int drow0, LAS float* scr, int lane) {
    { const int rr = lane >> 3, c4 = (lane & 7) * 4; f32x4 v[8];
#pragma unroll
      for (int i = 0; i < 8; ++i) v[i] = *(const f32x4*)(W + (size_t)(k0 + 8 * i + rr) * ldw + n0 + c4);
#pragma unroll
      for (int i = 0; i < 8; ++i) { LAS float* d = scr + (8 * i + rr) * 33 + c4; d[0] = v[i].x; d[1] = v[i].y; d[2] = v[i].z; d[3] = v[i].w; } }
    LDS_WAIT(); asm volatile("" ::: "memory");
    const int c = lane & 7;
#pragma unroll
    for (int j = 0; j < 4; ++j) { const int n = (lane >> 3) + 8 * j; const LAS float* s = scr + (8 * c) * 33 + n;
        u32x4 o; o.x = pk2(s[0 * 33], s[1 * 33]); o.y = pk2(s[2 * 33], s[3 * 33]); o.z = pk2(s[4 * 33], s[5 * 33]); o.w = pk2(s[6 * 33], s[7 * 33]);
        *(u32x4*)(WT + (size_t)(drow0 + n) * ldt + k0 + 8 * c) = o; }
    LDS_WAIT(); asm volatile("" ::: "memory");
}
__device__ __forceinline__ void xpose_job(const float* W, int K, int N, bf16* WT, int r, LAS float* scr, int lane) {
    const int nblk = N / 32, kb = r / nblk, nb = r % nblk;
    xpose_item(W, N, WT, K, 64 * kb, 32 * nb, 32 * nb, scr, lane);
}
__device__ __forceinline__ void xpose_item8(const float* W, int ldw, unsigned char* WT, int ldt, int k0, int n0, int drow0, float sc, LAS float* scr, int lane) {
    { const int rr = lane >> 3, c4 = (lane & 7) * 4; f32x4 v[8];
#pragma unroll
      for (int i = 0; i < 8; ++i) v[i] = *(const f32x4*)(W + (size_t)(k0 + 8 * i + rr) * ldw + n0 + c4);
#pragma unroll
      for (int i = 0; i < 8; ++i) { LAS float* d = scr + (8 * i + rr) * 33 + c4; d[0] = v[i].x; d[1] = v[i].y; d[2] = v[i].z; d[3] = v[i].w; } }
    LDS_WAIT(); asm volatile("" ::: "memory");
    const int c = lane & 3;
#pragma unroll
    for (int j = 0; j < 2; ++j) { const int n = (lane >> 2) + 16 * j; const LAS float* s = scr + (16 * c) * 33 + n;
        u32x4 o; o.x = pk4_fp8(s[0 * 33] * sc, s[1 * 33] * sc, s[2 * 33] * sc, s[3 * 33] * sc); o.y = pk4_fp8(s[4 * 33] * sc, s[5 * 33] * sc, s[6 * 33] * sc, s[7 * 33] * sc);
        o.z = pk4_fp8(s[8 * 33] * sc, s[9 * 33] * sc, s[10 * 33] * sc, s[11 * 33] * sc); o.w = pk4_fp8(s[12 * 33] * sc, s[13 * 33] * sc, s[14 * 33] * sc, s[15 * 33] * sc);
        *(u32x4*)(WT + (size_t)(drow0 + n) * ldt + k0 + 16 * c) = o; }
    LDS_WAIT(); asm volatile("" ::: "memory");
}
__device__ __forceinline__ void xpose_job8(const float* W, int K, int N, unsigned char* WT, int r, LAS float* scr, int lane) {
    const int nblk = N / 32, kb = r / nblk, nb = r % nblk;
    xpose_item8(W, N, WT, K, 64 * kb, 32 * nb, 32 * nb, 64.0f, scr, lane);
}
constexpr int DQ_N = 51 * 1408;
constexpr int CW_DQ = 32768;
__device__ __forceinline__ void moe_item(Frame& F, const Params& p, int l, int r, LAS float* scr) {
    unsigned char* ws = F.ws; constexpr int I_MOE1 = 1408;
    r += l * DQ_N;
        { const int m = r / I_MOE1, rr = r % I_MOE1, l = m / 51, mm = m % 51, which = mm / 17, e = mm % 17;
          if (which < 2) {
              const float* src = which == 0 ? (e < 16 ? p.in[I_MWG] + (size_t)(l * 16 + e) * DM * DE : p.in[I_MSG] + (size_t)l * DM * DE)
                                            : (e < 16 ? p.in[I_MWU] + (size_t)(l * 16 + e) * DM * DE : p.in[I_MSU] + (size_t)l * DM * DE);
              const int kb = rr / 44, nb = rr % 44, n0 = 32 * nb;
#if MOE_FP8
              xpose_item8(src, DE, ws + WS_W1 + (size_t)(l * 17 + e) * W1_E, DM, 64 * kb, n0, (n0 / 128) * 256 + (n0 % 128) + (which ? 128 : 0), 64.0f, scr, F.lane);
#else
              xpose_item(src, DE, (bf16*)(ws + WS_W1 + (size_t)(l * 17 + e) * W1_E), DM, 64 * kb, n0, (n0 / 128) * 256 + (n0 % 128) + (which ? 128 : 0), scr, F.lane);
#endif
          } else {
              const float* src = e < 16 ? p.in[I_MWD] + (size_t)(l * 16 + e) * DE * DM : p.in[I_MSD] + (size_t)l * DE * DM;
              const int kb = rr / 64, nb = rr % 64;
#if MOE_FP8
              xpose_item8(src, DM, ws + WS_W2 + (size_t)(l * 17 + e) * W2_E, DEP, 64 * kb, 32 * nb, 32 * nb, 64.0f, scr, F.lane);
#else
              xpose_item(src, DM, (bf16*)(ws + WS_W2 + (size_t)(l * 17 + e) * W2_E), DE, 64 * kb, 32 * nb, 32 * nb, scr, F.lane);
#endif
          } }
}
__device__ __forceinline__ void deferred_tail(Frame& F, const Params& p, int l, int quota) {
    LAS float* scr = (LAS float*)(F.lds + F.wave * 8448);
    volatile LAS unsigned* slot = F.MISC + 48;
    __syncthreads();
    if (F.tid == 0) slot[0] = __hip_atomic_fetch_add(F.ctl + CW_DQ + 64 * l, (unsigned)(8 * quota), RLX_AGENT);
    __syncthreads();
    const int base = __builtin_amdgcn_readfirstlane((int)slot[0]);
    const int end = base + 8 * quota < DQ_N ? base + 8 * quota : DQ_N;
    for (int q = base + F.wave; q < end; q += 8) moe_item(F, p, l, q, scr);
}
__device__ __forceinline__ void deferred_drain(Frame& F, const Params& p, int l) {
    LAS float* scr = (LAS float*)(F.lds + F.wave * 8448);
    const int H = __builtin_amdgcn_readfirstlane((int)__hip_atomic_load(F.ctl + CW_DQ + 64 * l, RLX_AGENT));
    const int gw = F.vcu * NWAVES + F.wave, NGW = F.G * NWAVES;
    for (int q = H + gw; q < DQ_N; q += NGW) moe_item(F, p, l, q, scr);
}
__device__ __forceinline__ void p0_prologue(Frame& F, const Params& p) {
    unsigned char* ws = F.ws;
    LAS float* sil = (LAS float*)(F.lds + 69632);
    for (int i = F.tid; i < 5 * DM; i += NTHR) { const int v = i / DM, k = i % DM; const float x = v < 4 ? p.in[I_C][v * DM + k] : p.in[I_CCTX][k]; sil[i] = x / (1.0f + __expf(-x)); }
    { const int gt = blockIdx.x * NTHR + F.tid;
      if (gt < 1024) { const int pos = gt >> 4, i = gt & 15; const float inv = powf(10000.0f, -(float)(2 * i) / 32.0f); const float ang = (float)pos * inv;
          ((f32x2*)(ws + WS_ROPE))[gt] = (f32x2){cosf(ang), sinf(ang)}; } }
    { constexpr int WIN_ES = DFP8_IN ? 1 : 2; u32x4* z = (u32x4*)(ws + WS_WIN + (size_t)ABIN * DM * WIN_ES); const int n16 = (ABINP - ABIN) * DM * WIN_ES / 16;
      for (int i = blockIdx.x * NTHR + F.tid; i < n16; i += F.G * NTHR) z[i] = (u32x4){0u, 0u, 0u, 0u}; }
    __syncthreads();
    if (F.wave < 3) {
        for (int item = blockIdx.x * 3 + F.wave; item < 768; item += F.G * 3) {
            const int l = item / 384, rem = item % 384, cg = rem >> 3, kc = rem & 7;
            const float* wp = p.in[I_ADAW] + ((size_t)l * DM + kc * 256) * 12288 + cg * 256 + F.lane * 4;
            f32x4 a0 = {0.f, 0.f, 0.f, 0.f}, a1 = a0, a2 = a0, a3 = a0, a4 = a0;
#pragma unroll 8
            for (int kk = 0; kk < 256; ++kk) { const f32x4 w = *(const f32x4*)(wp + (size_t)kk * 12288); const int k = kc * 256 + kk;
                a0 += w * sil[k]; a1 += w * sil[DM + k]; a2 += w * sil[2 * DM + k]; a3 += w * sil[3 * DM + k]; a4 += w * sil[4 * DM + k]; }
            float* o = (float*)(ws + WS_MODP) + ((size_t)(kc * 2 + l) * 5) * 12288 + cg * 256 + F.lane * 4;
            *(f32x4*)(o) = a0; *(f32x4*)(o + 12288) = a1; *(f32x4*)(o + 2 * 12288) = a2; *(f32x4*)(o + 3 * 12288) = a3; *(f32x4*)(o + 4 * 12288) = a4;
        }
    }
    LAS float* scr = (LAS float*)(F.lds + F.wave * 8448);
    const int gw = F.vcu * NWAVES + F.wave, NGW = F.G * NWAVES;
    constexpr int I_WIN = (DM / 64) * (ABIN / 32), I_WO = (DM / 64) * (DM / 32), I_UQ = (512 / 64) * (1536 / 32), I_UKV = (512 / 64) * (2048 / 32);
    constexpr int I_G1 = 8, I_GALL = 32 * I_G1, I_QKV = (DM / 64) * (6144 / 32), I_MOE1 = 1408;
    constexpr int NITEMS = I_WIN + I_WO + I_UQ + I_UKV + I_GALL + I_QKV + I_WO;
    for (int it = gw; it < NITEMS; it += NGW) {
        int r = it;
#if DFP8_IN
        if (r < I_WIN) { xpose_job8(p.in[I_ABWIN], DM, ABIN, ws + WS_WIN, r, scr, F.lane); continue; } r -= I_WIN;
#else
        if (r < I_WIN) { xpose_job(p.in[I_ABWIN], DM, ABIN, (bf16*)(ws + WS_WIN), r, scr, F.lane); continue; } r -= I_WIN;
#endif
#if DFP8_OUT0
        if (r < I_WO) { xpose_job8(p.in[I_ABWOUT], DM, DM, ws + WS_WOUT0, r, scr, F.lane); continue; } r -= I_WO;
#else
        if (r < I_WO) { xpose_job(p.in[I_ABWOUT], DM, DM, (bf16*)(ws + WS_WOUT0), r, scr, F.lane); continue; } r -= I_WO;
#endif
        if (r < I_UQ) { xpose_job(p.in[I_WUQ], 512, 1536, (bf16*)(ws + WS_WUQ), r, scr, F.lane); continue; } r -= I_UQ;
        if (r < I_UKV) { xpose_job(p.in[I_WUKV], 512, 2048, (bf16*)(ws + WS_WUKV), r, scr, F.lane); continue; } r -= I_UKV;
        if (r < I_GALL) { const int mi = r / I_G1, rr = r % I_G1;
            const int g = mi >> 3, blk = mi & 7, dir = g >> 1, ty = g & 1;
            const float* src = (ty ? p.in[I_LWI] : p.in[I_LWA]) + (size_t)(dir * 8 + blk) * 128 * 128;
            xpose_job(src, 128, 128, (bf16*)(ws + WS_WG) + (size_t)mi * 128 * 128, rr, scr, F.lane); continue; } r -= I_GALL;
#if DFP8_QKV
        if (r < I_QKV) { xpose_job8(p.in[I_NAWQKV], DM, 6144, ws + WS_WQKV, r, scr, F.lane); continue; } r -= I_QKV;
#else
        if (r < I_QKV) { xpose_job(p.in[I_NAWQKV], DM, 6144, (bf16*)(ws + WS_WQKV), r, scr, F.lane); continue; } r -= I_QKV;
#endif
#if DFP8_OUT1
        if (r < I_WO) { xpose_job8(p.in[I_NAWOUT], DM, DM, ws + WS_WOUT1, r, scr, F.lane); continue; }
#else
        if (r < I_WO) { xpose_job(p.in[I_NAWOUT], DM, DM, (bf16*)(ws + WS_WOUT1), r, scr, F.lane); continue; }
#endif
    }
#if MOE_FP8
    for (int i = blockIdx.x * NTHR + F.tid; i < 2 * 17 * DM * 8; i += F.G * NTHR) { const int row = i >> 3, c = i & 7; *(u32x4*)(ws + WS_W2 + (size_t)row * DEP + DE + 16 * c) = (u32x4){0u, 0u, 0u, 0u}; }
#endif
}

__device__ __forceinline__ void load_row_f32(const float* xrow, int lane, f32x4 (&v)[8]) {
#pragma unroll
    for (int j = 0; j < 8; ++j) v[j] = *(const f32x4*)(xrow + 4 * lane + 256 * j);
}
__device__ __forceinline__ void load_row_bf16(const bf16* xrow, int lane, f32x4 (&v)[8]) {
#pragma unroll
    for (int j = 0; j < 8; ++j) { const u32x2 w = *(const u32x2*)(xrow + 4 * lane + 256 * j); v[j] = (f32x4){bflo(w.x), bfhi(w.x), bflo(w.y), bfhi(w.y)}; }
}
__device__ __forceinline__ float row_rstd(const f32x4 (&v)[8]) {
    float s = 0.f;
#pragma unroll
    for (int j = 0; j < 8; ++j) s += (v[j].x * v[j].x + v[j].y * v[j].y) + (v[j].z * v[j].z + v[j].w * v[j].w);
    return rsqrtf(wave_sum(s) * (1.0f / DM) + EPS);
}
__device__ __forceinline__ void store_row_bf16(bf16* orow, int lane, const f32x4 (&h)[8]) {
#pragma unroll
    for (int j = 0; j < 8; ++j) { u32x2 w; w.x = pk2(h[j].x, h[j].y); w.y = pk2(h[j].z, h[j].w); *(u32x2*)(orow + 4 * lane + 256 * j) = w; }
}
__device__ __forceinline__ void store_row_fp8(unsigned char* orow, int lane, const f32x4 (&h)[8]) {
#pragma unroll
    for (int j = 0; j < 8; ++j) *(unsigned*)(orow + 4 * lane + 256 * j) = pk4_fp8(h[j].x, h[j].y, h[j].z, h[j].w);
}
__device__ __forceinline__ void p1_modulate0(Frame& F, const Params& p) {
    unsigned char* ws = F.ws;
    const float* modp = (const float*)(ws + WS_MODP);
    { float* mod = (float*)(ws + WS_MOD);
      for (int i = blockIdx.x * NTHR + F.tid; i < 2 * 5 * 12288; i += F.G * NTHR) { const int l = i / (5 * 12288), n = i % 12288; float s = p.in[I_ADAB][l * 12288 + n];
#pragma unroll
          for (int kc = 0; kc < 8; ++kc) s += modp[(size_t)kc * (2 * 5 * 12288) + i];
          mod[i] = s; } }
    LAS float* gs = (LAS float*)F.lds; LAS float* sh = gs + DM;
    for (int g = blockIdx.x; g < NTOK / 64; g += F.G) {
        const int row0 = 64 * g, v = vec_of_row(row0);
        for (int n = F.tid; n < DM; n += NTHR) { float sc = p.in[I_ADAB][DM + n], sf = p.in[I_ADAB][n];
#pragma unroll
            for (int kc = 0; kc < 8; ++kc) { const float* mp = modp + ((size_t)(kc * 2 + 0) * 5 + v) * 12288; sf += mp[n]; sc += mp[DM + n]; }
            gs[n] = p.in[I_NMIXG][n] * (1.0f + sc); sh[n] = sf; }
        __syncthreads();
        for (int i = 0; i < 8; ++i) { const int row = row0 + F.wave + 8 * i;
            const float* xr = row < NCTX ? p.in[I_CTX] + (size_t)row * DM : p.in[I_X] + (size_t)(row - NCTX) * DM;
            f32x4 x[8]; load_row_f32(xr, F.lane, x); const float rstd = row_rstd(x);
#pragma unroll
            for (int j = 0; j < 8; ++j) { const f32x4 gg = *(const LAS f32x4*)(gs + 4 * F.lane + 256 * j), ss = *(const LAS f32x4*)(sh + 4 * F.lane + 256 * j); x[j] = x[j] * rstd * gg + ss; }
#if DFP8_IN
            store_row_fp8(ws + WS_H + (size_t)row * DM, F.lane, x); }
#else
            store_row_bf16((bf16*)(ws + WS_H) + (size_t)row * DM, F.lane, x); }
#endif
        __syncthreads();
    }
}

__device__ __forceinline__ void p3_rank_norms(Frame& F, const Params& p) {
    const bf16* U = (const bf16*)(F.ws + WS_U); bf16* CQN = (bf16*)(F.ws + WS_CQN); bf16* CKVN = (bf16*)(F.ws + WS_CKVN);
    const int gw = blockIdx.x * NWAVES + F.wave, NGW = F.G * NWAVES;
    for (int row = gw; row < NTOK; row += NGW) {
#pragma unroll
        for (int w = 0; w < 2; ++w) {
            const u32x4 v = *(const u32x4*)(U + (size_t)row * ABIN + 2048 + 512 * w + 8 * F.lane);
            float x[8] = {bflo(v.x), bfhi(v.x), bflo(v.y), bfhi(v.y), bflo(v.z), bfhi(v.z), bflo(v.w), bfhi(v.w)};
            float s = 0.f;
#pragma unroll
            for (int j = 0; j < 8; ++j) s += x[j] * x[j];
            const float rstd = rsqrtf(wave_sum(s) * (1.0f / 512.0f) + EPS);
            const float* g = (w ? p.in[I_KVNG] : p.in[I_QNG]) + 8 * F.lane;
            const f32x4 g0 = *(const f32x4*)g, g1 = *(const f32x4*)(g + 4);
            u32x4 o; o.x = pk2(x[0] * rstd * g0.x, x[1] * rstd * g0.y); o.y = pk2(x[2] * rstd * g0.z, x[3] * rstd * g0.w);
            o.z = pk2(x[4] * rstd * g1.x, x[5] * rstd * g1.y); o.w = pk2(x[6] * rstd * g1.z, x[7] * rstd * g1.w);
            *(u32x4*)((w ? CKVN : CQN) + (size_t)row * 512 + 8 * F.lane) = o;
        }
    }
}
struct ScanSt { float A, H; };
__device__ __forceinline__ ScanSt scan_comb(ScanSt s1, ScanSt s2) { return ScanSt{s1.A * s2.A, s1.H * s2.A + s2.H}; }
__device__ __forceinline__ void p3_conv_gates(Frame& F, const Params& p) {
    const bf16* U = (const bf16*)(F.ws + WS_U);
    unsigned* HA = (unsigned*)(F.ws + WS_AB);
    f32x2* AGG = (f32x2*)(F.ws + WS_AGG);
    const bf16* WG = (const bf16*)(F.ws + WS_WG);
    LAS float* xcf = (LAS float*)F.lds;
    LAS unsigned char* xab = F.lds + 64 * 129 * 4;
    LAS unsigned* ot = (LAS unsigned*)(F.lds + 51200);
    const int tid = F.tid, lane = F.lane, w = F.wave, g4 = lane >> 4;
    for (int item = blockIdx.x; item < (NTOK / 64) * 8; item += F.G) {
        const int tt = item >> 3, n = item & 7;
        int row0, pos0, slen, bb_, pc;
        if (tt < 16) { bb_ = tt >> 2; pc = tt & 3; pos0 = 64 * pc; slen = CTXL; row0 = bb_ * CTXL + pos0; }
        else { const int tl = tt - 16; bb_ = tl >> 6; pc = 4 + (tl & 63); pos0 = 64 * (tl & 63); slen = SEQ; row0 = NCTX + bb_ * SEQ + pos0; }
        { const int i = tid >> 3, cg = tid & 7, ch0 = 128 * n + 16 * cg;
          float accv[16];
#pragma unroll
          for (int c = 0; c < 16; ++c) accv[c] = p.in[I_CONVB][ch0 + c];
#pragma unroll
          for (int j = 0; j < 4; ++j) { const int pos = pos0 + i + j - 2;
              if (pos >= 0 && pos < slen) {
                  const bf16* up = U + (size_t)(row0 + i + j - 2) * ABIN + ch0;
                  const u32x4 v0 = *(const u32x4*)up, v1 = *(const u32x4*)(up + 8);
                  const float x[16] = {bflo(v0.x), bfhi(v0.x), bflo(v0.y), bfhi(v0.y), bflo(v0.z), bfhi(v0.z), bflo(v0.w), bfhi(v0.w),
                                       bflo(v1.x), bfhi(v1.x), bflo(v1.y), bfhi(v1.y), bflo(v1.z), bfhi(v1.z), bflo(v1.w), bfhi(v1.w)};
                  const float* cw = p.in[I_CONVW] + j * DRNN + ch0;
#pragma unroll
                  for (int c = 0; c < 16; ++c) accv[c] += cw[c] * x[c]; } }
#pragma unroll
          for (int c = 0; c < 16; ++c) xcf[i * 129 + 16 * cg + c] = accv[c];
          u32x4 o0, o1; o0.x = pk2(accv[0], accv[1]); o0.y = pk2(accv[2], accv[3]); o0.z = pk2(accv[4], accv[5]); o0.w = pk2(accv[6], accv[7]);
          o1.x = pk2(accv[8], accv[9]); o1.y = pk2(accv[10], accv[11]); o1.z = pk2(accv[12], accv[13]); o1.w = pk2(accv[14], accv[15]);
          *(LAS u32x4*)(xab + i * 272 + 32 * cg) = o0; *(LAS u32x4*)(xab + i * 272 + 32 * cg + 16) = o1; }
        __syncthreads();
        bf16x8 af[4][4];
#pragma unroll
        for (int m = 0; m < 4; ++m)
#pragma unroll
            for (int ks = 0; ks < 4; ++ks) af[m][ks] = *(const LAS bf16x8*)(xab + (16 * m + (lane & 15)) * 272 + (32 * ks + 8 * g4) * 2);
        const int chl = 16 * w + (lane & 15), gch = 128 * n + chl;
#pragma unroll
        for (int d = 0; d < 2; ++d) {
            f32x4 ca[4], ci[4];
#pragma unroll
            for (int m = 0; m < 4; ++m) { ca[m] = (f32x4){0.f, 0.f, 0.f, 0.f}; ci[m] = ca[m]; }
#pragma unroll
            for (int ks = 0; ks < 4; ++ks) {
                const bf16x8 ba = *(const bf16x8*)(WG + ((size_t)((2 * d + 0) * 8 + n) * 128 + chl) * 128 + 32 * ks + 8 * g4);
                const bf16x8 bi = *(const bf16x8*)(WG + ((size_t)((2 * d + 1) * 8 + n) * 128 + chl) * 128 + 32 * ks + 8 * g4);
#pragma unroll
                for (int m = 0; m < 4; ++m) { ca[m] = __builtin_amdgcn_mfma_f32_16x16x32_bf16(af[m][ks], ba, ca[m], 0, 0, 0); ci[m] = __builtin_amdgcn_mfma_f32_16x16x32_bf16(af[m][ks], bi, ci[m], 0, 0, 0); }
            }
            const float ba_ = p.in[I_LBA][d * DRNN + gch], bi_ = p.in[I_LBI][d * DRNN + gch], lam = p.in[I_LAM][d * DRNN + gch];
            const float sp = log1pf(expf(-lam));
            ScanSt el[4][4];
#pragma unroll
            for (int m = 0; m < 4; ++m)
#pragma unroll
                for (int r = 0; r < 4; ++r) { const int i = 16 * m + 4 * g4 + r;
                    const float rg = __builtin_amdgcn_rcpf(1.0f + __expf(-(ca[m][r] + ba_))), ig = __builtin_amdgcn_rcpf(1.0f + __expf(-(ci[m][r] + bi_)));
                    const float la = -8.0f * rg * sp, x2 = 2.0f * la;
                    const float em = -x2 * (1.0f + x2 * (0.5f + x2 * (0.16666667f + x2 * (0.041666668f + x2 * 0.0083333333f))));
                    el[m][r].A = __expf(la); el[m][r].H = __builtin_amdgcn_sqrtf(em) * ig * xcf[i * 129 + chl]; }
#pragma unroll
            for (int m = 0; m < 4; ++m) {
                if (d == 0) { el[m][1] = scan_comb(el[m][0], el[m][1]); el[m][2] = scan_comb(el[m][1], el[m][2]); el[m][3] = scan_comb(el[m][2], el[m][3]); }
                else        { el[m][2] = scan_comb(el[m][3], el[m][2]); el[m][1] = scan_comb(el[m][2], el[m][1]); el[m][0] = scan_comb(el[m][1], el[m][0]); }
            }
            ScanSt pre = ScanSt{1.0f, 0.0f};
#pragma unroll
            for (int mm = 0; mm < 4; ++mm) { const int m = d == 0 ? mm : 3 - mm;
                const ScanSt T = d == 0 ? el[m][3] : el[m][0];
                ScanSt Tg[4];
#pragma unroll
                for (int q = 0; q < 4; ++q) { Tg[q].A = __shfl(T.A, (lane & 15) + 16 * q); Tg[q].H = __shfl(T.H, (lane & 15) + 16 * q); }
                ScanSt ex = pre, tot = pre;
#pragma unroll
                for (int qq = 0; qq < 4; ++qq) { const int q = d == 0 ? qq : 3 - qq;
                    const bool before = d == 0 ? (q < g4) : (q > g4);
                    const ScanSt nx = scan_comb(tot, Tg[q]); tot = nx; if (before) ex = nx; }
#pragma unroll
                for (int r = 0; r < 4; ++r) { const ScanSt f = scan_comb(ex, el[m][r]); const int i = 16 * m + 4 * g4 + r;
                    ot[(d * 64 + i) * 132 + chl] = pk2(f.H, f.A); }
                pre = tot; }
            if (g4 == 0) { const int c = d == 0 ? pc : (pc < 4 ? 3 - pc : 71 - pc); AGG[((size_t)(d * NB + bb_) * NCHUNK + c) * DRNN + gch] = (f32x2){pre.A, pre.H}; }
        }
        __syncthreads();
#pragma unroll
        for (int k = 0; k < 8; ++k) { const int q = tid + NTHR * k, d = q >> 11, rr = (q >> 5) & 63, c4 = (q & 31) * 4;
            const u32x4 v = *(const LAS u32x4*)(ot + (d * 64 + rr) * 132 + c4);
            *(u32x4*)(HA + ((size_t)d * NTOK + row0 + rr) * DRNN + 128 * n + c4) = v; }
        __syncthreads();
    }
}
__device__ __forceinline__ void scan_pass_c(Frame& F) {
    const f32x2* AGG = (const f32x2*)(F.ws + WS_AGG); float* CAR = (float*)(F.ws + WS_CARRY);
    for (int t = blockIdx.x * NTHR + F.tid; t < 2 * NB * DRNN; t += F.G * NTHR) {
        const int ch = t % DRNN, db = t / DRNN;
        float carry = 0.0f;
        for (int c = 0; c < NCHUNK; ++c) { const size_t idx = ((size_t)db * NCHUNK + c) * DRNN + ch; CAR[idx] = carry; const f32x2 ag = AGG[idx]; carry = ag.x * carry + ag.y; }
    }
}
__device__ __forceinline__ void scan_pass_d(Frame& F) {
    const unsigned* HA = (const unsigned*)(F.ws + WS_AB); const float* CAR = (const float*)(F.ws + WS_CARRY);
    const bf16* U = (const bf16*)(F.ws + WS_U); bf16* YC = (bf16*)(F.ws + WS_YC);
    for (int row = blockIdx.x * NWAVES + F.wave; row < NTOK; row += F.G * NWAVES) {
        int b, pc;
        if (row < NCTX) { b = row >> 8; pc = (row & 255) >> 6; } else { const int rl = row - NCTX; b = rl >> 12; pc = 4 + ((rl & 4095) >> 6); }
        const int cb = pc < 4 ? 3 - pc : 71 - pc;
        const float* cf = CAR + ((size_t)(0 * NB + b) * NCHUNK + pc) * DRNN; const float* cbk = CAR + ((size_t)(1 * NB + b) * NCHUNK + cb) * DRNN;
#pragma unroll
        for (int j = 0; j < 4; ++j) { const int c = 4 * F.lane + 256 * j;
            const u32x4 f = *(const u32x4*)(HA + (size_t)row * DRNN + c), bk = *(const u32x4*)(HA + ((size_t)NTOK + row) * DRNN + c);
            const f32x4 c0 = *(const f32x4*)(cf + c), c1 = *(const f32x4*)(cbk + c);
            const u32x2 gt = *(const u32x2*)(U + (size_t)row * ABIN + DRNN + c);
            const float o0 = (bflo(f.x) + bfhi(f.x) * c0.x + bflo(bk.x) + bfhi(bk.x) * c1.x) * bflo(gt.x);
            const float o1 = (bflo(f.y) + bfhi(f.y) * c0.y + bflo(bk.y) + bfhi(bk.y) * c1.y) * bfhi(gt.x);
            const float o2 = (bflo(f.z) + bfhi(f.z) * c0.z + bflo(bk.z) + bfhi(bk.z) * c1.z) * bflo(gt.y);
            const float o3 = (bflo(f.w) + bfhi(f.w) * c0.w + bflo(bk.w) + bfhi(bk.w) * c1.w) * bfhi(gt.y);
#if DFP8_OUT0
            *(unsigned*)((unsigned char*)YC + (size_t)row * DM + c) = pk4_fp8(4.0f * o0, 4.0f * o1, 4.0f * o2, 4.0f * o3); }
#else
            u32x2 o; o.x = pk2(o0, o1); o.y = pk2(o2, o3);
            *(u32x2*)(YC + (size_t)row * DM + c) = o; }
#endif
    }
}

__device__ __forceinline__ void p5_mla_finalize(Frame& F, const Params& p) {
    const bf16* QRAW = (const bf16*)(F.ws + WS_QRAW); const bf16* KVRAW = (const bf16*)(F.ws + WS_KVRAW); const bf16* U = (const bf16*)(F.ws + WS_U);
    bf16* QF = (bf16*)(F.ws + WS_QF); bf16* KF = (bf16*)(F.ws + WS_KF);
    const f32x2* rope = (const f32x2*)(F.ws + WS_ROPE);
    const int lane = F.lane;
    const float gq0 = p.in[I_QHG][lane], gq1 = p.in[I_QHG][64 + lane], gq2 = p.in[I_QHG][128 + lane];
    const float gk0 = p.in[I_KHG][lane], gk1 = p.in[I_KHG][64 + lane], gk2 = p.in[I_KHG][128 + lane];
    const float qs = 0.07216878364870322f * LOG2E;
    const int gw = blockIdx.x * NWAVES + F.wave, NGW = F.G * NWAVES;
    for (int row = gw; row < NTOK; row += NGW) {
        const bool lat = row >= NCTX;
        float cs = 1.0f, sn = 0.0f;
        if (lat) { const int t = (row - NCTX) % SEQ; const int pos = (lane < 32) ? (t / GW) : (t % GW); const f32x2 r = rope[pos * 16 + (lane & 15)]; cs = r.x; sn = r.y; }
        const float kr = bf2f(U[(size_t)row * ABIN + 3072 + lane]);
        const float kr2 = kr * kr;
#pragma unroll
        for (int h = 0; h < MH; ++h) {
            { const bf16* q = QRAW + (size_t)row * 1536 + h * MQK;
              const float v0 = bf2f(q[lane]), v1 = bf2f(q[64 + lane]), v2 = bf2f(q[128 + lane]);
              const float rstd = rsqrtf(wave_sum(v0 * v0 + v1 * v1 + v2 * v2) * (1.0f / MQK) + EPS);
              const float o0 = v0 * rstd * gq0, o1 = v1 * rstd * gq1; float o2 = v2 * rstd * gq2;
              const float pr = __shfl_xor(o2, 16);
              if (lat) o2 = (lane & 16) ? (pr * sn + o2 * cs) : (o2 * cs - pr * sn);
              bf16* qo = QF + ((size_t)row * MH + h) * MQK;
              qo[lane] = (bf16)f2bf(o0 * qs); qo[64 + lane] = (bf16)f2bf(o1 * qs); qo[128 + lane] = (bf16)f2bf(o2 * qs); }
            { const bf16* k = KVRAW + (size_t)row * 2048 + h * 256;
              const float v0 = bf2f(k[lane]), v1 = bf2f(k[64 + lane]);
              const float rstd = rsqrtf(wave_sum(v0 * v0 + v1 * v1 + kr2) * (1.0f / MQK) + EPS);
              const float o0 = v0 * rstd * gk0, o1 = v1 * rstd * gk1; float o2 = kr * rstd * gk2;
              const float pr = __shfl_xor(o2, 16);
              if (lat) o2 = (lane & 16) ? (pr * sn + o2 * cs) : (o2 * cs - pr * sn);
              bf16* ko = KF + ((size_t)row * MH + h) * MQK;
              ko[lane] = (bf16)f2bf(o0); ko[64 + lane] = (bf16)f2bf(o1); ko[128 + lane] = (bf16)f2bf(o2); }
        }
    }
}

__device__ __forceinline__ int crow(int r, int hi) { return (r & 3) + 8 * (r >> 2) + 4 * hi; }
__device__ __forceinline__ int v_st(int k, int c) { const int kk = (k & ~0xC) | ((k & 4) << 1) | ((k & 8) >> 1); return ((kk >> 3) * 4 + (c >> 5)) * 512 + ((kk & 7) * 32 + (c & 31)) * 2; }
__device__ __forceinline__ int v_rd_base(int lane) { return ((lane & 3) << 3) | (((lane >> 2) & 3) << 6) | (((lane >> 4) & 1) << 5) | (((lane >> 5) & 1) << 8); }
constexpr int v_rd_off(int d0, int ks, int half) { return d0 * 512 + ks * 4096 + half * 2048; }
template <int OFF> __device__ __forceinline__ s16x4 tr_read(int vb) {
    s16x4 r; asm volatile("ds_read_b64_tr_b16 %0, %1 offset:%2" : "=&v"(r) : "v"(vb), "i"(OFF) : "memory"); return r;
}
template <int D0> __device__ __forceinline__ void pv_load(s16x4 (&v)[8], int vb) {
    v[0] = tr_read<v_rd_off(D0, 0, 0)>(vb); v[1] = tr_read<v_rd_off(D0, 0, 1)>(vb); v[2] = tr_read<v_rd_off(D0, 1, 0)>(vb); v[3] = tr_read<v_rd_off(D0, 1, 1)>(vb);
    v[4] = tr_read<v_rd_off(D0, 2, 0)>(vb); v[5] = tr_read<v_rd_off(D0, 2, 1)>(vb); v[6] = tr_read<v_rd_off(D0, 3, 0)>(vb); v[7] = tr_read<v_rd_off(D0, 3, 1)>(vb);
}
__device__ __forceinline__ void pv_mma(f32x16& od, const s16x4 (&v)[8], bf16x8 pa0, bf16x8 pa1, bf16x8 pa2, bf16x8 pa3) {
#define PKV(L, H) (bf16x8){L[0], L[1], L[2], L[3], H[0], H[1], H[2], H[3]}
    od = __builtin_amdgcn_mfma_f32_32x32x16_bf16(pa0, PKV(v[0], v[1]), od, 0, 0, 0);
    od = __builtin_amdgcn_mfma_f32_32x32x16_bf16(pa1, PKV(v[2], v[3]), od, 0, 0, 0);
    od = __builtin_amdgcn_mfma_f32_32x32x16_bf16(pa2, PKV(v[4], v[5]), od, 0, 0, 0);
    od = __builtin_amdgcn_mfma_f32_32x32x16_bf16(pa3, PKV(v[6], v[7]), od, 0, 0, 0);
#undef PKV
}
__device__ __forceinline__ void pv_d0(f32x16* o, int vb, bf16x8 pa0, bf16x8 pa1, bf16x8 pa2, bf16x8 pa3) {
    s16x4 va[8], vbb[8];
    pv_load<0>(va, vb);
    pv_load<1>(vbb, vb); asm volatile("s_waitcnt lgkmcnt(8)" ::: "memory"); __builtin_amdgcn_sched_barrier(0);
    pv_mma(o[0], va, pa0, pa1, pa2, pa3); __builtin_amdgcn_sched_barrier(0);
    pv_load<2>(va, vb); asm volatile("s_waitcnt lgkmcnt(8)" ::: "memory"); __builtin_amdgcn_sched_barrier(0);
    pv_mma(o[1], vbb, pa0, pa1, pa2, pa3); __builtin_amdgcn_sched_barrier(0);
    pv_load<3>(vbb, vb); asm volatile("s_waitcnt lgkmcnt(8)" ::: "memory"); __builtin_amdgcn_sched_barrier(0);
    pv_mma(o[2], va, pa0, pa1, pa2, pa3); __builtin_amdgcn_sched_barrier(0);
    asm volatile("s_waitcnt lgkmcnt(0)" ::: "memory"); __builtin_amdgcn_sched_barrier(0);
    pv_mma(o[3], vbb, pa0, pa1, pa2, pa3);
}
__device__ __forceinline__ void pack_p(const f32x16& p0, const f32x16& p1, bf16x8& pa0, bf16x8& pa1, bf16x8& pa2, bf16x8& pa3) {
#define PK4(P, BASE, OUT) do { unsigned a0 = cvt_pk_bf16(P[BASE + 0], P[BASE + 1]), a1 = cvt_pk_bf16(P[BASE + 2], P[BASE + 3]);   \
    unsigned b0 = cvt_pk_bf16(P[BASE + 4], P[BASE + 5]), b1 = cvt_pk_bf16(P[BASE + 6], P[BASE + 7]);                              \
    auto r0 = __builtin_amdgcn_permlane32_swap(a0, b0, false, false); auto r1 = __builtin_amdgcn_permlane32_swap(a1, b1, false, false); \
    u32x4 w = {r0[0], r1[0], r0[1], r1[1]}; OUT = __builtin_bit_cast(bf16x8, w); } while (0)
    PK4(p0, 0, pa0); PK4(p0, 8, pa1); PK4(p1, 0, pa2); PK4(p1, 8, pa3);
#undef PK4
}
template <int DQK> struct AttnG {
    static constexpr int CPR = DQK / 8, KSTR = DQK * 2 + 16, KBYTES = 64 * KSTR, NKCH = (64 * CPR) / 512, ND0 = DQK / 16;
    static constexpr int VOFF = 2 * KBYTES, LIOFF = VOFF + 2 * 16384, END = LIOFF + 8 * 128;
};
template <int DQK> __device__ __forceinline__ void attn_tile_load(bf16x8 (&kreg)[AttnG<DQK>::NKCH], bf16x8 (&vreg)[2], const bf16* kt, int ldk, const bf16* vt, int ldv, int tid) {
    using G = AttnG<DQK>;
#pragma unroll
    for (int i = 0; i < G::NKCH; ++i) { const int q = tid + 512 * i, row = q / G::CPR, ch = q % G::CPR; kreg[i] = *(const bf16x8*)(kt + (size_t)row * ldk + ch * 8); }
    const int sr = tid >> 4, sc = (tid & 15) * 8;
    vreg[0] = *(const bf16x8*)(vt + (size_t)sr * ldv + sc); vreg[1] = *(const bf16x8*)(vt + (size_t)(32 + sr) * ldv + sc);
}
template <int DQK> __device__ __forceinline__ void attn_tile_write(const bf16x8 (&kreg)[AttnG<DQK>::NKCH], const bf16x8 (&vreg)[2], LAS unsigned char* kb, LAS unsigned char* vbuf, int tid) {
    using G = AttnG<DQK>;
#pragma unroll
    for (int i = 0; i < G::NKCH; ++i) { const int q = tid + 512 * i, row = q / G::CPR, ch = q % G::CPR; *(LAS bf16x8*)(kb + row * G::KSTR + ch * 16) = kreg[i]; }
    const int sr = tid >> 4, sc = (tid & 15) * 8;
    *(LAS bf16x8*)(vbuf + v_st(sr, sc)) = vreg[0]; *(LAS bf16x8*)(vbuf + v_st(32 + sr, sc)) = vreg[1];
}
template <int DQK> __device__ __forceinline__ void attn_qkt(f32x16& p0, f32x16& p1, const LAS unsigned char* kb, const bf16x8 (&qr)[AttnG<DQK>::ND0], int r32, int hi) {
    using G = AttnG<DQK>;
    constexpr int NGRP = G::ND0 / 2;
#pragma unroll
    for (int r = 0; r < 16; ++r) { p0[r] = 0.f; p1[r] = 0.f; }
    const LAS unsigned char* k0 = kb + r32 * G::KSTR + hi * 16; const LAS unsigned char* k1 = k0 + 32 * G::KSTR;
    bf16x8 fa[4], fb[4];
#define QK_LOAD(f, g) do { f[0] = *(const LAS bf16x8*)(k0 + (2 * (g)) * 32); f[1] = *(const LAS bf16x8*)(k1 + (2 * (g)) * 32); \
        f[2] = *(const LAS bf16x8*)(k0 + (2 * (g) + 1) * 32); f[3] = *(const LAS bf16x8*)(k1 + (2 * (g) + 1) * 32); } while (0)
#define QK_MMA(f, g) do { p0 = __builtin_amdgcn_mfma_f32_32x32x16_bf16(f[0], qr[2 * (g)], p0, 0, 0, 0); p1 = __builtin_amdgcn_mfma_f32_32x32x16_bf16(f[1], qr[2 * (g)], p1, 0, 0, 0); \
        p0 = __builtin_amdgcn_mfma_f32_32x32x16_bf16(f[2], qr[2 * (g) + 1], p0, 0, 0, 0); p1 = __builtin_amdgcn_mfma_f32_32x32x16_bf16(f[3], qr[2 * (g) + 1], p1, 0, 0, 0); } while (0)
    QK_LOAD(fa, 0);
#pragma unroll
    for (int g = 0; g < NGRP; g += 2) {
        if (g + 1 < NGRP) { QK_LOAD(fb, g + 1); asm volatile("s_waitcnt lgkmcnt(4)" ::: "memory"); } else asm volatile("s_waitcnt lgkmcnt(0)" ::: "memory");
        __builtin_amdgcn_sched_barrier(0); QK_MMA(fa, g); __builtin_amdgcn_sched_barrier(0);
        if (g + 1 < NGRP) {
            if (g + 2 < NGRP) { QK_LOAD(fa, g + 2); asm volatile("s_waitcnt lgkmcnt(4)" ::: "memory"); } else asm volatile("s_waitcnt lgkmcnt(0)" ::: "memory");
            __builtin_amdgcn_sched_barrier(0); QK_MMA(fb, g + 1); __builtin_amdgcn_sched_barrier(0);
        }
    }
#undef QK_LOAD
#undef QK_MMA
}
template <bool F8, int SC> __device__ __forceinline__ void attn_store(const f32x16 (&o)[4], float lsum, LAS float* li, void* orow0v, int ldo, int r32, int hi) {
    lsum += __shfl_xor(lsum, 32);
    if (hi == 0) li[r32] = lsum;
    LDS_WAIT();
    float rli[16];
#pragma unroll
    for (int r = 0; r < 16; ++r) rli[r] = (float)SC / li[crow(r, hi)];
    if constexpr (F8) { unsigned char* orow0 = (unsigned char*)orow0v;
#pragma unroll
        for (int r = 0; r < 16; ++r) { unsigned char* op = orow0 + (size_t)crow(r, hi) * ldo + r32;
#pragma unroll
            for (int d0 = 0; d0 < 4; ++d0) op[d0 * 32] = (unsigned char)(pk4_fp8(o[d0][r] * rli[r], 0.f, 0.f, 0.f) & 0xffu); }
    } else { bf16* orow0 = (bf16*)orow0v;
#pragma unroll
        for (int r = 0; r < 16; ++r) { bf16* op = orow0 + (size_t)crow(r, hi) * ldo + r32;
#pragma unroll
            for (int d0 = 0; d0 < 4; ++d0) op[d0 * 32] = (bf16)f2bf(o[d0][r] * rli[r]); } }
    LDS_WAIT();
}

__device__ __forceinline__ void mla_unit(Frame& F, int b, int h, int qrow0, int ntile) {
    using G = AttnG<MQK>;
    const bf16* QF = (const bf16*)(F.ws + WS_QF); const bf16* KF = (const bf16*)(F.ws + WS_KF); const bf16* KVRAW = (const bf16*)(F.ws + WS_KVRAW);
    bf16* YC = (bf16*)(F.ws + WS_YC);
    const int tid = F.tid, lane = F.lane, r32 = lane & 31, hi = lane >> 5, wid = F.wave;
    LAS unsigned char* lds = F.lds;
    LAS float* li = (LAS float*)(lds + G::LIOFF + wid * 128);
    bf16x8 qr[G::ND0];
    { const bf16* qp = QF + ((size_t)(qrow0 + wid * 32 + r32) * MH + h) * MQK + hi * 8;
#pragma unroll
      for (int d0 = 0; d0 < G::ND0; ++d0) qr[d0] = *(const bf16x8*)(qp + d0 * 16); }
    f32x16 o[4];
#pragma unroll
    for (int d = 0; d < 4; ++d)
#pragma unroll
        for (int r = 0; r < 16; ++r) o[d][r] = 0.f;
    float lsum = 0.f;
    const int vb0 = (int)(unsigned)(uintptr_t)(lds + G::VOFF) + v_rd_base(lane);
    bf16x8 kreg[G::NKCH], vreg[2];
#define MLA_TROW(j) ((j) < 4 ? b * CTXL + 64 * (j) : NCTX + b * SEQ + 64 * ((j) - 4))
    { const int tr = MLA_TROW(0); attn_tile_load<MQK>(kreg, vreg, KF + ((size_t)tr * MH + h) * MQK, MH * MQK, KVRAW + (size_t)tr * 2048 + h * 256 + 128, 2048, tid); }
    attn_tile_write<MQK>(kreg, vreg, lds, lds + G::VOFF, tid);
    __syncthreads();
    for (int j = 0; j < ntile; ++j) {
        const int cur = j & 1;
        if (j + 1 < ntile) { const int tr = MLA_TROW(j + 1); attn_tile_load<MQK>(kreg, vreg, KF + ((size_t)tr * MH + h) * MQK, MH * MQK, KVRAW + (size_t)tr * 2048 + h * 256 + 128, 2048, tid); }
        f32x16 p0, p1;
        attn_qkt<MQK>(p0, p1, lds + cur * G::KBYTES, qr, r32, hi);
#pragma unroll
        for (int r = 0; r < 16; ++r) { p0[r] = __builtin_amdgcn_exp2f(p0[r]); p1[r] = __builtin_amdgcn_exp2f(p1[r]); }
        float ps = 0.f;
#pragma unroll
        for (int r = 0; r < 16; ++r) ps += p0[r] + p1[r];
        lsum += ps;
        bf16x8 pa0, pa1, pa2, pa3; pack_p(p0, p1, pa0, pa1, pa2, pa3);
        pv_d0(o, vb0 + cur * 16384, pa0, pa1, pa2, pa3);
        if (j + 1 < ntile) attn_tile_write<MQK>(kreg, vreg, lds + (cur ^ 1) * G::KBYTES, lds + G::VOFF + (cur ^ 1) * 16384, tid);
        __syncthreads();
    }
#undef MLA_TROW
#if DFP8_OUT0
    attn_store<true, 4>(o, lsum, li, (unsigned char*)YC + (size_t)(qrow0 + wid * 32) * DM + DRNN + h * MV, DM, r32, hi);
#else
    attn_store<false, 1>(o, lsum, li, YC + (size_t)(qrow0 + wid * 32) * DM + DRNN + h * MV, DM, r32, hi);
#endif
    __syncthreads();
}
__device__ __forceinline__ void p6_mla_attention(Frame& F) {
    for (int U = F.vcu; U < 544; U += F.G) {
        int b, h, qrow0, ntile;
        if (U < 512) { const int bh = U >> 4, qb = U & 15; b = bh >> 3; h = bh & 7; qrow0 = NCTX + b * SEQ + qb * 256; ntile = 68; }
        else { const int bh = U - 512; b = bh >> 3; h = bh & 7; qrow0 = b * CTXL; ntile = 4; }
        mla_unit(F, b, h, qrow0, ntile);
    }
}

__device__ __forceinline__ void p15_na_finalize(Frame& F, const Params& p) {
    bf16* QKV = (bf16*)(F.ws + WS_QKV);
    const int lane = F.lane, d0 = (lane & 15) * 8;
    f32x4 gq[2], gk[2];
    gq[0] = *(const f32x4*)(p.in[I_NAQHG] + d0); gq[1] = *(const f32x4*)(p.in[I_NAQHG] + d0 + 4);
    gk[0] = *(const f32x4*)(p.in[I_NAKHG] + d0); gk[1] = *(const f32x4*)(p.in[I_NAKHG] + d0 + 4);
    const float qs = 0.08838834764831845f * LOG2E;
    const int gw = blockIdx.x * NWAVES + F.wave, NGW = F.G * NWAVES;
    for (int row = gw; row < NTOK; row += NGW) {
        bf16* rp = QKV + (size_t)row * 6144 + 8 * lane;
        const bool doq = row >= NCTX;
        u32x4 qv[4], kv[4];
#pragma unroll
        for (int j = 0; j < 4; ++j) { kv[j] = *(const u32x4*)(rp + DM + 512 * j); if (doq) qv[j] = *(const u32x4*)(rp + 512 * j); else qv[j] = (u32x4){0u, 0u, 0u, 0u}; }
#pragma unroll
        for (int t = 0; t < 2; ++t) {
            if (t == 0 && !doq) continue;
#pragma unroll
            for (int j = 0; j < 4; ++j) { const u32x4 w = t == 0 ? qv[j] : kv[j];
                float x[8] = {bflo(w.x), bfhi(w.x), bflo(w.y), bfhi(w.y), bflo(w.z), bfhi(w.z), bflo(w.w), bfhi(w.w)};
                float ss = 0.f;
#pragma unroll
                for (int c = 0; c < 8; ++c) ss += x[c] * x[c];
                ss += __shfl_xor(ss, 1); ss += __shfl_xor(ss, 2); ss += __shfl_xor(ss, 4); ss += __shfl_xor(ss, 8);
                const float rstd = rsqrtf(ss * (1.0f / NAD) + EPS) * (t == 0 ? qs : 1.0f);
                const f32x4 g0 = t == 0 ? gq[0] : gk[0], g1 = t == 0 ? gq[1] : gk[1];
                u32x4 o; o.x = pk2(x[0] * rstd * g0.x, x[1] * rstd * g0.y); o.y = pk2(x[2] * rstd * g0.z, x[3] * rstd * g0.w);
                o.z = pk2(x[4] * rstd * g1.x, x[5] * rstd * g1.y); o.w = pk2(x[6] * rstd * g1.z, x[7] * rstd * g1.w);
                *(u32x4*)(rp + (t == 0 ? 0 : DM) + 512 * j) = o; }
        }
    }
}
__device__ __forceinline__ void na_unit(Frame& F, const Params& p, int b, int h, int R0) {
    using G = AttnG<NAD>;
    const bf16* QKV = (const bf16*)(F.ws + WS_QKV); bf16* ATT = (bf16*)(F.ws + WS_ATT2);
    const int tid = F.tid, lane = F.lane, r32 = lane & 31, hi = lane >> 5, wid = F.wave;
    LAS unsigned char* lds = F.lds;
    LAS float* li = (LAS float*)(lds + G::LIOFF + wid * 128);
    LAS float* rpbl = (LAS float*)(lds + G::END);
    for (int i = tid; i < 15 * 32; i += NTHR) { const int dr = i >> 5, dc = i & 31; rpbl[i] = dc < 31 ? p.in[I_RPB][(h * 15 + dr) * 31 + dc] * LOG2E : 0.f; }
    const int rq = R0 + (wid >> 1), qc = 32 * (wid & 1) + r32;
    const int qrow = NCTX + b * SEQ + rq * GW + qc;
    bf16x8 qr[G::ND0];
    { const bf16* qp = QKV + (size_t)qrow * 6144 + h * NAD + hi * 8;
#pragma unroll
      for (int d0 = 0; d0 < G::ND0; ++d0) qr[d0] = *(const bf16x8*)(qp + d0 * 16); }
    f32x16 o[4];
#pragma unroll
    for (int d = 0; d < 4; ++d)
#pragma unroll
        for (int r = 0; r < 16; ++r) o[d][r] = 0.f;
    float lsum = 0.f;
    const int vb0 = (int)(unsigned)(uintptr_t)(lds + G::VOFF) + v_rd_base(lane);
    const int klo = min(max(R0 - 4, 0), 56), khi = min(max(R0 + 3 - 4, 0), 56) + 7, nloc = khi - klo + 1, ntile = nloc + 4;
    const int w0 = min(max(rq - 4, 0), 56);
    const int cst = min(max(qc - 8, 0), 48);
    bf16x8 kreg[G::NKCH], vreg[2];
#define NA_TROW(j) ((j) < nloc ? NCTX + b * SEQ + (klo + (j)) * GW : b * CTXL + 64 * ((j) - nloc))
    { const int tr = NA_TROW(0); attn_tile_load<NAD>(kreg, vreg, QKV + (size_t)tr * 6144 + DM + h * NAD, 6144, QKV + (size_t)tr * 6144 + 2 * DM + h * NAD, 6144, tid); }
    attn_tile_write<NAD>(kreg, vreg, lds, lds + G::VOFF, tid);
    __syncthreads();
    for (int j = 0; j < ntile; ++j) {
        const int cur = j & 1;
        if (j + 1 < ntile) { const int tr = NA_TROW(j + 1); attn_tile_load<NAD>(kreg, vreg, QKV + (size_t)tr * 6144 + DM + h * NAD, 6144, QKV + (size_t)tr * 6144 + 2 * DM + h * NAD, 6144, tid); }
        const bool local = j < nloc; const int krow = klo + j;
        if (!local || (krow >= w0 && krow < w0 + 8)) {
            f32x16 p0, p1;
            attn_qkt<NAD>(p0, p1, lds + cur * G::KBYTES, qr, r32, hi);
            if (local) {
                const LAS float* brow = rpbl + (krow - rq + 7) * 32 + (15 - qc);
#pragma unroll
                for (int r = 0; r < 16; ++r) {
                    const int kc0 = crow(r, hi), kc1 = 32 + kc0;
                    const bool ok0 = kc0 >= cst && kc0 < cst + 16, ok1 = kc1 >= cst && kc1 < cst + 16;
                    const float b0 = ok0 ? brow[kc0] : 0.f, b1 = ok1 ? brow[kc1] : 0.f;
                    p0[r] = ok0 ? __builtin_amdgcn_exp2f(p0[r] + b0) : 0.f; p1[r] = ok1 ? __builtin_amdgcn_exp2f(p1[r] + b1) : 0.f; }
            } else {
#pragma unroll
                for (int r = 0; r < 16; ++r) { p0[r] = __builtin_amdgcn_exp2f(p0[r]); p1[r] = __builtin_amdgcn_exp2f(p1[r]); }
            }
            float ps = 0.f;
#pragma unroll
            for (int r = 0; r < 16; ++r) ps += p0[r] + p1[r];
            lsum += ps;
            bf16x8 pa0, pa1, pa2, pa3; pack_p(p0, p1, pa0, pa1, pa2, pa3);
            pv_d0(o, vb0 + cur * 16384, pa0, pa1, pa2, pa3);
        }
        if (j + 1 < ntile) attn_tile_write<NAD>(kreg, vreg, lds + (cur ^ 1) * G::KBYTES, lds + G::VOFF + (cur ^ 1) * 16384, tid);
        __syncthreads();
    }
#undef NA_TROW
#if DFP8_OUT1
    attn_store<true, 8>(o, lsum, li, (unsigned char*)ATT + (size_t)(NCTX + b * SEQ + rq * GW + 32 * (wid & 1)) * DM + h * NAD, DM, r32, hi);
#else
    attn_store<false, 1>(o, lsum, li, ATT + (size_t)(NCTX + b * SEQ + rq * GW + 32 * (wid & 1)) * DM + h * NAD, DM, r32, hi);
#endif
    __syncthreads();
}
__device__ __forceinline__ void p16_na_attention(Frame& F, const Params& p) {
    for (int rnd = 0; rnd < 4; ++rnd)
        for (int U = rnd * 256 + F.vcu; U < rnd * 256 + 256; U += F.G) { const int bh = U >> 4, rg = U & 15, b = bh >> 4, h = bh & 15; na_unit(F, p, b, h, 4 * rg); }
}

__device__ __forceinline__ void p8_h2_route(Frame& F, const Params& p, int l, const bf16* X, int rbase) {
    unsigned char* ws = F.ws;
    LAS float* wt = (LAS float*)F.lds;
    { f32x4 rw[4][4];
#pragma unroll
      for (int i = 0; i < 4; ++i)
#pragma unroll
          for (int q = 0; q < 4; ++q) rw[i][q] = *(const f32x4*)(p.in[I_RW] + (size_t)(F.tid + NTHR * i) * NE + 4 * q);
#pragma unroll
      for (int i = 0; i < 4; ++i)
#pragma unroll
          for (int q = 0; q < 4; ++q)
#pragma unroll
              for (int c = 0; c < 4; ++c) wt[(4 * q + c) * DM + F.tid + NTHR * i] = rw[i][q][c]; }
    volatile LAS unsigned* lcnt = F.MISC + 16; volatile LAS unsigned* lbase = F.MISC + 32;
    LAS int* lrec = (LAS int*)(F.MISC + 64);
    if (F.tid < 16) lcnt[F.tid] = 0u;
    __syncthreads();
    const float* mod = (const float*)(ws + WS_MOD) + (size_t)l * 5 * 12288;
    const float* gn = p.in[I_NFFNG] + l * DM;
    float rb[16];
#pragma unroll
    for (int e = 0; e < 16; ++e) rb[e] = p.in[I_RB][e];
    int it = 0;
    for (int row = rbase + blockIdx.x * NWAVES + F.wave; row < NTOK; row += F.G * NWAVES, ++it) {
        const int v = vec_of_row(row);
        f32x4 x[8]; load_row_bf16(X + (size_t)row * DM, F.lane, x); const float rstd = row_rstd(x);
        const float* mv = mod + (size_t)v * 12288;
#pragma unroll
        for (int j = 0; j < 8; ++j) { const int c = 4 * F.lane + 256 * j; const f32x4 g = *(const f32x4*)(gn + c), sc = *(const f32x4*)(mv + 4 * DM + c), sh = *(const f32x4*)(mv + 3 * DM + c);
            x[j] = x[j] * rstd * g * (1.0f + sc) + sh; }
#if MOE_FP8
#pragma unroll
        for (int j = 0; j < 8; ++j) *(unsigned*)(ws + WS_H + (size_t)row * DM + 4 * F.lane + 256 * j) = pk4_fp8(x[j].x, x[j].y, x[j].z, x[j].w);
#else
        store_row_bf16((bf16*)(ws + WS_H) + (size_t)row * DM, F.lane, x);
#endif
        float lg[16];
#pragma unroll
        for (int e = 0; e < 16; ++e) { float s = 0.f; if ((e & 3) == 0) __builtin_amdgcn_sched_barrier(0);
#pragma unroll
            for (int j = 0; j < 8; ++j) { const f32x4 w = *(const LAS f32x4*)(wt + e * DM + 4 * F.lane + 256 * j); s += (x[j].x * w.x + x[j].y * w.y) + (x[j].z * w.z + x[j].w * w.w); }
            lg[e] = wave_sum(s); }
        float sc[16], sel[16];
#pragma unroll
        for (int e = 0; e < 16; ++e) { sc[e] = 1.0f / (1.0f + expf(-lg[e])); sel[e] = sc[e] + rb[e]; }
        int best = 0; float bestv = -3.0e38f;
#pragma unroll
        for (int g = 0; g < 4; ++g) { float m1 = -3.0e38f, m2 = -3.0e38f;
#pragma unroll
            for (int k = 0; k < 4; ++k) { const float s = sel[4 * g + k]; if (s > m1) { m2 = m1; m1 = s; } else if (s > m2) m2 = s; }
            const float gs = m1 + m2; if (gs > bestv) { bestv = gs; best = g; } }
        int e0 = 0, e1 = 0; float s0 = -3.0e38f, s1 = -3.0e38f, w0 = 0.f, w1 = 0.f;
#pragma unroll
        for (int e = 0; e < 16; ++e) { if ((e >> 2) == best) { const float s = sel[e];
                if (s > s0) { s1 = s0; e1 = e0; w1 = w0; s0 = s; e0 = e; w0 = sc[e]; } else if (s > s1) { s1 = s; e1 = e; w1 = sc[e]; } } }
        const float wn = 1.0f / (w0 + w1);
        if (F.lane == 0) {
            const int lp0 = (int)__hip_atomic_fetch_add((LAS unsigned*)(lcnt + e0), 1u, __ATOMIC_RELAXED, __HIP_MEMORY_SCOPE_WORKGROUP);
            const int lp1 = (int)__hip_atomic_fetch_add((LAS unsigned*)(lcnt + e1), 1u, __ATOMIC_RELAXED, __HIP_MEMORY_SCOPE_WORKGROUP);
            if (it < 64) { LAS int* r = lrec + (F.wave * 64 + it) * 4; r[0] = e0; r[1] = e1; r[2] = lp0; r[3] = lp1; }
            ((int*)(ws + WS_TOKE))[2 * row] = e0; ((int*)(ws + WS_TOKE))[2 * row + 1] = e1;
            ((float*)(ws + WS_TOKW))[2 * row] = w0 * wn; ((float*)(ws + WS_TOKW))[2 * row + 1] = w1 * wn;
        }
    }
    __syncthreads();
    if (F.tid < 16) { const unsigned n = lcnt[F.tid]; lbase[F.tid] = n ? __hip_atomic_fetch_add(F.ctl + CW_CNT + (l * 16 + F.tid) * 64, n, RLX_AGENT) : 0u; }
    __syncthreads();
    if (F.lane == 0) { it = 0;
        for (int row = rbase + blockIdx.x * NWAVES + F.wave; row < NTOK; row += F.G * NWAVES, ++it) { if (it >= 64) break;
            const LAS int* r = lrec + (F.wave * 64 + it) * 4;
            ((int*)(ws + WS_TOKP))[2 * row] = (int)lbase[r[0]] + r[2]; ((int*)(ws + WS_TOKP))[2 * row + 1] = (int)lbase[r[1]] + r[3]; } }
    __syncthreads();
}
__device__ __forceinline__ int moe_tiles(Frame& F, int l, int nsh, volatile LAS int* tile_e, int& ntot) {
    int nt_r = 0;
    if (F.tid == 0) { int t = 0;
        for (int e = 0; e < 16; ++e) { const int c = (int)__hip_atomic_load(F.ctl + CW_CNT + (l * 16 + e) * 64, RLX_AGENT); const int n = (c + 255) >> 8; for (int i = 0; i < n; ++i) tile_e[t++] = e; }
        for (int i = 0; i < nsh; ++i) tile_e[t + i] = 16;
        tile_e[255] = t; }
    __syncthreads();
    nt_r = __builtin_amdgcn_readfirstlane(tile_e[255]); ntot = nt_r + nsh;
    return nt_r;
}
__device__ __forceinline__ void p9_scatter(Frame& F, int l, int rbase) {
    unsigned char* ws = F.ws;
    int off[17]; { int t = 0;
#pragma unroll
        for (int e = 0; e < 16; ++e) { off[e] = t * 256; const int c = (int)__hip_atomic_load(F.ctl + CW_CNT + (l * 16 + e) * 64, RLX_AGENT); t += (c + 255) >> 8; }
        off[16] = t * 256; }
    const int* toke = (const int*)(ws + WS_TOKE); const int* tokp = (const int*)(ws + WS_TOKP); int* toks = (int*)(ws + WS_TOKS); int* slottok = (int*)(ws + WS_SLOTTOK);
    for (int i = blockIdx.x * NTHR + F.tid; i < (NTOK - rbase) * 2; i += F.G * NTHR) { const int row = rbase + (i >> 1), k = i & 1;
        const int e = toke[2 * row + k]; int o = 0;
#pragma unroll
        for (int q = 0; q < 16; ++q) o = (e == q) ? off[q] : o;
        const int slot = o + tokp[2 * row + k]; slottok[slot] = row; toks[2 * row + k] = slot; }
    for (int i = blockIdx.x * NTHR + F.tid; i < NTOK - rbase; i += F.G * NTHR) slottok[off[16] + i] = rbase + i;
    for (int i = blockIdx.x * NTHR + F.tid; i < 16 * 256; i += F.G * NTHR) { const int e = i >> 8, j = i & 255; int o = 0, on = 0;
#pragma unroll
        for (int q = 0; q < 16; ++q) { o = (e == q) ? off[q] : o; on = (e == q) ? off[q + 1] : on; }
        const int c = (int)__hip_atomic_load(F.ctl + CW_CNT + (l * 16 + e) * 64, RLX_AGENT);
        if (o + c + j < on) slottok[o + c + j] = rbase; }
}
__device__ __forceinline__ void p12_combine(Frame& F, const Params& p, int l, const bf16* Xin, void* Xout, int rbase, int sr_off) {
    unsigned char* ws = F.ws;
    const bf16* Y = (const bf16*)(ws + WS_Y);
    const float* mod = (const float*)(ws + WS_MOD) + (size_t)l * 5 * 12288;
    const int* toks = (const int*)(ws + WS_TOKS); const float* tokw = (const float*)(ws + WS_TOKW);
    for (int row = rbase + blockIdx.x * NWAVES + F.wave; row < NTOK; row += F.G * NWAVES) {
        const int v = vec_of_row(row);
        const int s0 = toks[2 * row], s1 = toks[2 * row + 1]; const float w0 = tokw[2 * row], w1 = tokw[2 * row + 1];
        const bf16* y0 = Y + (size_t)s0 * DM; const bf16* y1 = Y + (size_t)s1 * DM; const bf16* ys = Y + (size_t)(sr_off + row - rbase) * DM;
        const float* g5 = mod + (size_t)v * 12288 + 5 * DM;
        f32x4 x[8];
#pragma unroll
        for (int j = 0; j < 8; ++j) { const int c = 4 * F.lane + 256 * j;
            const u32x2 xw = *(const u32x2*)(Xin + (size_t)row * DM + c); const f32x4 xi = (f32x4){bflo(xw.x), bfhi(xw.x), bflo(xw.y), bfhi(xw.y)}, g = *(const f32x4*)(g5 + c);
            const u32x2 a = *(const u32x2*)(ys + c), b0 = *(const u32x2*)(y0 + c), b1 = *(const u32x2*)(y1 + c);
            f32x4 m;
            m.x = bflo(a.x) + w0 * bflo(b0.x) + w1 * bflo(b1.x); m.y = bfhi(a.x) + w0 * bfhi(b0.x) + w1 * bfhi(b1.x);
            m.z = bflo(a.y) + w0 * bflo(b0.y) + w1 * bflo(b1.y); m.w = bfhi(a.y) + w0 * bfhi(b0.y) + w1 * bfhi(b1.y);
            x[j] = xi + g * m; }
        if (l == 0) {
            store_row_bf16((bf16*)Xout + (size_t)row * DM, F.lane, x);
            const float rstd = row_rstd(x);
            const float* m1 = (const float*)(ws + WS_MOD) + (size_t)(5 + v) * 12288; const float* gn = p.in[I_NMIXG] + DM;
#pragma unroll
            for (int j = 0; j < 8; ++j) { const int c = 4 * F.lane + 256 * j; const f32x4 g = *(const f32x4*)(gn + c), sc = *(const f32x4*)(m1 + DM + c), sh = *(const f32x4*)(m1 + c);
                x[j] = x[j] * rstd * g * (1.0f + sc) + sh; }
#if DFP8_QKV
            store_row_fp8(ws + WS_H + (size_t)row * DM, F.lane, x);
#else
            store_row_bf16((bf16*)(ws + WS_H) + (size_t)row * DM, F.lane, x);
#endif
        } else {
#pragma unroll
            for (int j = 0; j < 8; ++j) *(f32x4*)((float*)Xout + (size_t)(row - NCTX) * DM + 4 * F.lane + 256 * j) = x[j];
        }
    }
}

constexpr int NPHASE = 22;
__global__ void __launch_bounds__(NTHR, 2) mega_fwd(Params p) {
    extern __shared__ __attribute__((aligned(16))) unsigned char lds_raw[];
    Frame F;
    F.lds = (LAS unsigned char*)lds_raw; F.MISC = (volatile LAS unsigned*)(F.lds + MISC_OFF);
    F.tid = threadIdx.x; F.lane = F.tid & 63; F.wave = __builtin_amdgcn_readfirstlane(F.tid >> 6);
    F.G = gridDim.x; { const int bx = blockIdx.x; F.vcu = (F.G % 8 == 0) ? (bx % 8) * (F.G / 8) + bx / 8 : bx; }
    F.ws = p.ws; F.ctl = (unsigned*)(p.ws + WS_CTL);
    unsigned char* ws = p.ws;
    for (int u = F.tid; u < (LDS_BYTES - MISC_OFF) / 4; u += NTHR) ((LAS unsigned*)(F.lds + MISC_OFF))[u] = 0u;
    __syncthreads();
    const int lo = p.ph_lo, hi = p.ph_hi;
    XcdBarrier bar; bar.bar = F.ctl + CW_BAR; bar.x = 0; bar.st = F.MISC;
    if (hi - lo > 1) bar = xcd_barrier_post(F.ctl + CW_BAR, F.MISC);
#ifdef ONLY_PHASE
#define IN(k) ((k) == ONLY_PHASE && lo <= (k) && (k) < hi)
#else
#define IN(k) (lo <= (k) && (k) < hi)
#endif
#define SEAM(k) do { if (IN(k) && IN((k) + 1)) xcd_barrier(bar); } while (0)
#ifndef PROBE_DUP
#define PROBE_DUP (-1)
#endif
#ifndef PROBE_DUP2
#define PROBE_DUP2 (-1)
#endif
#define REP(k) for (int _rep = 0; _rep < ((PROBE_DUP == (k) || PROBE_DUP2 == (k)) ? 2 : 1); ++_rep)
    volatile LAS int* tile_e = (volatile LAS int*)(F.MISC + 2112);
#define REFRESH() do { int _tz = threadIdx.x; asm volatile("" : "+v"(_tz)); F.tid = _tz; F.lane = _tz & 63; F.wave = __builtin_amdgcn_readfirstlane(_tz >> 6); } while (0)
    const size_t TS2048 = (size_t)256 * 2048 * 2;

#define TAIL_FILL(nwg, grp, quota) do { const int _n = (nwg), _c = (int)blockIdx.x, _mine = _n > _c ? (_n - _c + F.G - 1) / F.G : 0, _max = (_n + F.G - 1) / F.G; \
        if (_mine < _max) deferred_tail(F, p, (grp), (quota)); } while (0)
#ifndef TQ_P2
#define TQ_P2 12
#define TQ_P7 12
#define TQ_P10 6
#define TQ_P11 6
#define TQ_P13 7
#endif
    if (IN(0)) REP(0) { REFRESH(); p0_prologue(F, p); } SEAM(0);
    if (IN(1)) REP(1) { REFRESH(); p1_modulate0(F, p); } SEAM(1);
    if (IN(2)) REP(2) {   REFRESH();
        pg8::DenseSched S; S.T.init(NTOK / 256, ABINP / 256, F.G, (int)blockIdx.x); S.A = (const char*)(ws + WS_H); S.Bt = (const char*)(ws + WS_WIN); S.tstepB = DFP8_IN ? TS2048 / 2 : TS2048; S.row0 = 0;
        EpiU E{(bf16*)(ws + WS_U)};
        pg8::gemm_phase<EpiU, pg8::DenseSched, DFP8_IN != 0>(F.lds, DFP8_IN ? DM : 2 * DM, S, E);
        REFRESH(); TAIL_FILL((NTOK / 256) * (ABINP / 256), 0, TQ_P2);
    } SEAM(2);
    if (IN(3)) REP(3) { REFRESH(); p3_rank_norms(F, p); REFRESH(); p3_conv_gates(F, p); } SEAM(3);
    if (IN(4)) REP(4) {   REFRESH();
        { pg8::DenseSched S; S.T.init(NTOK / 256, 1536 / 256, F.G, (int)blockIdx.x); S.A = (const char*)(ws + WS_CQN); S.Bt = (const char*)(ws + WS_WUQ); S.tstepB = (size_t)256 * 512 * 2; S.row0 = 0;
          EpiBf E{(bf16*)(ws + WS_QRAW), 1536};
          pg8::gemm_phase<EpiBf, pg8::DenseSched, false>(F.lds, 2 * 512, S, E); }
        REFRESH();
        { pg8::DenseSched S; S.T.init(NTOK / 256, 2048 / 256, F.G, (int)blockIdx.x); S.A = (const char*)(ws + WS_CKVN); S.Bt = (const char*)(ws + WS_WUKV); S.tstepB = (size_t)256 * 512 * 2; S.row0 = 0;
          EpiBf E{(bf16*)(ws + WS_KVRAW), 2048};
          pg8::gemm_phase<EpiBf, pg8::DenseSched, false>(F.lds, 2 * 512, S, E); }
    } SEAM(4);
    if (IN(5)) REP(5) { REFRESH(); p5_mla_finalize(F, p); scan_pass_c(F); } SEAM(5);
    if (IN(6)) REP(6) { REFRESH(); p6_mla_attention(F); REFRESH(); scan_pass_d(F); } SEAM(6);
    if (IN(7)) REP(7) {   REFRESH();
        pg8::DenseSched S; S.T.init(NTOK / 256, DM / 256, F.G, (int)blockIdx.x); S.A = (const char*)(ws + WS_YC); S.Bt = (const char*)(ws + WS_WOUT0); S.tstepB = DFP8_OUT0 ? TS2048 / 2 : TS2048; S.row0 = 0;
        EpiRes<true> E{p.in[I_CTX], p.in[I_X], (bf16*)(ws + WS_XA), (const float*)(ws + WS_MOD) + 2 * DM, 0};
        pg8::gemm_phase<EpiRes<true>, pg8::DenseSched, DFP8_OUT0 != 0>(F.lds, DFP8_OUT0 ? DM : 2 * DM, S, E, 0x7d7d7d7du);
        REFRESH(); TAIL_FILL((NTOK / 256) * (DM / 256), 0, TQ_P7);
    } SEAM(7);

#if MOE_FP8
#define MOE_GEMM1() do { EpiSwiglu8 E{ws + WS_ACT}; pg8::gemm_phase<EpiSwiglu8, pg8::MoeSched, true>(F.lds, DM, S, E); } while (0)
#else
#define MOE_GEMM1() do { EpiSwiglu E{(bf16*)(ws + WS_ACT)}; pg8::gemm_phase<EpiSwiglu, pg8::MoeSched, false>(F.lds, 2 * DM, S, E); } while (0)
#endif
#define MOE_PHASES(l) do { \
        constexpr int pb = (l) ? 17 : 8, rbase = (l) ? NCTX : 0, nsh = (l) ? NLAT / 256 : NTOK / 256; \
        if (IN(pb + 0)) REP(pb + 0) { REFRESH(); p8_h2_route(F, p, (l), (const bf16*)(ws + WS_XA), rbase); } SEAM(pb + 0); \
        if (IN(pb + 1)) REP(pb + 1) { REFRESH(); p9_scatter(F, (l), rbase); deferred_drain(F, p, (l)); } SEAM(pb + 1); \
        if (IN(pb + 2)) REP(pb + 2) { REFRESH(); \
            int ntot; moe_tiles(F, (l), nsh, tile_e, ntot); \
            pg8::MoeSched S; S.T.init(ntot, 11, F.G, (int)blockIdx.x); S.A = (const char*)(ws + WS_H); S.Bt = (const char*)(ws + WS_W1 + (size_t)(l) * 17 * W1_E); S.tstepB = W1_E / 11; S.estride = W1_E; \
            S.rowmap = (const int*)(ws + WS_SLOTTOK); S.tile_e = tile_e; \
            MOE_GEMM1(); \
            if ((l) == 0) { REFRESH(); TAIL_FILL(ntot * 11, 1, TQ_P10); } \
        } SEAM(pb + 2); \
        if (IN(pb + 3)) REP(pb + 3) { REFRESH(); \
            int ntot; moe_tiles(F, (l), nsh, tile_e, ntot); \
            pg8::MoeSched S; S.T.init(ntot, 8, F.G, (int)blockIdx.x); S.A = (const char*)(ws + WS_ACT); S.Bt = (const char*)(ws + WS_W2 + (size_t)(l) * 17 * W2_E); S.tstepB = W2_E / 8; S.estride = W2_E; \
            S.rowmap = nullptr; S.tile_e = tile_e; \
            EpiBf E{(bf16*)(ws + WS_Y), DM}; \
            pg8::gemm_phase<EpiBf, pg8::MoeSched, MOE_FP8 != 0>(F.lds, ACT_LD * ACT_ES, S, E); \
            if ((l) == 0) { REFRESH(); TAIL_FILL(ntot * 8, 1, TQ_P11); } \
        } SEAM(pb + 3); \
        if (IN(pb + 4)) REP(pb + 4) { REFRESH(); \
            int ntot; const int ntr = moe_tiles(F, (l), nsh, tile_e, ntot); \
            p12_combine(F, p, (l), (const bf16*)(ws + WS_XA), (l) ? (void*)p.out : (void*)(ws + WS_XB), rbase, ntr * 256); \
        } SEAM(pb + 4); \
    } while (0)
    MOE_PHASES(0);
    if (IN(13)) REP(13) {   REFRESH();
        pg8::DenseSched S; S.T.init(NTOK / 256, 6144 / 256, F.G, (int)blockIdx.x); S.A = (const char*)(ws + WS_H); S.Bt = (const char*)(ws + WS_WQKV); S.tstepB = DFP8_QKV ? TS2048 / 2 : TS2048; S.row0 = 0;
        EpiBf E{(bf16*)(ws + WS_QKV), 6144};
        pg8::gemm_phase<EpiBf, pg8::DenseSched, DFP8_QKV != 0>(F.lds, DFP8_QKV ? DM : 2 * DM, S, E);
        REFRESH(); TAIL_FILL((NTOK / 256) * (6144 / 256), 1, TQ_P13);
    } SEAM(13);
    if (IN(14)) REP(14) { REFRESH(); p15_na_finalize(F, p); } SEAM(14);
    if (IN(15)) REP(15) { REFRESH(); p16_na_attention(F, p); } SEAM(15);
    if (IN(16)) REP(16) {   REFRESH();
        pg8::DenseSched S; S.T.init(NLAT / 256, DM / 256, F.G, (int)blockIdx.x); S.A = (const char*)(ws + WS_ATT2); S.Bt = (const char*)(ws + WS_WOUT1); S.tstepB = DFP8_OUT1 ? TS2048 / 2 : TS2048; S.row0 = NCTX;
        EpiRes<false> E{(const void*)(ws + WS_XB), (const void*)(ws + WS_XB), (bf16*)(ws + WS_XA), (const float*)(ws + WS_MOD) + (size_t)5 * 12288 + 2 * DM, NCTX};
        pg8::gemm_phase<EpiRes<false>, pg8::DenseSched, DFP8_OUT1 != 0>(F.lds, DFP8_OUT1 ? DM : 2 * DM, S, E, 0x7c7c7c7cu);
    } SEAM(16);
    MOE_PHASES(1);
#undef MOE_PHASES
#undef IN
#undef SEAM
}

extern "C" void kernel_launch(void* const* d_in, const int* in_sizes, int n_in, void* d_out, int out_size, void* d_ws, size_t ws_size, hipStream_t stream) {
    static int grid = 0;
    if (grid == 0) {
        if (n_in != 36 || in_sizes[0] != NLAT * DM || out_size != NLAT * DM || ws_size < WS_END) {
            fprintf(stderr, "kernel_launch: shape mismatch: n_in %d in0 %d out %d ws %zu (need %zu)\n", n_in, n_in > 0 ? in_sizes[0] : -1, out_size, ws_size, (size_t)WS_END); grid = -1; return; }
        int dev = 0, cus = 0, per_cu = 0;
        if (hipGetDevice(&dev) != hipSuccess || hipDeviceGetAttribute(&cus, hipDeviceAttributeMultiprocessorCount, dev) != hipSuccess) { grid = -1; return; }
        if (hipFuncSetAttribute((const void*)mega_fwd, hipFuncAttributeMaxDynamicSharedMemorySize, LDS_BYTES) != hipSuccess) { fprintf(stderr, "kernel_launch: hipFuncSetAttribute failed\n"); grid = -1; return; }
        if (hipOccupancyMaxActiveBlocksPerMultiprocessor(&per_cu, (const void*)mega_fwd, NTHR, LDS_BYTES) != hipSuccess || per_cu < 1) { fprintf(stderr, "kernel_launch: occupancy query says %d\n", per_cu); }
        (void)hipGetLastError();
        grid = cus;
    }
    if (grid < 0) return;
    if (hipMemsetAsync((char*)d_ws + WS_CTL, 0, CTL_BYTES, stream) != hipSuccess) return;
    Params P{};
    for (int i = 0; i < 36; ++i) P.in[i] = (const float*)d_in[i];
    P.out = (float*)d_out; P.ws = (unsigned char*)d_ws;
#if MK_N_LAUNCHES == 1
    P.ph_lo = 0; P.ph_hi = NPHASE;
    hipLaunchKernelGGL(mega_fwd, dim3(grid), dim3(NTHR), LDS_BYTES, stream, P);
#else
    for (int k = 0; k < NPHASE; ++k) { P.ph_lo = k; P.ph_hi = k + 1; hipLaunchKernelGGL(mega_fwd, dim3(grid), dim3(NTHR), LDS_BYTES, stream, P); }
#endif
    const hipError_t le = hipPeekAtLastError();
    if (le != hipSuccess) fprintf(stderr, "kernel_launch: launch failed: %s\n", hipGetErrorName(le));
}
```

```cpp
#include <hip/hip_runtime.h>
#include <cstdio>
#include <cstdint>

#ifndef MK_N_LAUNCHES
#define MK_N_LAUNCHES 1
#endif

#define GAS __attribute__((address_space(1)))
#define LAS __attribute__((address_space(3)))
typedef unsigned short bf16;
typedef short bf16x8 __attribute__((ext_vector_type(8)));
typedef short s16x4 __attribute__((ext_vector_type(4)));
typedef float f32x2 __attribute__((ext_vector_type(2)));
typedef float f32x4 __attribute__((ext_vector_type(4)));
typedef float f32x16 __attribute__((ext_vector_type(16)));
typedef unsigned u32x2 __attribute__((ext_vector_type(2)));
typedef unsigned u32x4 __attribute__((ext_vector_type(4)));
#define LDS_WAIT() asm volatile("s_waitcnt lgkmcnt(0)" ::: "memory")
#define VM_WAIT() asm volatile("s_waitcnt vmcnt(0)" ::: "memory")
#define RLX_AGENT __ATOMIC_RELAXED, __HIP_MEMORY_SCOPE_AGENT

constexpr int DM = 2048, NB = 4, SEQ = 4096, CTXL = 256, GW = 64;
constexpr int NCTX = NB * CTXL, NLAT = NB * SEQ, NTOK = NCTX + NLAT;
constexpr int DRNN = 1024, QRK = 512, KVRK = 512, MROPE = 64, MNOPE = 128, MQK = 192, MV = 128, MH = 8;
constexpr int ABIN = 3136, ABINP = 3328;
constexpr int NAH = 16, NAD = 128;
constexpr int NE = 16, DE = 1408, NG = 4;
constexpr int NCHUNK = 68;
constexpr float EPS = 1e-6f;
constexpr float LOG2E = 1.4426950408889634f;
constexpr int MAXSLOT = 56320;

constexpr size_t al256(size_t x) { return (x + 255) / 256 * 256; }
constexpr size_t WS_CTL = 0, CTL_BYTES = 1u << 20;
constexpr int CW_TMO = 0, CW_BAR = 4096, CW_CNT = 16384;
constexpr size_t WS_MODP = CTL_BYTES;
constexpr size_t WS_MOD = WS_MODP + al256((size_t)8 * 2 * 5 * 12288 * 4);
constexpr size_t WS_ROPE = WS_MOD + al256((size_t)2 * 5 * 12288 * 4);
constexpr size_t WS_AGG = WS_ROPE + al256(64 * 16 * 8);
constexpr size_t WS_CARRY = WS_AGG + al256((size_t)2 * 4 * NCHUNK * 1024 * 8);
constexpr size_t WS_TOKE = WS_CARRY + al256((size_t)2 * 4 * NCHUNK * 1024 * 4);
constexpr size_t WS_TOKW = WS_TOKE + al256((size_t)NTOK * 8);
constexpr size_t WS_TOKP = WS_TOKW + al256((size_t)NTOK * 8);
constexpr size_t WS_TOKS = WS_TOKP + al256((size_t)NTOK * 8);
constexpr size_t WS_SLOTTOK = WS_TOKS + al256((size_t)NTOK * 8);
constexpr size_t WS_WIN = al256(WS_SLOTTOK + (size_t)MAXSLOT * 4);
constexpr size_t WS_WOUT0 = WS_WIN + (size_t)ABINP * DM * 2;
constexpr size_t WS_WUQ = WS_WOUT0 + (size_t)DM * DM * 2;
constexpr size_t WS_WUKV = WS_WUQ + (size_t)1536 * 512 * 2;
constexpr size_t WS_WG = WS_WUKV + (size_t)2048 * 512 * 2;
constexpr size_t WS_WQKV = WS_WG + (size_t)4 * 8 * 128 * 128 * 2;
constexpr size_t WS_WOUT1 = WS_WQKV + (size_t)6144 * DM * 2;
#ifndef MOE_FP8
#define MOE_FP8 1
#endif
#ifndef DFP8_IN
#define DFP8_IN 0
#endif
#ifndef DFP8_QKV
#define DFP8_QKV 1
#endif
#ifndef DFP8_OUT0
#define DFP8_OUT0 0
#endif
#ifndef DFP8_OUT1
#define DFP8_OUT1 1
#endif
constexpr int DEP = 1536;
#if MOE_FP8
constexpr size_t W1_E = (size_t)2816 * DM, W2_E = (size_t)DM * DEP;
constexpr int ACT_LD = DEP, ACT_ES = 1;
#else
constexpr size_t W1_E = (size_t)2816 * DM * 2, W2_E = (size_t)DM * DE * 2;
constexpr int ACT_LD = DE, ACT_ES = 2;
#endif
constexpr size_t WS_W1 = WS_WOUT1 + (size_t)DM * DM * 2;
constexpr size_t WS_W2 = WS_W1 + 2 * 17 * W1_E;
constexpr size_t WS_XA = WS_W2 + 2 * 17 * W2_E;
constexpr size_t XBYTES = (size_t)NTOK * DM * 4;
constexpr size_t WS_XB = WS_XA + XBYTES;
constexpr size_t WS_H = WS_XB + XBYTES;
constexpr size_t WS_D = WS_H + (size_t)NTOK * DM * 2;
constexpr size_t WS_U = WS_D;
constexpr size_t WS_AB = WS_U + al256((size_t)NTOK * ABIN * 2);
constexpr size_t ABSZ = (size_t)NTOK * DRNN * 4;
constexpr size_t WS_CQN = WS_AB + 4 * ABSZ;
constexpr size_t WS_CKVN = WS_CQN + (size_t)NTOK * 512 * 2;
constexpr size_t WS_YC = WS_CKVN + (size_t)NTOK * 512 * 2;
constexpr size_t WS_D_END0 = WS_YC + (size_t)NTOK * DM * 2;
constexpr size_t WS_QRAW = WS_XA;
constexpr size_t WS_KVRAW = WS_QRAW + al256((size_t)NTOK * 1536 * 2);
constexpr size_t WS_QF = WS_XB;
constexpr size_t WS_KF = WS_QF + al256((size_t)NTOK * 1536 * 2);
static_assert(WS_KVRAW + (size_t)NTOK * 2048 * 2 <= WS_XB && WS_KF + (size_t)NTOK * 1536 * 2 <= WS_H, "mixer overlays");
constexpr size_t WS_ACT = WS_D;
constexpr size_t WS_Y = WS_ACT + al256((size_t)MAXSLOT * ACT_LD * ACT_ES);
constexpr size_t WS_D_END1 = WS_Y + (size_t)MAXSLOT * DM * 2;
constexpr size_t WS_QKV = WS_D;
constexpr size_t WS_ATT2 = WS_QKV + (size_t)NTOK * 6144 * 2;
constexpr size_t WS_D_END2 = WS_ATT2 + (size_t)NTOK * DM * 2;
constexpr size_t WS_END = (WS_D_END0 > WS_D_END1 ? (WS_D_END0 > WS_D_END2 ? WS_D_END0 : WS_D_END2) : (WS_D_END1 > WS_D_END2 ? WS_D_END1 : WS_D_END2));

constexpr int RING_BYTES = 131072;
constexpr int MISC_OFF = RING_BYTES;
constexpr int LDS_BYTES = 147456;
constexpr int NWAVES = 8, NTHR = 512;

__device__ __forceinline__ unsigned f2bf(float f) { unsigned u = __builtin_bit_cast(unsigned, f); return (u + 0x7fffu + ((u >> 16) & 1u)) >> 16; }
__device__ __forceinline__ unsigned pk2(float lo, float hi) { return f2bf(lo) | (f2bf(hi) << 16); }
__device__ __forceinline__ float bf2f(unsigned short b) { return __builtin_bit_cast(float, (unsigned)b << 16); }
__device__ __forceinline__ float bflo(unsigned w) { return __builtin_bit_cast(float, w << 16); }
__device__ __forceinline__ float bfhi(unsigned w) { return __builtin_bit_cast(float, w & 0xffff0000u); }
__device__ __forceinline__ unsigned cvt_pk_bf16(float lo, float hi) { unsigned r; asm volatile("v_cvt_pk_bf16_f32 %0, %1, %2" : "=v"(r) : "v"(lo), "v"(hi)); return r; }
__device__ __forceinline__ float clamp_e4m3(float x) { return __builtin_amdgcn_fmed3f(x, -448.0f, 448.0f); }
__device__ __forceinline__ unsigned pk4_fp8(float a, float b, float c, float d) { int w = 0; w = __builtin_amdgcn_cvt_pk_fp8_f32(clamp_e4m3(a), clamp_e4m3(b), w, false); w = __builtin_amdgcn_cvt_pk_fp8_f32(clamp_e4m3(c), clamp_e4m3(d), w, true); return (unsigned)w; }
__device__ __forceinline__ float wave_sum(float v) {
#pragma unroll
    for (int o = 1; o < 64; o <<= 1) v += __shfl_xor(v, o);
    return v;
}
__device__ __forceinline__ float sigmoidf_(float x) { return 1.0f / (1.0f + __expf(-x)); }
__device__ __forceinline__ float gelu_tanh(float x) { const float u = 0.7978845608028654f * (x + 0.044715f * x * x * x); const float th = 1.0f - 2.0f / (1.0f + __expf(2.0f * u)); return 0.5f * x * (1.0f + th); }
__device__ __forceinline__ int vec_of_row(int row) { return row < NCTX ? 4 : (row - NCTX) / SEQ; }

#define XB_TMO      128
#define XB_XCNT(j)  (256  + 64 * (j))
#define XB_XSUB(j)  (1280 + 64 * (j))
#define XB_XGEN(j)  (2304 + 64 * (j))
#define XB_TOP      3328
#define XB_TOPGEN   3392
#define XCD_BAR_WORDS 3456
#define XB_SPIN_CAP (1u << 18)
__device__ __forceinline__ unsigned xb_ld(unsigned* p)              { return __hip_atomic_load(p, __ATOMIC_RELAXED, __HIP_MEMORY_SCOPE_AGENT); }
__device__ __forceinline__ unsigned xb_add(unsigned* p, unsigned v) { return __hip_atomic_fetch_add(p, v, __ATOMIC_RELAXED, __HIP_MEMORY_SCOPE_AGENT); }
__device__ __forceinline__ unsigned xb_xcc_id() { return (unsigned)__builtin_amdgcn_s_getreg((3 << 11) | 20) & 0xFu; }
#define XB_SPIN(cond, bar) do { unsigned _sp = 0; while (cond) { __builtin_amdgcn_s_sleep(1); \
    if ((++_sp & 255u) == 0u) { if (xb_ld(&(bar)[XB_TMO])) break; if (_sp > XB_SPIN_CAP) { atomicAdd(&(bar)[XB_TMO], 1u); break; } } } } while (0)
struct XcdBarrier { unsigned* bar; unsigned x; volatile LAS unsigned* st; };
__device__ __forceinline__ XcdBarrier xcd_barrier_post(unsigned* bar, volatile LAS unsigned* st) {
    XcdBarrier b; b.bar = bar; b.x = xb_xcc_id(); b.st = st;
    if (threadIdx.x == 0) (void)xb_add(&bar[XB_XCNT(b.x)], 1u);
    return b;
}
__device__ __forceinline__ void xcd_barrier_complete(unsigned* bar, unsigned x, unsigned& nloc, unsigned& nx) {
    const unsigned G = gridDim.x * gridDim.y * gridDim.z;
    unsigned sum, cnt, mine, sp = 0u;
    for (;;) {
        sum = 0u; cnt = 0u; mine = 0u;
#pragma unroll
        for (unsigned j = 0; j < 16; ++j) { const unsigned c = xb_ld(&bar[XB_XCNT(j)]); sum += c; cnt += (c > 0u) ? 1u : 0u; mine = (j == x) ? c : mine; }
        if (sum == G) break;
        __builtin_amdgcn_s_sleep(1);
        if ((++sp & 255u) == 0u) { if (xb_ld(&bar[XB_TMO])) break; if (sp > XB_SPIN_CAP) { atomicAdd(&bar[XB_TMO], 1u); break; } }
    }
    nloc = mine > 0u ? mine : 1u; nx = cnt > 0u ? cnt : 1u;
}
__device__ __forceinline__ void xcd_barrier(const XcdBarrier& b) {
    asm volatile("s_waitcnt vmcnt(0)" ::: "memory");
    __syncthreads();
    if (threadIdx.x == 0) {
        unsigned* bar = b.bar;
        __builtin_amdgcn_s_waitcnt(0);
        unsigned nloc = b.st[0], nx = b.st[1];
        if (nloc == 0u) { xcd_barrier_complete(bar, b.x, nloc, nx); b.st[0] = nloc; b.st[1] = nx; }
        const unsigned old = xb_add(&bar[XB_XSUB(b.x)], 1u);
        const unsigned gen = old / nloc;
        if (old + 1u == (gen + 1u) * nloc) {
            __builtin_amdgcn_fence(__ATOMIC_RELEASE, "agent");
            asm volatile("s_waitcnt vmcnt(0)" ::: "memory");
            const unsigned og = xb_add(&bar[XB_TOP], 1u);
            const unsigned tg = og / nx;
            if (og + 1u == (tg + 1u) * nx) xb_add(&bar[XB_TOPGEN], 1u);
            else XB_SPIN(xb_ld(&bar[XB_TOPGEN]) == tg, bar);
            __builtin_amdgcn_fence(__ATOMIC_ACQUIRE, "agent");
            xb_add(&bar[XB_XGEN(b.x)], 1u);
            asm volatile("s_waitcnt vmcnt(0)" ::: "memory");
        } else {
            XB_SPIN(xb_ld(&bar[XB_XGEN(b.x)]) == gen, bar);
            __builtin_amdgcn_fence(__ATOMIC_ACQUIRE, "agent");
            asm volatile("s_waitcnt vmcnt(0)" ::: "memory");
        }
    }
    __syncthreads();
}

namespace pg8 {
constexpr int BM = 256, BK = 64, HALF = 128, HTB = HALF * BK * 2, STAGE_BYTES = 8 * HTB, NXCD = 8, WGM = 8;
__device__ __forceinline__ int lds_byte(int r, int c) { const int st = (r >> 4) * 2 + (c >> 5), rr = r & 15, cc = c & 31, ob = rr * 64 + cc * 2; return st * 1024 + (ob ^ (((ob >> 9) & 1) << 5)); }
__device__ __forceinline__ void stage_rc(int b, int& R, int& C) { const int st = b / 1024, sb = b % 1024, swz = sb ^ (((sb >> 9) & 1) << 5); R = (st >> 1) * 16 + swz / 64; C = (st & 1) * 32 + (swz % 64) / 2; }
__device__ __forceinline__ int perm32(int rho) { const int n = rho >> 4, i = rho & 15; return 8 * (i >> 2) + 4 * n + (i & 3); }

__device__ __forceinline__ void dma16(unsigned lds_dst, const void* sbase, unsigned voff) {
    unsigned keep;
    asm volatile("s_mov_b32 %0, m0\n\ts_mov_b32 m0, %3\n\ts_nop 0\n\tglobal_load_lds_dwordx4 %1, %2\n\ts_mov_b32 m0, %0" : "=&s"(keep) : "v"(voff), "s"(sbase), "s"(lds_dst) : "memory");
}
struct Unit {
    const char* ap;
    const char* bp;
    const int* rowmap;
    int arow0;
    int pm, pn, grp;
};
struct TileOrder {
    int nM, nN, nwg, G, c;
    __device__ __forceinline__ void init(int nM_, int nN_, int G_, int c_) { nM = nM_; nN = nN_; nwg = nM * nN; G = G_; c = c_; }
    __device__ __forceinline__ bool tile(int i, int& pm, int& pn) const {
        const long L = (long)i * G + c; if (L >= nwg) return false;
        int wgid = (int)L; { const int q = nwg / NXCD, r = nwg % NXCD, xcd = wgid % NXCD, off = wgid / NXCD; wgid = (xcd < r ? xcd * (q + 1) : r * (q + 1) + (xcd - r) * q) + off; }
        const int nig = WGM * nN, gid = wgid / nig, fm = gid * WGM, gsz = (nM - fm) < WGM ? (nM - fm) : WGM;
        pm = fm + ((wgid % nig) % gsz); pn = (wgid % nig) / gsz; return true;
    }
};
struct DenseSched {
    TileOrder T; const char* A; const char* Bt; size_t tstepB; int row0;
    __device__ __forceinline__ bool next(int i, Unit& u) const {
        int pm, pn; if (!T.tile(i, pm, pn)) return false;
        u.ap = A; u.bp = Bt + (size_t)pn * tstepB; u.rowmap = nullptr; u.arow0 = row0 + pm * BM; u.pm = pm; u.pn = pn; u.grp = 0; return true;
    }
};
struct MoeSched {
    TileOrder T; const char* A; const char* Bt; size_t tstepB, estride; const int* rowmap; const volatile LAS int* tile_e;
    __device__ __forceinline__ bool next(int i, Unit& u) const {
        int pm, pn; if (!T.tile(i, pm, pn)) return false;
        const int e = __builtin_amdgcn_readfirstlane(tile_e[pm]);
        u.ap = A; u.bp = Bt + (size_t)e * estride + (size_t)pn * tstepB; u.rowmap = rowmap; u.arow0 = pm * BM; u.pm = pm; u.pn = pn; u.grp = e; return true;
    }
};

typedef int v8i __attribute__((ext_vector_type(8)));
template <class Epi, class Sched, bool FP8>
__device__ __forceinline__ void gemm_phase(LAS unsigned char* lds, const int rowBytes, const Sched& S, const Epi& E, const unsigned sclA = 0x7f7f7f7fu) {
    const int tid = threadIdx.x, wid = __builtin_amdgcn_readfirstlane(tid >> 6), lane = tid & 63, wr = wid >> 2, wc = wid & 3, fr = lane & 15, fq = lane >> 4;
    const int nt = rowBytes / 128;
    int sR[2]; unsigned sC2[2], voffB[2];
#pragma unroll
    for (int i = 0; i < 2; ++i) { int R, C;
        if constexpr (FP8) { R = (tid >> 3) + 64 * i; const int t = R >> 1, g = (t & 1) | (t & 4); C = (((tid & 7) - g) & 7) * 8; }
        else stage_rc(tid * 16 + i * 8192, R, C);
        const int Rb = Epi::PERM ? ((R & ~31) + perm32(R & 31)) : R;
        sR[i] = R; sC2[i] = (unsigned)C * 2u; voffB[i] = (unsigned)Rb * (unsigned)rowBytes + (unsigned)C * 2u; }
    const size_t kstep = 128;
    const size_t hstepB = (size_t)HALF * rowBytes;
    const unsigned rowB = (unsigned)rowBytes;
    const unsigned ldsw = (unsigned)wid * 1024u;
    int aoff, boff, aoff1 = 0, boff1 = 0;
    if constexpr (FP8) { const int t = fr >> 1, g = (t & 1) | (t & 4);
        aoff = (wr * 64 + fr) * 128 + ((2 * fq + g) & 7) * 16; aoff1 = (wr * 64 + fr) * 128 + ((2 * fq + 1 + g) & 7) * 16;
        boff = (wc * 32 + fr) * 128 + ((2 * fq + g) & 7) * 16; boff1 = (wc * 32 + fr) * 128 + ((2 * fq + 1 + g) & 7) * 16; }
    else { aoff = lds_byte(wr * 64 + fr, fq * 8); boff = lds_byte(wc * 32 + fr, fq * 8); }
#define PG8_SA(b, h) (((b) * 2 + (h)) * HTB)
#define PG8_SB(b, h) ((4 + (b) * 2 + (h)) * HTB)
#define PG8_STAGE(bufoff, gbase, voff) do { _Pragma("unroll") for (int _i = 0; _i < 2; ++_i) \
        dma16((unsigned)((bufoff) + _i * 8192) + ldsw, (const void*)(gbase), (voff)[_i]); } while (0)
#define PG8_LD8(base, o0, o1) __builtin_shufflevector(*(const LAS u32x4*)(lds + (base) + (o0)), *(const LAS u32x4*)(lds + (base) + (o1)), 0, 1, 2, 3, 4, 5, 6, 7)
#define PG8_LDA(dst, b, h) do { if constexpr (FP8) { _Pragma("unroll") for (int m = 0; m < 4; ++m) dst##8[m] = __builtin_bit_cast(v8i, PG8_LD8(PG8_SA(b, h) + m * 2048, aoff, aoff1)); } \
        else { _Pragma("unroll") for (int m = 0; m < 4; ++m) _Pragma("unroll") for (int k = 0; k < 2; ++k) dst[m][k] = *(const LAS bf16x8*)(lds + PG8_SA(b, h) + aoff + m * 2048 + k * 1024); } } while (0)
#define PG8_LDB(dst, b, h) do { if constexpr (FP8) { _Pragma("unroll") for (int n = 0; n < 2; ++n) dst##8[n] = __builtin_bit_cast(v8i, PG8_LD8(PG8_SB(b, h) + n * 2048, boff, boff1)); } \
        else { _Pragma("unroll") for (int n = 0; n < 2; ++n) _Pragma("unroll") for (int k = 0; k < 2; ++k) dst[n][k] = *(const LAS bf16x8*)(lds + PG8_SB(b, h) + boff + n * 2048 + k * 1024); } } while (0)
#define PG8_MMA(ai, bj, At, Bt) do { __builtin_amdgcn_s_setprio(1); \
        if constexpr (FP8) { _Pragma("unroll") for (int m = 0; m < 4; ++m) _Pragma("unroll") for (int n = 0; n < 2; ++n) \
            asm volatile("v_mfma_scale_f32_16x16x128_f8f6f4 %0, %1, %2, %0, %3, %4 op_sel_hi:[0,0,0]" : "+v"(acc[ai][bj][m][n]) : "v"(Bt##8[n]), "v"(At##8[m]), "v"(sclW), "v"(sclA)); } \
        else { _Pragma("unroll") for (int m = 0; m < 4; ++m) _Pragma("unroll") for (int n = 0; n < 2; ++n) _Pragma("unroll") for (int k = 0; k < 2; ++k) \
            acc[ai][bj][m][n] = __builtin_amdgcn_mfma_f32_16x16x32_bf16(Bt[n][k], At[m][k], acc[ai][bj][m][n], 0, 0, 0); } \
        __builtin_amdgcn_s_setprio(0); } while (0)
#define PG8_WAIT_V(n) asm volatile("s_waitcnt vmcnt(" #n ")" ::: "memory")
#define PG8_WAIT_L(n) asm volatile("s_waitcnt lgkmcnt(" #n ")" ::: "memory")
#define PG8_BAR __builtin_amdgcn_s_barrier()
#define PG8_SCHED __builtin_amdgcn_sched_barrier(0)
#define PG8_MKOFF(u, o0, o1) do { _Pragma("unroll") for (int _i = 0; _i < 2; ++_i) { const int _r0 = (u).arow0 + sR[_i], _r1 = _r0 + HALF; \
        const int _g0 = (u).rowmap ? (u).rowmap[_r0] : _r0, _g1 = (u).rowmap ? (u).rowmap[_r1] : _r1; \
        o0[_i] = (unsigned)_g0 * rowB + sC2[_i]; o1[_i] = (unsigned)_g1 * rowB + sC2[_i]; } } while (0)
    Unit cur, nxt; int ui = 0;
    if (!S.next(0, cur)) return;
    f32x4 acc[2][2][4][2];
#pragma unroll
    for (int a = 0; a < 2; ++a)
#pragma unroll
        for (int b = 0; b < 2; ++b)
#pragma unroll
            for (int m = 0; m < 4; ++m)
#pragma unroll
                for (int n = 0; n < 2; ++n) acc[a][b][m][n] = (f32x4){0.f, 0.f, 0.f, 0.f};
    bf16x8 At[4][2], B0[2][2], B1[2][2]; v8i At8[4], B08[2], B18[2];
    const unsigned sclW = 0x79797979u;
    unsigned oc0[2], oc1[2], on0[2], on1[2];
    PG8_MKOFF(cur, oc0, oc1);
    on0[0] = oc0[0]; on0[1] = oc0[1]; on1[0] = oc1[0]; on1[1] = oc1[1];
    const char* cA = cur.ap; const char* cB = cur.bp;
    PG8_STAGE(PG8_SB(0, 0), cB, voffB); PG8_STAGE(PG8_SB(0, 1), cB + hstepB, voffB); PG8_STAGE(PG8_SA(0, 0), cA, oc0); PG8_STAGE(PG8_SA(0, 1), cA, oc1);
    if (wr == 1) PG8_BAR;
    PG8_WAIT_V(2); PG8_BAR;
    PG8_STAGE(PG8_SB(1, 0), cB + kstep, voffB); PG8_STAGE(PG8_SA(1, 0), cA + kstep, oc0); PG8_STAGE(PG8_SB(1, 1), cB + hstepB + kstep, voffB);
    PG8_WAIT_V(6); PG8_BAR;
    for (;;) {
        const bool has_next = S.next(ui + 1, nxt);
        const char* nA = has_next ? nxt.ap : cA; const char* nB = has_next ? nxt.bp : cB;
        for (int t = 0; t < nt; t += 2) {
            const bool last = (t == nt - 2);
            if (last && has_next) { PG8_MKOFF(nxt, on0, on1); }
            const char* a1 = cA + (size_t)(t + 1) * kstep;
            const char* a2 = last ? nA : cA + (size_t)(t + 2) * kstep; const char* b2 = last ? nB : cB + (size_t)(t + 2) * kstep;
            const char* a3 = a2 + kstep; const char* b3 = b2 + kstep;
            unsigned o20[2], o21[2];
            o20[0] = last ? on0[0] : oc0[0]; o20[1] = last ? on0[1] : oc0[1]; o21[0] = last ? on1[0] : oc1[0]; o21[1] = last ? on1[1] : oc1[1];
            PG8_LDB(B0, 0, 0); PG8_LDB(B1, 0, 1); PG8_SCHED; PG8_LDA(At, 0, 0); PG8_STAGE(PG8_SA(1, 1), a1, oc1);
            PG8_WAIT_V(8); PG8_WAIT_L(0); PG8_BAR; PG8_MMA(0, 0, At, B0); PG8_MMA(0, 1, At, B1); PG8_BAR; PG8_SCHED;
            PG8_LDA(At, 0, 1); PG8_STAGE(PG8_SB(0, 0), b2, voffB); PG8_STAGE(PG8_SB(0, 1), b2 + hstepB, voffB); PG8_STAGE(PG8_SA(0, 0), a2, o20);
            PG8_WAIT_V(8); PG8_WAIT_L(0); PG8_BAR; PG8_MMA(1, 0, At, B0); PG8_MMA(1, 1, At, B1); PG8_BAR; PG8_SCHED;
            PG8_LDB(B0, 1, 0); PG8_LDB(B1, 1, 1); PG8_SCHED; PG8_LDA(At, 1, 0); PG8_STAGE(PG8_SA(0, 1), a2, o21);
            PG8_WAIT_V(8); PG8_WAIT_L(0); PG8_BAR; PG8_MMA(0, 0, At, B0); PG8_MMA(0, 1, At, B1); PG8_BAR; PG8_SCHED;
            PG8_LDA(At, 1, 1); PG8_STAGE(PG8_SB(1, 0), b3, voffB); PG8_STAGE(PG8_SB(1, 1), b3 + hstepB, voffB); PG8_STAGE(PG8_SA(1, 0), a3, o20);
            PG8_WAIT_V(8); PG8_WAIT_L(0); PG8_BAR; PG8_MMA(1, 0, At, B0); PG8_MMA(1, 1, At, B1); PG8_BAR; PG8_SCHED;
        }
        if (wr == 0) PG8_BAR;
        if constexpr (FP8) asm volatile("s_nop 15\n\ts_nop 15" ::: "memory");
        E(acc, cur, wr, wc, fr, fq);
        if (!has_next) break;
#pragma unroll
        for (int a = 0; a < 2; ++a)
#pragma unroll
            for (int b = 0; b < 2; ++b)
#pragma unroll
                for (int m = 0; m < 4; ++m)
#pragma unroll
                    for (int n = 0; n < 2; ++n) acc[a][b][m][n] = (f32x4){0.f, 0.f, 0.f, 0.f};
        cur = nxt; cA = nA; cB = nB; ++ui;
        oc0[0] = on0[0]; oc0[1] = on0[1]; oc1[0] = on1[0]; oc1[1] = on1[1];
        if (wr == 1) PG8_BAR;
    }
    PG8_WAIT_V(0);
    PG8_BAR;
#undef PG8_SA
#undef PG8_SB
#undef PG8_STAGE
#undef PG8_LDA
#undef PG8_LD8
#undef PG8_LDB
#undef PG8_MMA
#undef PG8_WAIT_V
#undef PG8_WAIT_L
#undef PG8_BAR
#undef PG8_SCHED
#undef PG8_MKOFF
}
}

struct Params { const float* in[36]; float* out; unsigned char* ws; int ph_lo, ph_hi; };
enum { I_X = 0, I_C, I_CTX, I_CCTX, I_ADAW, I_ADAB, I_NMIXG, I_NFFNG, I_ABWIN, I_ABWOUT, I_CONVW, I_CONVB, I_LWA, I_LBA, I_LWI, I_LBI, I_LAM,
       I_QNG, I_WUQ, I_KVNG, I_WUKV, I_QHG, I_KHG, I_NAWQKV, I_NAWOUT, I_NAQHG, I_NAKHG, I_RPB, I_RW, I_RB, I_MWG, I_MWU, I_MWD, I_MSG, I_MSU, I_MSD };

using pg8::Unit;
struct EpiU {
    static constexpr bool PERM = true;
    bf16* U;
    __device__ __forceinline__ void operator()(const f32x4 (&acc)[2][2][4][2], const Unit& u, int wr, int wc, int fr, int fq) const {
        const int row0 = u.pm * 256 + wr * 64 + fr, col0 = u.pn * 256 + wc * 32 + 8 * fq;
        const bool gel = (u.pn >= 4 && u.pn < 8);
#pragma unroll
        for (int ai = 0; ai < 2; ++ai)
#pragma unroll
            for (int m = 0; m < 4; ++m) { bf16* rowp = U + (size_t)(row0 + ai * 128 + m * 16) * ABIN + col0;
#pragma unroll
                for (int bj = 0; bj < 2; ++bj) { if (col0 + bj * 128 >= ABIN) continue;
                    f32x4 v0 = acc[ai][bj][m][0], v1 = acc[ai][bj][m][1];
                    if (gel) {
#pragma unroll
                        for (int j = 0; j < 4; ++j) { v0[j] = gelu_tanh(v0[j]); v1[j] = gelu_tanh(v1[j]); } }
                    u32x4 w; w.x = cvt_pk_bf16(v0[0], v0[1]); w.y = cvt_pk_bf16(v0[2], v0[3]); w.z = cvt_pk_bf16(v1[0], v1[1]); w.w = cvt_pk_bf16(v1[2], v1[3]);
                    *(u32x4*)(rowp + bj * 128) = w; } }
    }
};
struct EpiBf {
    static constexpr bool PERM = true;
    bf16* O; int ldc;
    __device__ __forceinline__ void operator()(const f32x4 (&acc)[2][2][4][2], const Unit& u, int wr, int wc, int fr, int fq) const {
        const int row0 = u.pm * 256 + wr * 64 + fr, col0 = u.pn * 256 + wc * 32 + 8 * fq;
#pragma unroll
        for (int ai = 0; ai < 2; ++ai)
#pragma unroll
            for (int m = 0; m < 4; ++m) { bf16* rowp = O + (size_t)(row0 + ai * 128 + m * 16) * ldc + col0;
#pragma unroll
                for (int bj = 0; bj < 2; ++bj) { const f32x4 v0 = acc[ai][bj][m][0], v1 = acc[ai][bj][m][1];
                    u32x4 w; w.x = cvt_pk_bf16(v0[0], v0[1]); w.y = cvt_pk_bf16(v0[2], v0[3]); w.z = cvt_pk_bf16(v1[0], v1[1]); w.w = cvt_pk_bf16(v1[2], v1[3]);
                    *(u32x4*)(rowp + bj * 128) = w; } }
    }
};
template <bool INF32> struct EpiRes {
    static constexpr bool PERM = true;
    const void* xin_ctx; const void* xin_lat;
    bf16* xout; const float* gate; int row0;
    __device__ __forceinline__ void operator()(const f32x4 (&acc)[2][2][4][2], const Unit& u, int wr, int wc, int fr, int fq) const {
        const int r0 = row0 + u.pm * 256 + wr * 64 + fr, col0 = u.pn * 256 + wc * 32 + 8 * fq;
        const int v = vec_of_row(row0 + u.pm * 256);
        f32x4 g[2][2];
#pragma unroll
        for (int bj = 0; bj < 2; ++bj)
#pragma unroll
            for (int n = 0; n < 2; ++n) g[bj][n] = *(const f32x4*)(gate + (size_t)v * 12288 + col0 + bj * 128 + n * 4);
#pragma unroll
        for (int ai = 0; ai < 2; ++ai)
#pragma unroll
            for (int m = 0; m < 4; ++m) { const int row = r0 + ai * 128 + m * 16; bf16* xo = xout + (size_t)row * DM + col0;
#pragma unroll
                for (int bj = 0; bj < 2; ++bj) { f32x4 x0, x1;
                    if constexpr (INF32) { const float* xi = (row < NCTX ? (const float*)xin_ctx + (size_t)row * DM : (const float*)xin_lat + (size_t)(row - NCTX) * DM) + col0 + bj * 128;
                        x0 = *(const f32x4*)xi; x1 = *(const f32x4*)(xi + 4); }
                    else { const u32x4 w = *(const u32x4*)((const bf16*)xin_ctx + (size_t)row * DM + col0 + bj * 128);
                        x0 = (f32x4){bflo(w.x), bfhi(w.x), bflo(w.y), bfhi(w.y)}; x1 = (f32x4){bflo(w.z), bfhi(w.z), bflo(w.w), bfhi(w.w)}; }
                    x0 = x0 + g[bj][0] * acc[ai][bj][m][0]; x1 = x1 + g[bj][1] * acc[ai][bj][m][1];
                    u32x4 o; o.x = cvt_pk_bf16(x0[0], x0[1]); o.y = cvt_pk_bf16(x0[2], x0[3]); o.z = cvt_pk_bf16(x1[0], x1[1]); o.w = cvt_pk_bf16(x1[2], x1[3]);
                    *(u32x4*)(xo + bj * 128) = o; } }
    }
};
struct EpiSwiglu {
    static constexpr bool PERM = true;
    bf16* ACT;
    __device__ __forceinline__ void operator()(const f32x4 (&acc)[2][2][4][2], const Unit& u, int wr, int wc, int fr, int fq) const {
        const int row0 = u.pm * 256 + wr * 64 + fr, col0 = u.pn * 128 + wc * 32 + 8 * fq;
#pragma unroll
        for (int ai = 0; ai < 2; ++ai)
#pragma unroll
            for (int m = 0; m < 4; ++m) { bf16* rowp = ACT + (size_t)(row0 + ai * 128 + m * 16) * DE + col0;
                float o[8];
#pragma unroll
                for (int n = 0; n < 2; ++n)
#pragma unroll
                    for (int j = 0; j < 4; ++j) { const float gv = acc[ai][0][m][n][j], uv = acc[ai][1][m][n][j]; o[n * 4 + j] = gv / (1.0f + __expf(-gv)) * uv; }
                u32x4 w; w.x = cvt_pk_bf16(o[0], o[1]); w.y = cvt_pk_bf16(o[2], o[3]); w.z = cvt_pk_bf16(o[4], o[5]); w.w = cvt_pk_bf16(o[6], o[7]);
                *(u32x4*)rowp = w; }
    }
};

struct EpiSwiglu8 {
    static constexpr bool PERM = true;
    unsigned char* ACT;
    __device__ __forceinline__ void operator()(const f32x4 (&acc)[2][2][4][2], const Unit& u, int wr, int wc, int fr, int fq) const {
        const int row0 = u.pm * 256 + wr * 64 + fr, col0 = u.pn * 128 + wc * 32 + 8 * fq;
#pragma unroll
        for (int ai = 0; ai < 2; ++ai)
#pragma unroll
            for (int m = 0; m < 4; ++m) { unsigned char* rowp = ACT + (size_t)(row0 + ai * 128 + m * 16) * DEP + col0;
                float o[8];
#pragma unroll
                for (int n = 0; n < 2; ++n)
#pragma unroll
                    for (int j = 0; j < 4; ++j) { const float gv = acc[ai][0][m][n][j], uv = acc[ai][1][m][n][j]; o[n * 4 + j] = gv / (1.0f + __expf(-gv)) * uv; }
                u32x2 w; w.x = pk4_fp8(o[0], o[1], o[2], o[3]); w.y = pk4_fp8(o[4], o[5], o[6], o[7]);
                *(u32x2*)rowp = w;
                if (u.pn == 10) *(u32x2*)(rowp + 128) = (u32x2){0u, 0u}; }
    }
};

struct Frame {
    LAS unsigned char* lds; volatile LAS unsigned* MISC; unsigned* ctl; unsigned char* ws;
    int tid, lane, wave, vcu, G;
};

__device__ __forceinline__ void xpose_item(const float* W, int ldw, bf16* WT, int ldt, int k0, int n0, int drow0, LAS float* scr, int lane) {
    { const int rr = lane >> 3, c4 = (lane & 7) * 4; f32x4 v[8];
#pragma unroll
      for (int i = 0; i < 8; ++i) v[i] = *(const f32x4*)(W + (size_t)(k0 + 8 * i + rr) * ldw + n0 + c4);
#pragma unroll
      for (int i = 0; i < 8; ++i) { LAS float* d = scr + (8 * i + rr) * 33 + c4; d[0] = v[i].x; d[1] = v[i].y; d[2] = v[i].z; d[3] = v[i].w; } }
    LDS_WAIT(); asm volatile("" ::: "memory");
    const int c = lane & 7;
#pragma unroll
    for (int j = 0; j < 4; ++j) { const int n = (lane >> 3) + 8 * j; const LAS float* s = scr + (8 * c) * 33 + n;
        u32x4 o; o.x = pk2(s[0 * 33], s[1 * 33]); o.y = pk2(s[2 * 33], s[3 * 33]); o.z = pk2(s[4 * 33], s[5 * 33]); o.w = pk2(s[6 * 33], s[7 * 33]);
        *(u32x4*)(WT + (size_t)(drow0 + n) * ldt + k0 + 8 * c) = o; }
    LDS_WAIT(); asm volatile("" ::: "memory");
}
__device__ __forceinline__ void xpose_job(const float* W, int K, int N, bf16* WT, int r, LAS float* scr, int lane) {
    const int nblk = N / 32, kb = r / nblk, nb = r % nblk;
    xpose_item(W, N, WT, K, 64 * kb, 32 * nb, 32 * nb, scr, lane);
}
__device__ __forceinline__ void xpose_item8(const float* W, int ldw, unsigned char* WT, int ldt, int k0, int n0, int drow0, float sc, LAS float* scr, int lane) {
    { const int rr = lane >> 3, c4 = (lane & 7) * 4; f32x4 v[8];
#pragma unroll
      for (int i = 0; i < 8; ++i) v[i] = *(const f32x4*)(W + (size_t)(k0 + 8 * i + rr) * ldw + n0 + c4);
#pragma unroll
      for (int i = 0; i < 8; ++i) { LAS float* d = scr + (8 * i + rr) * 33 + c4; d[0] = v[i].x; d[1] = v[i].y; d[2] = v[i].z; d[3] = v[i].w; } }
    LDS_WAIT(); asm volatile("" ::: "memory");
    const int c = lane & 3;
#pragma unroll
    for (int j = 0; j < 2; ++j) { const int n = (lane >> 2) + 16 * j; const LAS float* s = scr + (16 * c) * 33 + n;
        u32x4 o; o.x = pk4_fp8(s[0 * 33] * sc, s[1 * 33] * sc, s[2 * 33] * sc, s[3 * 33] * sc); o.y = pk4_fp8(s[4 * 33] * sc, s[5 * 33] * sc, s[6 * 33] * sc, s[7 * 33] * sc);
        o.z = pk4_fp8(s[8 * 33] * sc, s[9 * 33] * sc, s[10 * 33] * sc, s[11 * 33] * sc); o.w = pk4_fp8(s[12 * 33] * sc, s[13 * 33] * sc, s[14 * 33] * sc, s[15 * 33] * sc);
        *(u32x4*)(WT + (size_t)(drow0 + n) * ldt + k0 + 16 * c) = o; }
    LDS_WAIT(); asm volatile("" ::: "memory");
}
__device__ __forceinline__ void xpose_job8(const float* W, int K, int N, unsigned char* WT, int r, LAS float* scr, int lane) {
    const int nblk = N / 32, kb = r / nblk, nb = r % nblk;
    xpose_item8(W, N, WT, K, 64 * kb, 32 * nb, 32 * nb, 64.0f, scr, lane);
}
constexpr int DQ_N = 51 * 1408;
constexpr int CW_DQ = 32768;
__device__ __forceinline__ void moe_item(Frame& F, const Params& p, int l, int r, LAS float* scr) {
    unsigned char* ws = F.ws; constexpr int I_MOE1 = 1408;
    r += l * DQ_N;
        { const int m = r / I_MOE1, rr = r % I_MOE1, l = m / 51, mm = m % 51, which = mm / 17, e = mm % 17;
          if (which < 2) {
              const float* src = which == 0 ? (e < 16 ? p.in[I_MWG] + (size_t)(l * 16 + e) * DM * DE : p.in[I_MSG] + (size_t)l * DM * DE)
                                            : (e < 16 ? p.in[I_MWU] + (size_t)(l * 16 + e) * DM * DE : p.in[I_MSU] + (size_t)l * DM * DE);
              const int kb = rr / 44, nb = rr % 44, n0 = 32 * nb;
#if MOE_FP8
              xpose_item8(src, DE, ws + WS_W1 + (size_t)(l * 17 + e) * W1_E, DM, 64 * kb, n0, (n0 / 128) * 256 + (n0 % 128) + (which ? 128 : 0), 64.0f, scr, F.lane);
#else
              xpose_item(src, DE, (bf16*)(ws + WS_W1 + (size_t)(l * 17 + e) * W1_E), DM, 64 * kb, n0, (n0 / 128) * 256 + (n0 % 128) + (which ? 128 : 0), scr, F.lane);
#endif
          } else {
              const float* src = e < 16 ? p.in[I_MWD] + (size_t)(l * 16 + e) * DE * DM : p.in[I_MSD] + (size_t)l * DE * DM;
              const int kb = rr / 64, nb = rr % 64;
#if MOE_FP8
              xpose_item8(src, DM, ws + WS_W2 + (size_t)(l * 17 + e) * W2_E, DEP, 64 * kb, 32 * nb, 32 * nb, 64.0f, scr, F.lane);
#else
              xpose_item(src, DM, (bf16*)(ws + WS_W2 + (size_t)(l * 17 + e) * W2_E), DE, 64 * kb, 32 * nb, 32 * nb, scr, F.lane);
#endif
          } }
}
__device__ __forceinline__ void deferred_tail(Frame& F, const Params& p, int l, int quota) {
    LAS float* scr = (LAS float*)(F.lds + F.wave * 8448);
    volatile LAS unsigned* slot = F.MISC + 48;
    __syncthreads();
    if (F.tid == 0) slot[0] = __hip_atomic_fetch_add(F.ctl + CW_DQ + 64 * l, (unsigned)(8 * quota), RLX_AGENT);
    __syncthreads();
    const int base = __builtin_amdgcn_readfirstlane((int)slot[0]);
    const int end = base + 8 * quota < DQ_N ? base + 8 * quota : DQ_N;
    for (int q = base + F.wave; q < end; q += 8) moe_item(F, p, l, q, scr);
}
__device__ __forceinline__ void deferred_drain(Frame& F, const Params& p, int l) {
    LAS float* scr = (LAS float*)(F.lds + F.wave * 8448);
    const int H = __builtin_amdgcn_readfirstlane((int)__hip_atomic_load(F.ctl + CW_DQ + 64 * l, RLX_AGENT));
    const int gw = F.vcu * NWAVES + F.wave, NGW = F.G * NWAVES;
    for (int q = H + gw; q < DQ_N; q += NGW) moe_item(F, p, l, q, scr);
}
__device__ __forceinline__ void p0_prologue(Frame& F, const Params& p) {
    unsigned char* ws = F.ws;
    LAS float* sil = (LAS float*)(F.lds + 69632);
    for (int i = F.tid; i < 5 * DM; i += NTHR) { const int v = i / DM, k = i % DM; const float x = v < 4 ? p.in[I_C][v * DM + k] : p.in[I_CCTX][k]; sil[i] = x / (1.0f + __expf(-x)); }
    { const int gt = blockIdx.x * NTHR + F.tid;
      if (gt < 1024) { const int pos = gt >> 4, i = gt & 15; const float inv = powf(10000.0f, -(float)(2 * i) / 32.0f); const float ang = (float)pos * inv;
          ((f32x2*)(ws + WS_ROPE))[gt] = (f32x2){cosf(ang), sinf(ang)}; } }
    { constexpr int WIN_ES = DFP8_IN ? 1 : 2; u32x4* z = (u32x4*)(ws + WS_WIN + (size_t)ABIN * DM * WIN_ES); const int n16 = (ABINP - ABIN) * DM * WIN_ES / 16;
      for (int i = blockIdx.x * NTHR + F.tid; i < n16; i += F.G * NTHR) z[i] = (u32x4){0u, 0u, 0u, 0u}; }
    __syncthreads();
    if (F.wave < 3) {
        for (int item = blockIdx.x * 3 + F.wave; item < 768; item += F.G * 3) {
            const int l = item / 384, rem = item % 384, cg = rem >> 3, kc = rem & 7;
            const float* wp = p.in[I_ADAW] + ((size_t)l * DM + kc * 256) * 12288 + cg * 256 + F.lane * 4;
            f32x4 a0 = {0.f, 0.f, 0.f, 0.f}, a1 = a0, a2 = a0, a3 = a0, a4 = a0;
#pragma unroll 8
            for (int kk = 0; kk < 256; ++kk) { const f32x4 w = *(const f32x4*)(wp + (size_t)kk * 12288); const int k = kc * 256 + kk;
                a0 += w * sil[k]; a1 += w * sil[DM + k]; a2 += w * sil[2 * DM + k]; a3 += w * sil[3 * DM + k]; a4 += w * sil[4 * DM + k]; }
            float* o = (float*)(ws + WS_MODP) + ((size_t)(kc * 2 + l) * 5) * 12288 + cg * 256 + F.lane * 4;
            *(f32x4*)(o) = a0; *(f32x4*)(o + 12288) = a1; *(f32x4*)(o + 2 * 12288) = a2; *(f32x4*)(o + 3 * 12288) = a3; *(f32x4*)(o + 4 * 12288) = a4;
        }
    }
    LAS float* scr = (LAS float*)(F.lds + F.wave * 8448);
    const int gw = F.vcu * NWAVES + F.wave, NGW = F.G * NWAVES;
    constexpr int I_WIN = (DM / 64) * (ABIN / 32), I_WO = (DM / 64) * (DM / 32), I_UQ = (512 / 64) * (1536 / 32), I_UKV = (512 / 64) * (2048 / 32);
    constexpr int I_G1 = 8, I_GALL = 32 * I_G1, I_QKV = (DM / 64) * (6144 / 32), I_MOE1 = 1408;
    constexpr int NITEMS = I_WIN + I_WO + I_UQ + I_UKV + I_GALL + I_QKV + I_WO;
    for (int it = gw; it < NITEMS; it += NGW) {
        int r = it;
#if DFP8_IN
        if (r < I_WIN) { xpose_job8(p.in[I_ABWIN], DM, ABIN, ws + WS_WIN, r, scr, F.lane); continue; } r -= I_WIN;
#else
        if (r < I_WIN) { xpose_job(p.in[I_ABWIN], DM, ABIN, (bf16*)(ws + WS_WIN), r, scr, F.lane); continue; } r -= I_WIN;
#endif
#if DFP8_OUT0
        if (r < I_WO) { xpose_job8(p.in[I_ABWOUT], DM, DM, ws + WS_WOUT0, r, scr, F.lane); continue; } r -= I_WO;
#else
        if (r < I_WO) { xpose_job(p.in[I_ABWOUT], DM, DM, (bf16*)(ws + WS_WOUT0), r, scr, F.lane); continue; } r -= I_WO;
#endif
        if (r < I_UQ) { xpose_job(p.in[I_WUQ], 512, 1536, (bf16*)(ws + WS_WUQ), r, scr, F.lane); continue; } r -= I_UQ;
        if (r < I_UKV) { xpose_job(p.in[I_WUKV], 512, 2048, (bf16*)(ws + WS_WUKV), r, scr, F.lane); continue; } r -= I_UKV;
        if (r < I_GALL) { const int mi = r / I_G1, rr = r % I_G1;
            const int g = mi >> 3, blk = mi & 7, dir = g >> 1, ty = g & 1;
            const float* src = (ty ? p.in[I_LWI] : p.in[I_LWA]) + (size_t)(dir * 8 + blk) * 128 * 128;
            xpose_job(src, 128, 128, (bf16*)(ws + WS_WG) + (size_t)mi * 128 * 128, rr, scr, F.lane); continue; } r -= I_GALL;
#if DFP8_QKV
        if (r < I_QKV) { xpose_job8(p.in[I_NAWQKV], DM, 6144, ws + WS_WQKV, r, scr, F.lane); continue; } r -= I_QKV;
#else
        if (r < I_QKV) { xpose_job(p.in[I_NAWQKV], DM, 6144, (bf16*)(ws + WS_WQKV), r, scr, F.lane); continue; } r -= I_QKV;
#endif
#if DFP8_OUT1
        if (r < I_WO) { xpose_job8(p.in[I_NAWOUT], DM, DM, ws + WS_WOUT1, r, scr, F.lane); continue; }
#else
        if (r < I_WO) { xpose_job(p.in[I_NAWOUT], DM, DM, (bf16*)(ws + WS_WOUT1), r, scr, F.lane); continue; }
#endif
    }
#if MOE_FP8
    for (int i = blockIdx.x * NTHR + F.tid; i < 2 * 17 * DM * 8; i += F.G * NTHR) { const int row = i >> 3, c = i & 7; *(u32x4*)(ws + WS_W2 + (size_t)row * DEP + DE + 16 * c) = (u32x4){0u, 0u, 0u, 0u}; }
#endif
}

__device__ __forceinline__ void load_row_f32(const float* xrow, int lane, f32x4 (&v)[8]) {
#pragma unroll
    for (int j = 0; j < 8; ++j) v[j] = *(const f32x4*)(xrow + 4 * lane + 256 * j);
}
__device__ __forceinline__ void load_row_bf16(const bf16* xrow, int lane, f32x4 (&v)[8]) {
#pragma unroll
    for (int j = 0; j < 8; ++j) { const u32x2 w = *(const u32x2*)(xrow + 4 * lane + 256 * j); v[j] = (f32x4){bflo(w.x), bfhi(w.x), bflo(w.y), bfhi(w.y)}; }
}
__device__ __forceinline__ float row_rstd(const f32x4 (&v)[8]) {
    float s = 0.f;
#pragma unroll
    for (int j = 0; j < 8; ++j) s += (v[j].x * v[j].x + v[j].y * v[j].y) + (v[j].z * v[j].z + v[j].w * v[j].w);
    return rsqrtf(wave_sum(s) * (1.0f / DM) + EPS);
}
__device__ __forceinline__ void store_row_bf16(bf16* orow, int lane, const f32x4 (&h)[8]) {
#pragma unroll
    for (int j = 0; j < 8; ++j) { u32x2 w; w.x = pk2(h[j].x, h[j].y); w.y = pk2(h[j].z, h[j].w); *(u32x2*)(orow + 4 * lane + 256 * j) = w; }
}
__device__ __forceinline__ void store_row_fp8(unsigned char* orow, int lane, const f32x4 (&h)[8]) {
#pragma unroll
    for (int j = 0; j < 8; ++j) *(unsigned*)(orow + 4 * lane + 256 * j) = pk4_fp8(h[j].x, h[j].y, h[j].z, h[j].w);
}
__device__ __forceinline__ void p1_modulate0(Frame& F, const Params& p) {
    unsigned char* ws = F.ws;
    const float* modp = (const float*)(ws + WS_MODP);
    { float* mod = (float*)(ws + WS_MOD);
      for (int i = blockIdx.x * NTHR + F.tid; i < 2 * 5 * 12288; i += F.G * NTHR) { const int l = i / (5 * 12288), n = i % 12288; float s = p.in[I_ADAB][l * 12288 + n];
#pragma unroll
          for (int kc = 0; kc < 8; ++kc) s += modp[(size_t)kc * (2 * 5 * 12288) + i];
          mod[i] = s; } }
    LAS float* gs = (LAS float*)F.lds; LAS float* sh = gs + DM;
    for (int g = blockIdx.x; g < NTOK / 64; g += F.G) {
        const int row0 = 64 * g, v = vec_of_row(row0);
        for (int n = F.tid; n < DM; n += NTHR) { float sc = p.in[I_ADAB][DM + n], sf = p.in[I_ADAB][n];
#pragma unroll
            for (int kc = 0; kc < 8; ++kc) { const float* mp = modp + ((size_t)(kc * 2 + 0) * 5 + v) * 12288; sf += mp[n]; sc += mp[DM + n]; }
            gs[n] = p.in[I_NMIXG][n] * (1.0f + sc); sh[n] = sf; }
        __syncthreads();
        for (int i = 0; i < 8; ++i) { const int row = row0 + F.wave + 8 * i;
            const float* xr = row < NCTX ? p.in[I_CTX] + (size_t)row * DM : p.in[I_X] + (size_t)(row - NCTX) * DM;
            f32x4 x[8]; load_row_f32(xr, F.lane, x); const float rstd = row_rstd(x);
#pragma unroll
            for (int j = 0; j < 8; ++j) { const f32x4 gg = *(const LAS f32x4*)(gs + 4 * F.lane + 256 * j), ss = *(const LAS f32x4*)(sh + 4 * F.lane + 256 * j); x[j] = x[j] * rstd * gg + ss; }
#if DFP8_IN
            store_row_fp8(ws + WS_H + (size_t)row * DM, F.lane, x); }
#else
            store_row_bf16((bf16*)(ws + WS_H) + (size_t)row * DM, F.lane, x); }
#endif
        __syncthreads();
    }
}

__device__ __forceinline__ void p3_rank_norms(Frame& F, const Params& p) {
    const bf16* U = (const bf16*)(F.ws + WS_U); bf16* CQN = (bf16*)(F.ws + WS_CQN); bf16* CKVN = (bf16*)(F.ws + WS_CKVN);
    const int gw = blockIdx.x * NWAVES + F.wave, NGW = F.G * NWAVES;
    for (int row = gw; row < NTOK; row += NGW) {
#pragma unroll
        for (int w = 0; w < 2; ++w) {
            const u32x4 v = *(const u32x4*)(U + (size_t)row * ABIN + 2048 + 512 * w + 8 * F.lane);
            float x[8] = {bflo(v.x), bfhi(v.x), bflo(v.y), bfhi(v.y), bflo(v.z), bfhi(v.z), bflo(v.w), bfhi(v.w)};
            float s = 0.f;
#pragma unroll
            for (int j = 0; j < 8; ++j) s += x[j] * x[j];
            const float rstd = rsqrtf(wave_sum(s) * (1.0f / 512.0f) + EPS);
            const float* g = (w ? p.in[I_KVNG] : p.in[I_QNG]) + 8 * F.lane;
            const f32x4 g0 = *(const f32x4*)g, g1 = *(const f32x4*)(g + 4);
            u32x4 o; o.x = pk2(x[0] * rstd * g0.x, x[1] * rstd * g0.y); o.y = pk2(x[2] * rstd * g0.z, x[3] * rstd * g0.w);
            o.z = pk2(x[4] * rstd * g1.x, x[5] * rstd * g1.y); o.w = pk2(x[6] * rstd * g1.z, x[7] * rstd * g1.w);
            *(u32x4*)((w ? CKVN : CQN) + (size_t)row * 512 + 8 * F.lane) = o;
        }
    }
}
struct ScanSt { float A, H; };
__device__ __forceinline__ ScanSt scan_comb(ScanSt s1, ScanSt s2) { return ScanSt{s1.A * s2.A, s1.H * s2.A + s2.H}; }
__device__ __forceinline__ void p3_conv_gates(Frame& F, const Params& p) {
    const bf16* U = (const bf16*)(F.ws + WS_U);
    unsigned* HA = (unsigned*)(F.ws + WS_AB);
    f32x2* AGG = (f32x2*)(F.ws + WS_AGG);
    const bf16* WG = (const bf16*)(F.ws + WS_WG);
    LAS float* xcf = (LAS float*)F.lds;
    LAS unsigned char* xab = F.lds + 64 * 129 * 4;
    LAS unsigned* ot = (LAS unsigned*)(F.lds + 51200);
    const int tid = F.tid, lane = F.lane, w = F.wave, g4 = lane >> 4;
    for (int item = blockIdx.x; item < (NTOK / 64) * 8; item += F.G) {
        const int tt = item >> 3, n = item & 7;
        int row0, pos0, slen, bb_, pc;
        if (tt < 16) { bb_ = tt >> 2; pc = tt & 3; pos0 = 64 * pc; slen = CTXL; row0 = bb_ * CTXL + pos0; }
        else { const int tl = tt - 16; bb_ = tl >> 6; pc = 4 + (tl & 63); pos0 = 64 * (tl & 63); slen = SEQ; row0 = NCTX + bb_ * SEQ + pos0; }
        { const int i = tid >> 3, cg = tid & 7, ch0 = 128 * n + 16 * cg;
          float accv[16];
#pragma unroll
          for (int c = 0; c < 16; ++c) accv[c] = p.in[I_CONVB][ch0 + c];
#pragma unroll
          for (int j = 0; j < 4; ++j) { const int pos = pos0 + i + j - 2;
              if (pos >= 0 && pos < slen) {
                  const bf16* up = U + (size_t)(row0 + i + j - 2) * ABIN + ch0;
                  const u32x4 v0 = *(const u32x4*)up, v1 = *(const u32x4*)(up + 8);
                  const float x[16] = {bflo(v0.x), bfhi(v0.x), bflo(v0.y), bfhi(v0.y), bflo(v0.z), bfhi(v0.z), bflo(v0.w), bfhi(v0.w),
                                       bflo(v1.x), bfhi(v1.x), bflo(v1.y), bfhi(v1.y), bflo(v1.z), bfhi(v1.z), bflo(v1.w), bfhi(v1.w)};
                  const float* cw = p.in[I_CONVW] + j * DRNN + ch0;
#pragma unroll
                  for (int c = 0; c < 16; ++c) accv[c] += cw[c] * x[c]; } }
#pragma unroll
          for (int c = 0; c < 16; ++c) xcf[i * 129 + 16 * cg + c] = accv[c];
          u32x4 o0, o1; o0.x = pk2(accv[0], accv[1]); o0.y = pk2(accv[2], accv[3]); o0.z = pk2(accv[4], accv[5]); o0.w = pk2(accv[6], accv[7]);
          o1.x = pk2(accv[8], accv[9]); o1.y = pk2(accv[10], accv[11]); o1.z = pk2(accv[12], accv[13]); o1.w = pk2(accv[14], accv[15]);
          *(LAS u32x4*)(xab + i * 272 + 32 * cg) = o0; *(LAS u32x4*)(xab + i * 272 + 32 * cg + 16) = o1; }
        __syncthreads();
        bf16x8 af[4][4];
#pragma unroll
        for (int m = 0; m < 4; ++m)
#pragma unroll
            for (int ks = 0; ks < 4; ++ks) af[m][ks] = *(const LAS bf16x8*)(xab + (16 * m + (lane & 15)) * 272 + (32 * ks + 8 * g4) * 2);
        const int chl = 16 * w + (lane & 15), gch = 128 * n + chl;
#pragma unroll
        for (int d = 0; d < 2; ++d) {
            f32x4 ca[4], ci[4];
#pragma unroll
            for (int m = 0; m < 4; ++m) { ca[m] = (f32x4){0.f, 0.f, 0.f, 0.f}; ci[m] = ca[m]; }
#pragma unroll
            for (int ks = 0; ks < 4; ++ks) {
                const bf16x8 ba = *(const bf16x8*)(WG + ((size_t)((2 * d + 0) * 8 + n) * 128 + chl) * 128 + 32 * ks + 8 * g4);
                const bf16x8 bi = *(const bf16x8*)(WG + ((size_t)((2 * d + 1) * 8 + n) * 128 + chl) * 128 + 32 * ks + 8 * g4);
#pragma unroll
                for (int m = 0; m < 4; ++m) { ca[m] = __builtin_amdgcn_mfma_f32_16x16x32_bf16(af[m][ks], ba, ca[m], 0, 0, 0); ci[m] = __builtin_amdgcn_mfma_f32_16x16x32_bf16(af[m][ks], bi, ci[m], 0, 0, 0); }
            }
            const float ba_ = p.in[I_LBA][d * DRNN + gch], bi_ = p.in[I_LBI][d * DRNN + gch], lam = p.in[I_LAM][d * DRNN + gch];
            const float sp = log1pf(expf(-lam));
            ScanSt el[4][4];
#pragma unroll
            for (int m = 0; m < 4; ++m)
#pragma unroll
                for (int r = 0; r < 4; ++r) { const int i = 16 * m + 4 * g4 + r;
                    const float rg = __builtin_amdgcn_rcpf(1.0f + __expf(-(ca[m][r] + ba_))), ig = __builtin_amdgcn_rcpf(1.0f + __expf(-(ci[m][r] + bi_)));
                    const float la = -8.0f * rg * sp, x2 = 2.0f * la;
                    const float em = -x2 * (1.0f + x2 * (0.5f + x2 * (0.16666667f + x2 * (0.041666668f + x2 * 0.0083333333f))));
                    el[m][r].A = __expf(la); el[m][r].H = __builtin_amdgcn_sqrtf(em) * ig * xcf[i * 129 + chl]; }
#pragma unroll
            for (int m = 0; m < 4; ++m) {
                if (d == 0) { el[m][1] = scan_comb(el[m][0], el[m][1]); el[m][2] = scan_comb(el[m][1], el[m][2]); el[m][3] = scan_comb(el[m][2], el[m][3]); }
                else        { el[m][2] = scan_comb(el[m][3], el[m][2]); el[m][1] = scan_comb(el[m][2], el[m][1]); el[m][0] = scan_comb(el[m][1], el[m][0]); }
            }
            ScanSt pre = ScanSt{1.0f, 0.0f};
#pragma unroll
            for (int mm = 0; mm < 4; ++mm) { const int m = d == 0 ? mm : 3 - mm;
                const ScanSt T = d == 0 ? el[m][3] : el[m][0];
                ScanSt Tg[4];
#pragma unroll
                for (int q = 0; q < 4; ++q) { Tg[q].A = __shfl(T.A, (lane & 15) + 16 * q); Tg[q].H = __shfl(T.H, (lane & 15) + 16 * q); }
                ScanSt ex = pre, tot = pre;
#pragma unroll
                for (int qq = 0; qq < 4; ++qq) { const int q = d == 0 ? qq : 3 - qq;
                    const bool before = d == 0 ? (q < g4) : (q > g4);
                    const ScanSt nx = scan_comb(tot, Tg[q]); tot = nx; if (before) ex = nx; }
#pragma unroll
                for (int r = 0; r < 4; ++r) { const ScanSt f = scan_comb(ex, el[m][r]); const int i = 16 * m + 4 * g4 + r;
                    ot[(d * 64 + i) * 132 + chl] = pk2(f.H, f.A); }
                pre = tot; }
            if (g4 == 0) { const int c = d == 0 ? pc : (pc < 4 ? 3 - pc : 71 - pc); AGG[((size_t)(d * NB + bb_) * NCHUNK + c) * DRNN + gch] = (f32x2){pre.A, pre.H}; }
        }
        __syncthreads();
#pragma unroll
        for (int k = 0; k < 8; ++k) { const int q = tid + NTHR * k, d = q >> 11, rr = (q >> 5) & 63, c4 = (q & 31) * 4;
            const u32x4 v = *(const LAS u32x4*)(ot + (d * 64 + rr) * 132 + c4);
            *(u32x4*)(HA + ((size_t)d * NTOK + row0 + rr) * DRNN + 128 * n + c4) = v; }
        __syncthreads();
    }
}
__device__ __forceinline__ void scan_pass_c(Frame& F) {
    const f32x2* AGG = (const f32x2*)(F.ws + WS_AGG); float* CAR = (float*)(F.ws + WS_CARRY);
    for (int t = blockIdx.x * NTHR + F.tid; t < 2 * NB * DRNN; t += F.G * NTHR) {
        const int ch = t % DRNN, db = t / DRNN;
        float carry = 0.0f;
        for (int c = 0; c < NCHUNK; ++c) { const size_t idx = ((size_t)db * NCHUNK + c) * DRNN + ch; CAR[idx] = carry; const f32x2 ag = AGG[idx]; carry = ag.x * carry + ag.y; }
    }
}
__device__ __forceinline__ void scan_pass_d(Frame& F) {
    const unsigned* HA = (const unsigned*)(F.ws + WS_AB); const float* CAR = (const float*)(F.ws + WS_CARRY);
    const bf16* U = (const bf16*)(F.ws + WS_U); bf16* YC = (bf16*)(F.ws + WS_YC);
    for (int row = blockIdx.x * NWAVES + F.wave; row < NTOK; row += F.G * NWAVES) {
        int b, pc;
        if (row < NCTX) { b = row >> 8; pc = (row & 255) >> 6; } else { const int rl = row - NCTX; b = rl >> 12; pc = 4 + ((rl & 4095) >> 6); }
        const int cb = pc < 4 ? 3 - pc : 71 - pc;
        const float* cf = CAR + ((size_t)(0 * NB + b) * NCHUNK + pc) * DRNN; const float* cbk = CAR + ((size_t)(1 * NB + b) * NCHUNK + cb) * DRNN;
#pragma unroll
        for (int j = 0; j < 4; ++j) { const int c = 4 * F.lane + 256 * j;
            const u32x4 f = *(const u32x4*)(HA + (size_t)row * DRNN + c), bk = *(const u32x4*)(HA + ((size_t)NTOK + row) * DRNN + c);
            const f32x4 c0 = *(const f32x4*)(cf + c), c1 = *(const f32x4*)(cbk + c);
            const u32x2 gt = *(const u32x2*)(U + (size_t)row * ABIN + DRNN + c);
            const float o0 = (bflo(f.x) + bfhi(f.x) * c0.x + bflo(bk.x) + bfhi(bk.x) * c1.x) * bflo(gt.x);
            const float o1 = (bflo(f.y) + bfhi(f.y) * c0.y + bflo(bk.y) + bfhi(bk.y) * c1.y) * bfhi(gt.x);
            const float o2 = (bflo(f.z) + bfhi(f.z) * c0.z + bflo(bk.z) + bfhi(bk.z) * c1.z) * bflo(gt.y);
            const float o3 = (bflo(f.w) + bfhi(f.w) * c0.w + bflo(bk.w) + bfhi(bk.w) * c1.w) * bfhi(gt.y);
#if DFP8_OUT0
            *(unsigned*)((unsigned char*)YC + (size_t)row * DM + c) = pk4_fp8(4.0f * o0, 4.0f * o1, 4.0f * o2, 4.0f * o3); }
#else
            u32x2 o; o.x = pk2(o0, o1); o.y = pk2(o2, o3);
            *(u32x2*)(YC + (size_t)row * DM + c) = o; }
#endif
    }
}

__device__ __forceinline__ void p5_mla_finalize(Frame& F, const Params& p) {
    const bf16* QRAW = (const bf16*)(F.ws + WS_QRAW); const bf16* KVRAW = (const bf16*)(F.ws + WS_KVRAW); const bf16* U = (const bf16*)(F.ws + WS_U);
    bf16* QF = (bf16*)(F.ws + WS_QF); bf16* KF = (bf16*)(F.ws + WS_KF);
    const f32x2* rope = (const f32x2*)(F.ws + WS_ROPE);
    const int lane = F.lane;
    const float gq0 = p.in[I_QHG][lane], gq1 = p.in[I_QHG][64 + lane], gq2 = p.in[I_QHG][128 + lane];
    const float gk0 = p.in[I_KHG][lane], gk1 = p.in[I_KHG][64 + lane], gk2 = p.in[I_KHG][128 + lane];
    const float qs = 0.07216878364870322f * LOG2E;
    const int gw = blockIdx.x * NWAVES + F.wave, NGW = F.G * NWAVES;
    for (int row = gw; row < NTOK; row += NGW) {
        const bool lat = row >= NCTX;
        float cs = 1.0f, sn = 0.0f;
        if (lat) { const int t = (row - NCTX) % SEQ; const int pos = (lane < 32) ? (t / GW) : (t % GW); const f32x2 r = rope[pos * 16 + (lane & 15)]; cs = r.x; sn = r.y; }
        const float kr = bf2f(U[(size_t)row * ABIN + 3072 + lane]);
        const float kr2 = kr * kr;
#pragma unroll
        for (int h = 0; h < MH; ++h) {
            { const bf16* q = QRAW + (size_t)row * 1536 + h * MQK;
              const float v0 = bf2f(q[lane]), v1 = bf2f(q[64 + lane]), v2 = bf2f(q[128 + lane]);
              const float rstd = rsqrtf(wave_sum(v0 * v0 + v1 * v1 + v2 * v2) * (1.0f / MQK) + EPS);
              const float o0 = v0 * rstd * gq0, o1 = v1 * rstd * gq1; float o2 = v2 * rstd * gq2;
              const float pr = __shfl_xor(o2, 16);
              if (lat) o2 = (lane & 16) ? (pr * sn + o2 * cs) : (o2 * cs - pr * sn);
              bf16* qo = QF + ((size_t)row * MH + h) * MQK;
              qo[lane] = (bf16)f2bf(o0 * qs); qo[64 + lane] = (bf16)f2bf(o1 * qs); qo[128 + lane] = (bf16)f2bf(o2 * qs); }
            { const bf16* k = KVRAW + (size_t)row * 2048 + h * 256;
              const float v0 = bf2f(k[lane]), v1 = bf2f(k[64 + lane]);
              const float rstd = rsqrtf(wave_sum(v0 * v0 + v1 * v1 + kr2) * (1.0f / MQK) + EPS);
              const float o0 = v0 * rstd * gk0, o1 = v1 * rstd * gk1; float o2 = kr * rstd * gk2;
              const float pr = __shfl_xor(o2, 16);
              if (lat) o2 = (lane & 16) ? (pr * sn + o2 * cs) : (o2 * cs - pr * sn);
              bf16* ko = KF + ((size_t)row * MH + h) * MQK;
              ko[lane] = (bf16)f2bf(o0); ko[64 + lane] = (bf16)f2bf(o1); ko[128 + lane] = (bf16)f2bf(o2); }
        }
    }
}

__device__ __forceinline__ int crow(int r, int hi) { return (r & 3) + 8 * (r >> 2) + 4 * hi; }
__device__ __forceinline__ int v_st(int k, int c) { const int kk = (k & ~0xC) | ((k & 4) << 1) | ((k & 8) >> 1); return ((kk >> 3) * 4 + (c >> 5)) * 512 + ((kk & 7) * 32 + (c & 31)) * 2; }
__device__ __forceinline__ int v_rd_base(int lane) { return ((lane & 3) << 3) | (((lane >> 2) & 3) << 6) | (((lane >> 4) & 1) << 5) | (((lane >> 5) & 1) << 8); }
constexpr int v_rd_off(int d0, int ks, int half) { return d0 * 512 + ks * 4096 + half * 2048; }
template <int OFF> __device__ __forceinline__ s16x4 tr_read(int vb) {
    s16x4 r; asm volatile("ds_read_b64_tr_b16 %0, %1 offset:%2" : "=&v"(r) : "v"(vb), "i"(OFF) : "memory"); return r;
}
template <int D0> __device__ __forceinline__ void pv_load(s16x4 (&v)[8], int vb) {
    v[0] = tr_read<v_rd_off(D0, 0, 0)>(vb); v[1] = tr_read<v_rd_off(D0, 0, 1)>(vb); v[2] = tr_read<v_rd_off(D0, 1, 0)>(vb); v[3] = tr_read<v_rd_off(D0, 1, 1)>(vb);
    v[4] = tr_read<v_rd_off(D0, 2, 0)>(vb); v[5] = tr_read<v_rd_off(D0, 2, 1)>(vb); v[6] = tr_read<v_rd_off(D0, 3, 0)>(vb); v[7] = tr_read<v_rd_off(D0, 3, 1)>(vb);
}
__device__ __forceinline__ void pv_mma(f32x16& od, const s16x4 (&v)[8], bf16x8 pa0, bf16x8 pa1, bf16x8 pa2, bf16x8 pa3) {
#define PKV(L, H) (bf16x8){L[0], L[1], L[2], L[3], H[0], H[1], H[2], H[3]}
    od = __builtin_amdgcn_mfma_f32_32x32x16_bf16(pa0, PKV(v[0], v[1]), od, 0, 0, 0);
    od = __builtin_amdgcn_mfma_f32_32x32x16_bf16(pa1, PKV(v[2], v[3]), od, 0, 0, 0);
    od = __builtin_amdgcn_mfma_f32_32x32x16_bf16(pa2, PKV(v[4], v[5]), od, 0, 0, 0);
    od = __builtin_amdgcn_mfma_f32_32x32x16_bf16(pa3, PKV(v[6], v[7]), od, 0, 0, 0);
#undef PKV
}
__device__ __forceinline__ void pv_d0(f32x16* o, int vb, bf16x8 pa0, bf16x8 pa1, bf16x8 pa2, bf16x8 pa3) {
    s16x4 va[8], vbb[8];
    pv_load<0>(va, vb);
    pv_load<1>(vbb, vb); asm volatile("s_waitcnt lgkmcnt(8)" ::: "memory"); __builtin_amdgcn_sched_barrier(0);
    pv_mma(o[0], va, pa0, pa1, pa2, pa3); __builtin_amdgcn_sched_barrier(0);
    pv_load<2>(va, vb); asm volatile("s_waitcnt lgkmcnt(8)" ::: "memory"); __builtin_amdgcn_sched_barrier(0);
    pv_mma(o[1], vbb, pa0, pa1, pa2, pa3); __builtin_amdgcn_sched_barrier(0);
    pv_load<3>(vbb, vb); asm volatile("s_waitcnt lgkmcnt(8)" ::: "memory"); __builtin_amdgcn_sched_barrier(0);
    pv_mma(o[2], va, pa0, pa1, pa2, pa3); __builtin_amdgcn_sched_barrier(0);
    asm volatile("s_waitcnt lgkmcnt(0)" ::: "memory"); __builtin_amdgcn_sched_barrier(0);
    pv_mma(o[3], vbb, pa0, pa1, pa2, pa3);
}
__device__ __forceinline__ void pack_p(const f32x16& p0, const f32x16& p1, bf16x8& pa0, bf16x8& pa1, bf16x8& pa2, bf16x8& pa3) {
#define PK4(P, BASE, OUT) do { unsigned a0 = cvt_pk_bf16(P[BASE + 0], P[BASE + 1]), a1 = cvt_pk_bf16(P[BASE + 2], P[BASE + 3]);   \
    unsigned b0 = cvt_pk_bf16(P[BASE + 4], P[BASE + 5]), b1 = cvt_pk_bf16(P[BASE + 6], P[BASE + 7]);                              \
    auto r0 = __builtin_amdgcn_permlane32_swap(a0, b0, false, false); auto r1 = __builtin_amdgcn_permlane32_swap(a1, b1, false, false); \
    u32x4 w = {r0[0], r1[0], r0[1], r1[1]}; OUT = __builtin_bit_cast(bf16x8, w); } while (0)
    PK4(p0, 0, pa0); PK4(p0, 8, pa1); PK4(p1, 0, pa2); PK4(p1, 8, pa3);
#undef PK4
}
template <int DQK> struct AttnG {
    static constexpr int CPR = DQK / 8, KSTR = DQK * 2 + 16, KBYTES = 64 * KSTR, NKCH = (64 * CPR) / 512, ND0 = DQK / 16;
    static constexpr int VOFF = 2 * KBYTES, LIOFF = VOFF + 2 * 16384, END = LIOFF + 8 * 128;
};
template <int DQK> __device__ __forceinline__ void attn_tile_load(bf16x8 (&kreg)[AttnG<DQK>::NKCH], bf16x8 (&vreg)[2], const bf16* kt, int ldk, const bf16* vt, int ldv, int tid) {
    using G = AttnG<DQK>;
#pragma unroll
    for (int i = 0; i < G::NKCH; ++i) { const int q = tid + 512 * i, row = q / G::CPR, ch = q % G::CPR; kreg[i] = *(const bf16x8*)(kt + (size_t)row * ldk + ch * 8); }
    const int sr = tid >> 4, sc = (tid & 15) * 8;
    vreg[0] = *(const bf16x8*)(vt + (size_t)sr * ldv + sc); vreg[1] = *(const bf16x8*)(vt + (size_t)(32 + sr) * ldv + sc);
}
template <int DQK> __device__ __forceinline__ void attn_tile_write(const bf16x8 (&kreg)[AttnG<DQK>::NKCH], const bf16x8 (&vreg)[2], LAS unsigned char* kb, LAS unsigned char* vbuf, int tid) {
    using G = AttnG<DQK>;
#pragma unroll
    for (int i = 0; i < G::NKCH; ++i) { const int q = tid + 512 * i, row = q / G::CPR, ch = q % G::CPR; *(LAS bf16x8*)(kb + row * G::KSTR + ch * 16) = kreg[i]; }
    const int sr = tid >> 4, sc = (tid & 15) * 8;
    *(LAS bf16x8*)(vbuf + v_st(sr, sc)) = vreg[0]; *(LAS bf16x8*)(vbuf + v_st(32 + sr, sc)) = vreg[1];
}
template <int DQK> __device__ __forceinline__ void attn_qkt(f32x16& p0, f32x16& p1, const LAS unsigned char* kb, const bf16x8 (&qr)[AttnG<DQK>::ND0], int r32, int hi) {
    using G = AttnG<DQK>;
    constexpr int NGRP = G::ND0 / 2;
#pragma unroll
    for (int r = 0; r < 16; ++r) { p0[r] = 0.f; p1[r] = 0.f; }
    const LAS unsigned char* k0 = kb + r32 * G::KSTR + hi * 16; const LAS unsigned char* k1 = k0 + 32 * G::KSTR;
    bf16x8 fa[4], fb[4];
#define QK_LOAD(f, g) do { f[0] = *(const LAS bf16x8*)(k0 + (2 * (g)) * 32); f[1] = *(const LAS bf16x8*)(k1 + (2 * (g)) * 32); \
        f[2] = *(const LAS bf16x8*)(k0 + (2 * (g) + 1) * 32); f[3] = *(const LAS bf16x8*)(k1 + (2 * (g) + 1) * 32); } while (0)
#define QK_MMA(f, g) do { p0 = __builtin_amdgcn_mfma_f32_32x32x16_bf16(f[0], qr[2 * (g)], p0, 0, 0, 0); p1 = __builtin_amdgcn_mfma_f32_32x32x16_bf16(f[1], qr[2 * (g)], p1, 0, 0, 0); \
        p0 = __builtin_amdgcn_mfma_f32_32x32x16_bf16(f[2], qr[2 * (g) + 1], p0, 0, 0, 0); p1 = __builtin_amdgcn_mfma_f32_32x32x16_bf16(f[3], qr[2 * (g) + 1], p1, 0, 0, 0); } while (0)
    QK_LOAD(fa, 0);
#pragma unroll
    for (int g = 0; g < NGRP; g += 2) {
        if (g + 1 < NGRP) { QK_LOAD(fb, g + 1); asm volatile("s_waitcnt lgkmcnt(4)" ::: "memory"); } else asm volatile("s_waitcnt lgkmcnt(0)" ::: "memory");
        __builtin_amdgcn_sched_barrier(0); QK_MMA(fa, g); __builtin_amdgcn_sched_barrier(0);
        if (g + 1 < NGRP) {
            if (g + 2 < NGRP) { QK_LOAD(fa, g + 2); asm volatile("s_waitcnt lgkmcnt(4)" ::: "memory"); } else asm volatile("s_waitcnt lgkmcnt(0)" ::: "memory");
            __builtin_amdgcn_sched_barrier(0); QK_MMA(fb, g + 1); __builtin_amdgcn_sched_barrier(0);
        }
    }
#undef QK_LOAD
#undef QK_MMA
}
template <bool F8, int SC> __device__ __forceinline__ void attn_store(const f32x16 (&o)[4], float lsum, LAS float* li, void* orow0v, int ldo, int r32, int hi) {
    lsum += __shfl_xor(lsum, 32);
    if (hi == 0) li[r32] = lsum;
    LDS_WAIT();
    float rli[16];
#pragma unroll
    for (int r = 0; r < 16; ++r) rli[r] = (float)SC / li[crow(r, hi)];
    if constexpr (F8) { unsigned char* orow0 = (unsigned char*)orow0v;
#pragma unroll
        for (int r = 0; r < 16; ++r) { unsigned char* op = orow0 + (size_t)crow(r, hi) * ldo + r32;
#pragma unroll
            for (int d0 = 0; d0 < 4; ++d0) op[d0 * 32] = (unsigned char)(pk4_fp8(o[d0][r] * rli[r], 0.f, 0.f, 0.f) & 0xffu); }
    } else { bf16* orow0 = (bf16*)orow0v;
#pragma unroll
        for (int r = 0; r < 16; ++r) { bf16* op = orow0 + (size_t)crow(r, hi) * ldo + r32;
#pragma unroll
            for (int d0 = 0; d0 < 4; ++d0) op[d0 * 32] = (bf16)f2bf(o[d0][r] * rli[r]); } }
    LDS_WAIT();
}

__device__ __forceinline__ void mla_unit(Frame& F, int b, int h, int qrow0, int ntile) {
    using G = AttnG<MQK>;
    const bf16* QF = (const bf16*)(F.ws + WS_QF); const bf16* KF = (const bf16*)(F.ws + WS_KF); const bf16* KVRAW = (const bf16*)(F.ws + WS_KVRAW);
    bf16* YC = (bf16*)(F.ws + WS_YC);
    const int tid = F.tid, lane = F.lane, r32 = lane & 31, hi = lane >> 5, wid = F.wave;
    LAS unsigned char* lds = F.lds;
    LAS float* li = (LAS float*)(lds + G::LIOFF + wid * 128);
    bf16x8 qr[G::ND0];
    { const bf16* qp = QF + ((size_t)(qrow0 + wid * 32 + r32) * MH + h) * MQK + hi * 8;
#pragma unroll
      for (int d0 = 0; d0 < G::ND0; ++d0) qr[d0] = *(const bf16x8*)(qp + d0 * 16); }
    f32x16 o[4];
#pragma unroll
    for (int d = 0; d < 4; ++d)
#pragma unroll
        for (int r = 0; r < 16; ++r) o[d][r] = 0.f;
    float lsum = 0.f;
    const int vb0 = (int)(unsigned)(uintptr_t)(lds + G::VOFF) + v_rd_base(lane);
    bf16x8 kreg[G::NKCH], vreg[2];
#define MLA_TROW(j) ((j) < 4 ? b * CTXL + 64 * (j) : NCTX + b * SEQ + 64 * ((j) - 4))
    { const int tr = MLA_TROW(0); attn_tile_load<MQK>(kreg, vreg, KF + ((size_t)tr * MH + h) * MQK, MH * MQK, KVRAW + (size_t)tr * 2048 + h * 256 + 128, 2048, tid); }
    attn_tile_write<MQK>(kreg, vreg, lds, lds + G::VOFF, tid);
    __syncthreads();
    for (int j = 0; j < ntile; ++j) {
        const int cur = j & 1;
        if (j + 1 < ntile) { const int tr = MLA_TROW(j + 1); attn_tile_load<MQK>(kreg, vreg, KF + ((size_t)tr * MH + h) * MQK, MH * MQK, KVRAW + (size_t)tr * 2048 + h * 256 + 128, 2048, tid); }
        f32x16 p0, p1;
        attn_qkt<MQK>(p0, p1, lds + cur * G::KBYTES, qr, r32, hi);
#pragma unroll
        for (int r = 0; r < 16; ++r) { p0[r] = __builtin_amdgcn_exp2f(p0[r]); p1[r] = __builtin_amdgcn_exp2f(p1[r]); }
        float ps = 0.f;
#pragma unroll
        for (int r = 0; r < 16; ++r) ps += p0[r] + p1[r];
        lsum += ps;
        bf16x8 pa0, pa1, pa2, pa3; pack_p(p0, p1, pa0, pa1, pa2, pa3);
        pv_d0(o, vb0 + cur * 16384, pa0, pa1, pa2, pa3);
        if (j + 1 < ntile) attn_tile_write<MQK>(kreg, vreg, lds + (cur ^ 1) * G::KBYTES, lds + G::VOFF + (cur ^ 1) * 16384, tid);
        __syncthreads();
    }
#undef MLA_TROW
#if DFP8_OUT0
    attn_store<true, 4>(o, lsum, li, (unsigned char*)YC + (size_t)(qrow0 + wid * 32) * DM + DRNN + h * MV, DM, r32, hi);
#else
    attn_store<false, 1>(o, lsum, li, YC + (size_t)(qrow0 + wid * 32) * DM + DRNN + h * MV, DM, r32, hi);
#endif
    __syncthreads();
}
__device__ __forceinline__ void p6_mla_attention(Frame& F) {
    for (int U = F.vcu; U < 544; U += F.G) {
        int b, h, qrow0, ntile;
        if (U < 512) { const int bh = U >> 4, qb = U & 15; b = bh >> 3; h = bh & 7; qrow0 = NCTX + b * SEQ + qb * 256; ntile = 68; }
        else { const int bh = U - 512; b = bh >> 3; h = bh & 7; qrow0 = b * CTXL; ntile = 4; }
        mla_unit(F, b, h, qrow0, ntile);
    }
}

__device__ __forceinline__ void p15_na_finalize(Frame& F, const Params& p) {
    bf16* QKV = (bf16*)(F.ws + WS_QKV);
    const int lane = F.lane, d0 = (lane & 15) * 8;
    f32x4 gq[2], gk[2];
    gq[0] = *(const f32x4*)(p.in[I_NAQHG] + d0); gq[1] = *(const f32x4*)(p.in[I_NAQHG] + d0 + 4);
    gk[0] = *(const f32x4*)(p.in[I_NAKHG] + d0); gk[1] = *(const f32x4*)(p.in[I_NAKHG] + d0 + 4);
    const float qs = 0.08838834764831845f * LOG2E;
    const int gw = blockIdx.x * NWAVES + F.wave, NGW = F.G * NWAVES;
    for (int row = gw; row < NTOK; row += NGW) {
        bf16* rp = QKV + (size_t)row * 6144 + 8 * lane;
        const bool doq = row >= NCTX;
        u32x4 qv[4], kv[4];
#pragma unroll
        for (int j = 0; j < 4; ++j) { kv[j] = *(const u32x4*)(rp + DM + 512 * j); if (doq) qv[j] = *(const u32x4*)(rp + 512 * j); else qv[j] = (u32x4){0u, 0u, 0u, 0u}; }
#pragma unroll
        for (int t = 0; t < 2; ++t) {
            if (t == 0 && !doq) continue;
#pragma unroll
            for (int j = 0; j < 4; ++j) { const u32x4 w = t == 0 ? qv[j] : kv[j];
                float x[8] = {bflo(w.x), bfhi(w.x), bflo(w.y), bfhi(w.y), bflo(w.z), bfhi(w.z), bflo(w.w), bfhi(w.w)};
                float ss = 0.f;
#pragma unroll
                for (int c = 0; c < 8; ++c) ss += x[c] * x[c];
                ss += __shfl_xor(ss, 1); ss += __shfl_xor(ss, 2); ss += __shfl_xor(ss, 4); ss += __shfl_xor(ss, 8);
                const float rstd = rsqrtf(ss * (1.0f / NAD) + EPS) * (t == 0 ? qs : 1.0f);
                const f32x4 g0 = t == 0 ? gq[0] : gk[0], g1 = t == 0 ? gq[1] : gk[1];
                u32x4 o; o.x = pk2(x[0] * rstd * g0.x, x[1] * rstd * g0.y); o.y = pk2(x[2] * rstd * g0.z, x[3] * rstd * g0.w);
                o.z = pk2(x[4] * rstd * g1.x, x[5] * rstd * g1.y); o.w = pk2(x[6] * rstd * g1.z, x[7] * rstd * g1.w);
                *(u32x4*)(rp + (t == 0 ? 0 : DM) + 512 * j) = o; }
        }
    }
}
__device__ __forceinline__ void na_unit(Frame& F, const Params& p, int b, int h, int R0) {
    using G = AttnG<NAD>;
    const bf16* QKV = (const bf16*)(F.ws + WS_QKV); bf16* ATT = (bf16*)(F.ws + WS_ATT2);
    const int tid = F.tid, lane = F.lane, r32 = lane & 31, hi = lane >> 5, wid = F.wave;
    LAS unsigned char* lds = F.lds;
    LAS float* li = (LAS float*)(lds + G::LIOFF + wid * 128);
    LAS float* rpbl = (LAS float*)(lds + G::END);
    for (int i = tid; i < 15 * 32; i += NTHR) { const int dr = i >> 5, dc = i & 31; rpbl[i] = dc < 31 ? p.in[I_RPB][(h * 15 + dr) * 31 + dc] * LOG2E : 0.f; }
    const int rq = R0 + (wid >> 1), qc = 32 * (wid & 1) + r32;
    const int qrow = NCTX + b * SEQ + rq * GW + qc;
    bf16x8 qr[G::ND0];
    { const bf16* qp = QKV + (size_t)qrow * 6144 + h * NAD + hi * 8;
#pragma unroll
      for (int d0 = 0; d0 < G::ND0; ++d0) qr[d0] = *(const bf16x8*)(qp + d0 * 16); }
    f32x16 o[4];
#pragma unroll
    for (int d = 0; d < 4; ++d)
#pragma unroll
        for (int r = 0; r < 16; ++r) o[d][r] = 0.f;
    float lsum = 0.f;
    const int vb0 = (int)(unsigned)(uintptr_t)(lds + G::VOFF) + v_rd_base(lane);
    const int klo = min(max(R0 - 4, 0), 56), khi = min(max(R0 + 3 - 4, 0), 56) + 7, nloc = khi - klo + 1, ntile = nloc + 4;
    const int w0 = min(max(rq - 4, 0), 56);
    const int cst = min(max(qc - 8, 0), 48);
    bf16x8 kreg[G::NKCH], vreg[2];
#define NA_TROW(j) ((j) < nloc ? NCTX + b * SEQ + (klo + (j)) * GW : b * CTXL + 64 * ((j) - nloc))
    { const int tr = NA_TROW(0); attn_tile_load<NAD>(kreg, vreg, QKV + (size_t)tr * 6144 + DM + h * NAD, 6144, QKV + (size_t)tr * 6144 + 2 * DM + h * NAD, 6144, tid); }
    attn_tile_write<NAD>(kreg, vreg, lds, lds + G::VOFF, tid);
    __syncthreads();
    for (int j = 0; j < ntile; ++j) {
        const int cur = j & 1;
        if (j + 1 < ntile) { const int tr = NA_TROW(j + 1); attn_tile_load<NAD>(kreg, vreg, QKV + (size_t)tr * 6144 + DM + h * NAD, 6144, QKV + (size_t)tr * 6144 + 2 * DM + h * NAD, 6144, tid); }
        const bool local = j < nloc; const int krow = klo + j;
        if (!local || (krow >= w0 && krow < w0 + 8)) {
            f32x16 p0, p1;
            attn_qkt<NAD>(p0, p1, lds + cur * G::KBYTES, qr, r32, hi);
            if (local) {
                const LAS float* brow = rpbl + (krow - rq + 7) * 32 + (15 - qc);
#pragma unroll
                for (int r = 0; r < 16; ++r) {
                    const int kc0 = crow(r, hi), kc1 = 32 + kc0;
                    const bool ok0 = kc0 >= cst && kc0 < cst + 16, ok1 = kc1 >= cst && kc1 < cst + 16;
                    const float b0 = ok0 ? brow[kc0] : 0.f, b1 = ok1 ? brow[kc1] : 0.f;
                    p0[r] = ok0 ? __builtin_amdgcn_exp2f(p0[r] + b0) : 0.f; p1[r] = ok1 ? __builtin_amdgcn_exp2f(p1[r] + b1) : 0.f; }
            } else {
#pragma unroll
                for (int r = 0; r < 16; ++r) { p0[r] = __builtin_amdgcn_exp2f(p0[r]); p1[r] = __builtin_amdgcn_exp2f(p1[r]); }
            }
            float ps = 0.f;
#pragma unroll
            for (int r = 0; r < 16; ++r) ps += p0[r] + p1[r];
            lsum += ps;
            bf16x8 pa0, pa1, pa2, pa3; pack_p(p0, p1, pa0, pa1, pa2, pa3);
            pv_d0(o, vb0 + cur * 16384, pa0, pa1, pa2, pa3);
        }
        if (j + 1 < ntile) attn_tile_write<NAD>(kreg, vreg, lds + (cur ^ 1) * G::KBYTES, lds + G::VOFF + (cur ^ 1) * 16384, tid);
        __syncthreads();
    }
#undef NA_TROW
#if DFP8_OUT1
    attn_store<true, 8>(o, lsum, li, (unsigned char*)ATT + (size_t)(NCTX + b * SEQ + rq * GW + 32 * (wid & 1)) * DM + h * NAD, DM, r32, hi);
#else
    attn_store<false, 1>(o, lsum, li, ATT + (size_t)(NCTX + b * SEQ + rq * GW + 32 * (wid & 1)) * DM + h * NAD, DM, r32, hi);
#endif
    __syncthreads();
}
__device__ __forceinline__ void p16_na_attention(Frame& F, const Params& p) {
    for (int rnd = 0; rnd < 4; ++rnd)
        for (int U = rnd * 256 + F.vcu; U < rnd * 256 + 256; U += F.G) { const int bh = U >> 4, rg = U & 15, b = bh >> 4, h = bh & 15; na_unit(F, p, b, h, 4 * rg); }
}

__device__ __forceinline__ void p8_h2_route(Frame& F, const Params& p, int l, const bf16* X, int rbase) {
    unsigned char* ws = F.ws;
    LAS float* wt = (LAS float*)F.lds;
    { f32x4 rw[4][4];
#pragma unroll
      for (int i = 0; i < 4; ++i)
#pragma unroll
          for (int q = 0; q < 4; ++q) rw[i][q] = *(const f32x4*)(p.in[I_RW] + (size_t)(F.tid + NTHR * i) * NE + 4 * q);
#pragma unroll
      for (int i = 0; i < 4; ++i)
#pragma unroll
          for (int q = 0; q < 4; ++q)
#pragma unroll
              for (int c = 0; c < 4; ++c) wt[(4 * q + c) * DM + F.tid + NTHR * i] = rw[i][q][c]; }
    volatile LAS unsigned* lcnt = F.MISC + 16; volatile LAS unsigned* lbase = F.MISC + 32;
    LAS int* lrec = (LAS int*)(F.MISC + 64);
    if (F.tid < 16) lcnt[F.tid] = 0u;
    __syncthreads();
    const float* mod = (const float*)(ws + WS_MOD) + (size_t)l * 5 * 12288;
    const float* gn = p.in[I_NFFNG] + l * DM;
    float rb[16];
#pragma unroll
    for (int e = 0; e < 16; ++e) rb[e] = p.in[I_RB][e];
    int it = 0;
    for (int row = rbase + blockIdx.x * NWAVES + F.wave; row < NTOK; row += F.G * NWAVES, ++it) {
        const int v = vec_of_row(row);
        f32x4 x[8]; load_row_bf16(X + (size_t)row * DM, F.lane, x); const float rstd = row_rstd(x);
        const float* mv = mod + (size_t)v * 12288;
#pragma unroll
        for (int j = 0; j < 8; ++j) { const int c = 4 * F.lane + 256 * j; const f32x4 g = *(const f32x4*)(gn + c), sc = *(const f32x4*)(mv + 4 * DM + c), sh = *(const f32x4*)(mv + 3 * DM + c);
            x[j] = x[j] * rstd * g * (1.0f + sc) + sh; }
#if MOE_FP8
#pragma unroll
        for (int j = 0; j < 8; ++j) *(unsigned*)(ws + WS_H + (size_t)row * DM + 4 * F.lane + 256 * j) = pk4_fp8(x[j].x, x[j].y, x[j].z, x[j].w);
#else
        store_row_bf16((bf16*)(ws + WS_H) + (size_t)row * DM, F.lane, x);
#endif
        float lg[16];
#pragma unroll
        for (int e = 0; e < 16; ++e) { float s = 0.f; if ((e & 3) == 0) __builtin_amdgcn_sched_barrier(0);
#pragma unroll
            for (int j = 0; j < 8; ++j) { const f32x4 w = *(const LAS f32x4*)(wt + e * DM + 4 * F.lane + 256 * j); s += (x[j].x * w.x + x[j].y * w.y) + (x[j].z * w.z + x[j].w * w.w); }
            lg[e] = wave_sum(s); }
        float sc[16], sel[16];
#pragma unroll
        for (int e = 0; e < 16; ++e) { sc[e] = 1.0f / (1.0f + expf(-lg[e])); sel[e] = sc[e] + rb[e]; }
        int best = 0; float bestv = -3.0e38f;
#pragma unroll
        for (int g = 0; g < 4; ++g) { float m1 = -3.0e38f, m2 = -3.0e38f;
#pragma unroll
            for (int k = 0; k < 4; ++k) { const float s = sel[4 * g + k]; if (s > m1) { m2 = m1; m1 = s; } else if (s > m2) m2 = s; }
            const float gs = m1 + m2; if (gs > bestv) { bestv = gs; best = g; } }
        int e0 = 0, e1 = 0; float s0 = -3.0e38f, s1 = -3.0e38f, w0 = 0.f, w1 = 0.f;
#pragma unroll
        for (int e = 0; e < 16; ++e) { if ((e >> 2) == best) { const float s = sel[e];
                if (s > s0) { s1 = s0; e1 = e0; w1 = w0; s0 = s; e0 = e; w0 = sc[e]; } else if (s > s1) { s1 = s; e1 = e; w1 = sc[e]; } } }
        const float wn = 1.0f / (w0 + w1);
        if (F.lane == 0) {
            const int lp0 = (int)__hip_atomic_fetch_add((LAS unsigned*)(lcnt + e0), 1u, __ATOMIC_RELAXED, __HIP_MEMORY_SCOPE_WORKGROUP);
            const int lp1 = (int)__hip_atomic_fetch_add((LAS unsigned*)(lcnt + e1), 1u, __ATOMIC_RELAXED, __HIP_MEMORY_SCOPE_WORKGROUP);
            if (it < 64) { LAS int* r = lrec + (F.wave * 64 + it) * 4; r[0] = e0; r[1] = e1; r[2] = lp0; r[3] = lp1; }
            ((int*)(ws + WS_TOKE))[2 * row] = e0; ((int*)(ws + WS_TOKE))[2 * row + 1] = e1;
            ((float*)(ws + WS_TOKW))[2 * row] = w0 * wn; ((float*)(ws + WS_TOKW))[2 * row + 1] = w1 * wn;
        }
    }
    __syncthreads();
    if (F.tid < 16) { const unsigned n = lcnt[F.tid]; lbase[F.tid] = n ? __hip_atomic_fetch_add(F.ctl + CW_CNT + (l * 16 + F.tid) * 64, n, RLX_AGENT) : 0u; }
    __syncthreads();
    if (F.lane == 0) { it = 0;
        for (int row = rbase + blockIdx.x * NWAVES + F.wave; row < NTOK; row += F.G * NWAVES, ++it) { if (it >= 64) break;
            const LAS int* r = lrec + (F.wave * 64 + it) * 4;
            ((int*)(ws + WS_TOKP))[2 * row] = (int)lbase[r[0]] + r[2]; ((int*)(ws + WS_TOKP))[2 * row + 1] = (int)lbase[r[1]] + r[3]; } }
    __syncthreads();
}
__device__ __forceinline__ int moe_tiles(Frame& F, int l, int nsh, volatile LAS int* tile_e, int& ntot) {
    int nt_r = 0;
    if (F.tid == 0) { int t = 0;
        for (int e = 0; e < 16; ++e) { const int c = (int)__hip_atomic_load(F.ctl + CW_CNT + (l * 16 + e) * 64, RLX_AGENT); const int n = (c + 255) >> 8; for (int i = 0; i < n; ++i) tile_e[t++] = e; }
        for (int i = 0; i < nsh; ++i) tile_e[t + i] = 16;
        tile_e[255] = t; }
    __syncthreads();
    nt_r = __builtin_amdgcn_readfirstlane(tile_e[255]); ntot = nt_r + nsh;
    return nt_r;
}
__device__ __forceinline__ void p9_scatter(Frame& F, int l, int rbase) {
    unsigned char* ws = F.ws;
    int off[17]; { int t = 0;
#pragma unroll
        for (int e = 0; e < 16; ++e) { off[e] = t * 256; const int c = (int)__hip_atomic_load(F.ctl + CW_CNT + (l * 16 + e) * 64, RLX_AGENT); t += (c + 255) >> 8; }
        off[16] = t * 256; }
    const int* toke = (const int*)(ws + WS_TOKE); const int* tokp = (const int*)(ws + WS_TOKP); int* toks = (int*)(ws + WS_TOKS); int* slottok = (int*)(ws + WS_SLOTTOK);
    for (int i = blockIdx.x * NTHR + F.tid; i < (NTOK - rbase) * 2; i += F.G * NTHR) { const int row = rbase + (i >> 1), k = i & 1;
        const int e = toke[2 * row + k]; int o = 0;
#pragma unroll
        for (int q = 0; q < 16; ++q) o = (e == q) ? off[q] : o;
        const int slot = o + tokp[2 * row + k]; slottok[slot] = row; toks[2 * row + k] = slot; }
    for (int i = blockIdx.x * NTHR + F.tid; i < NTOK - rbase; i += F.G * NTHR) slottok[off[16] + i] = rbase + i;
    for (int i = blockIdx.x * NTHR + F.tid; i < 16 * 256; i += F.G * NTHR) { const int e = i >> 8, j = i & 255; int o = 0, on = 0;
#pragma unroll
        for (int q = 0; q < 16; ++q) { o = (e == q) ? off[q] : o; on = (e == q) ? off[q + 1] : on; }
        const int c = (int)__hip_atomic_load(F.ctl + CW_CNT + (l * 16 + e) * 64, RLX_AGENT);
        if (o + c + j < on) slottok[o + c + j] = rbase; }
}
__device__ __forceinline__ void p12_combine(Frame& F, const Params& p, int l, const bf16* Xin, void* Xout, int rbase, int sr_off) {
    unsigned char* ws = F.ws;
    const bf16* Y = (const bf16*)(ws + WS_Y);
    const float* mod = (const float*)(ws + WS_MOD) + (size_t)l * 5 * 12288;
    const int* toks = (const int*)(ws + WS_TOKS); const float* tokw = (const float*)(ws + WS_TOKW);
    for (int row = rbase + blockIdx.x * NWAVES + F.wave; row < NTOK; row += F.G * NWAVES) {
        const int v = vec_of_row(row);
        const int s0 = toks[2 * row], s1 = toks[2 * row + 1]; const float w0 = tokw[2 * row], w1 = tokw[2 * row + 1];
        const bf16* y0 = Y + (size_t)s0 * DM; const bf16* y1 = Y + (size_t)s1 * DM; const bf16* ys = Y + (size_t)(sr_off + row - rbase) * DM;
        const float* g5 = mod + (size_t)v * 12288 + 5 * DM;
        f32x4 x[8];
#pragma unroll
        for (int j = 0; j < 8; ++j) { const int c = 4 * F.lane + 256 * j;
            const u32x2 xw = *(const u32x2*)(Xin + (size_t)row * DM + c); const f32x4 xi = (f32x4){bflo(xw.x), bfhi(xw.x), bflo(xw.y), bfhi(xw.y)}, g = *(const f32x4*)(g5 + c);
            const u32x2 a = *(const u32x2*)(ys + c), b0 = *(const u32x2*)(y0 + c), b1 = *(const u32x2*)(y1 + c);
            f32x4 m;
            m.x = bflo(a.x) + w0 * bflo(b0.x) + w1 * bflo(b1.x); m.y = bfhi(a.x) + w0 * bfhi(b0.x) + w1 * bfhi(b1.x);
            m.z = bflo(a.y) + w0 * bflo(b0.y) + w1 * bflo(b1.y); m.w = bfhi(a.y) + w0 * bfhi(b0.y) + w1 * bfhi(b1.y);
            x[j] = xi + g * m; }
        if (l == 0) {
            store_row_bf16((bf16*)Xout + (size_t)row * DM, F.lane, x);
            const float rstd = row_rstd(x);
            const float* m1 = (const float*)(ws + WS_MOD) + (size_t)(5 + v) * 12288; const float* gn = p.in[I_NMIXG] + DM;
#pragma unroll
            for (int j = 0; j < 8; ++j) { const int c = 4 * F.lane + 256 * j; const f32x4 g = *(const f32x4*)(gn + c), sc = *(const f32x4*)(m1 + DM + c), sh = *(const f32x4*)(m1 + c);
                x[j] = x[j] * rstd * g * (1.0f + sc) + sh; }
#if DFP8_QKV
            store_row_fp8(ws + WS_H + (size_t)row * DM, F.lane, x);
#else
            store_row_bf16((bf16*)(ws + WS_H) + (size_t)row * DM, F.lane, x);
#endif
        } else {
#pragma unroll
            for (int j = 0; j < 8; ++j) *(f32x4*)((float*)Xout + (size_t)(row - NCTX) * DM + 4 * F.lane + 256 * j) = x[j];
        }
    }
}

constexpr int NPHASE = 22;
__global__ void __launch_bounds__(NTHR, 2) mega_fwd(Params p) {
    extern __shared__ __attribute__((aligned(16))) unsigned char lds_raw[];
    Frame F;
    F.lds = (LAS unsigned char*)lds_raw; F.MISC = (volatile LAS unsigned*)(F.lds + MISC_OFF);
    F.tid = threadIdx.x; F.lane = F.tid & 63; F.wave = __builtin_amdgcn_readfirstlane(F.tid >> 6);
    F.G = gridDim.x; { const int bx = blockIdx.x; F.vcu = (F.G % 8 == 0) ? (bx % 8) * (F.G / 8) + bx / 8 : bx; }
    F.ws = p.ws; F.ctl = (unsigned*)(p.ws + WS_CTL);
    unsigned char* ws = p.ws;
    for (int u = F.tid; u < (LDS_BYTES - MISC_OFF) / 4; u += NTHR) ((LAS unsigned*)(F.lds + MISC_OFF))[u] = 0u;
    __syncthreads();
    const int lo = p.ph_lo, hi = p.ph_hi;
    XcdBarrier bar; bar.bar = F.ctl + CW_BAR; bar.x = 0; bar.st = F.MISC;
    if (hi - lo > 1) bar = xcd_barrier_post(F.ctl + CW_BAR, F.MISC);
#ifdef ONLY_PHASE
#define IN(k) ((k) == ONLY_PHASE && lo <= (k) && (k) < hi)
#else
#define IN(k) (lo <= (k) && (k) < hi)
#endif
#define SEAM(k) do { if (IN(k) && IN((k) + 1)) xcd_barrier(bar); } while (0)
#ifndef PROBE_DUP
#define PROBE_DUP (-1)
#endif
#ifndef PROBE_DUP2
#define PROBE_DUP2 (-1)
#endif
#define REP(k) for (int _rep = 0; _rep < ((PROBE_DUP == (k) || PROBE_DUP2 == (k)) ? 2 : 1); ++_rep)
    volatile LAS int* tile_e = (volatile LAS int*)(F.MISC + 2112);
#define REFRESH() do { int _tz = threadIdx.x; asm volatile("" : "+v"(_tz)); F.tid = _tz; F.lane = _tz & 63; F.wave = __builtin_amdgcn_readfirstlane(_tz >> 6); } while (0)
    const size_t TS2048 = (size_t)256 * 2048 * 2;

#define TAIL_FILL(nwg, grp, quota) do { const int _n = (nwg), _c = (int)blockIdx.x, _mine = _n > _c ? (_n - _c + F.G - 1) / F.G : 0, _max = (_n + F.G - 1) / F.G; \
        if (_mine < _max) deferred_tail(F, p, (grp), (quota)); } while (0)
#ifndef TQ_P2
#define TQ_P2 12
#define TQ_P7 12
#define TQ_P10 6
#define TQ_P11 6
#define TQ_P13 7
#endif
    if (IN(0)) REP(0) { REFRESH(); p0_prologue(F, p); } SEAM(0);
    if (IN(1)) REP(1) { REFRESH(); p1_modulate0(F, p); } SEAM(1);
    if (IN(2)) REP(2) {   REFRESH();
        pg8::DenseSched S; S.T.init(NTOK / 256, ABINP / 256, F.G, (int)blockIdx.x); S.A = (const char*)(ws + WS_H); S.Bt = (const char*)(ws + WS_WIN); S.tstepB = DFP8_IN ? TS2048 / 2 : TS2048; S.row0 = 0;
        EpiU E{(bf16*)(ws + WS_U)};
        pg8::gemm_phase<EpiU, pg8::DenseSched, DFP8_IN != 0>(F.lds, DFP8_IN ? DM : 2 * DM, S, E);
        REFRESH(); TAIL_FILL((NTOK / 256) * (ABINP / 256), 0, TQ_P2);
    } SEAM(2);
    if (IN(3)) REP(3) { REFRESH(); p3_rank_norms(F, p); REFRESH(); p3_conv_gates(F, p); } SEAM(3);
    if (IN(4)) REP(4) {   REFRESH();
        { pg8::DenseSched S; S.T.init(NTOK / 256, 1536 / 256, F.G, (int)blockIdx.x); S.A = (const char*)(ws + WS_CQN); S.Bt = (const char*)(ws + WS_WUQ); S.tstepB = (size_t)256 * 512 * 2; S.row0 = 0;
          EpiBf E{(bf16*)(ws + WS_QRAW), 1536};
          pg8::gemm_phase<EpiBf, pg8::DenseSched, false>(F.lds, 2 * 512, S, E); }
        REFRESH();
        { pg8::DenseSched S; S.T.init(NTOK / 256, 2048 / 256, F.G, (int)blockIdx.x); S.A = (const char*)(ws + WS_CKVN); S.Bt = (const char*)(ws + WS_WUKV); S.tstepB = (size_t)256 * 512 * 2; S.row0 = 0;
          EpiBf E{(bf16*)(ws + WS_KVRAW), 2048};
          pg8::gemm_phase<EpiBf, pg8::DenseSched, false>(F.lds, 2 * 512, S, E); }
    } SEAM(4);
    if (IN(5)) REP(5) { REFRESH(); p5_mla_finalize(F, p); scan_pass_c(F); } SEAM(5);
    if (IN(6)) REP(6) { REFRESH(); p6_mla_attention(F); REFRESH(); scan_pass_d(F); } SEAM(6);
    if (IN(7)) REP(7) {   REFRESH();
        pg8::DenseSched S; S.T.init(NTOK / 256, DM / 256, F.G, (int)blockIdx.x); S.A = (const char*)(ws + WS_YC); S.Bt = (const char*)(ws + WS_WOUT0); S.tstepB = DFP8_OUT0 ? TS2048 / 2 : TS2048; S.row0 = 0;
        EpiRes<true> E{p.in[I_CTX], p.in[I_X], (bf16*)(ws + WS_XA), (const float*)(ws + WS_MOD) + 2 * DM, 0};
        pg8::gemm_phase<EpiRes<true>, pg8::DenseSched, DFP8_OUT0 != 0>(F.lds, DFP8_OUT0 ? DM : 2 * DM, S, E, 0x7d7d7d7du);
        REFRESH(); TAIL_FILL((NTOK / 256) * (DM / 256), 0, TQ_P7);
    } SEAM(7);

#if MOE_FP8
#define MOE_GEMM1() do { EpiSwiglu8 E{ws + WS_ACT}; pg8::gemm_phase<EpiSwiglu8, pg8::MoeSched, true>(F.lds, DM, S, E); } while (0)
#else
#define MOE_GEMM1() do { EpiSwiglu E{(bf16*)(ws + WS_ACT)}; pg8::gemm_phase<EpiSwiglu, pg8::MoeSched, false>(F.lds, 2 * DM, S, E); } while (0)
#endif
#define MOE_PHASES(l) do { \
        constexpr int pb = (l) ? 17 : 8, rbase = (l) ? NCTX : 0, nsh = (l) ? NLAT / 256 : NTOK / 256; \
        if (IN(pb + 0)) REP(pb + 0) { REFRESH(); p8_h2_route(F, p, (l), (const bf16*)(ws + WS_XA), rbase); } SEAM(pb + 0); \
        if (IN(pb + 1)) REP(pb + 1) { REFRESH(); p9_scatter(F, (l), rbase); deferred_drain(F, p, (l)); } SEAM(pb + 1); \
        if (IN(pb + 2)) REP(pb + 2) { REFRESH(); \
            int ntot; moe_tiles(F, (l), nsh, tile_e, ntot); \
            pg8::MoeSched S; S.T.init(ntot, 11, F.G, (int)blockIdx.x); S.A = (const char*)(ws + WS_H); S.Bt = (const char*)(ws + WS_W1 + (size_t)(l) * 17 * W1_E); S.tstepB = W1_E / 11; S.estride = W1_E; \
            S.rowmap = (const int*)(ws + WS_SLOTTOK); S.tile_e = tile_e; \
            MOE_GEMM1(); \
            if ((l) == 0) { REFRESH(); TAIL_FILL(ntot * 11, 1, TQ_P10); } \
        } SEAM(pb + 2); \
        if (IN(pb + 3)) REP(pb + 3) { REFRESH(); \
            int ntot; moe_tiles(F, (l), nsh, tile_e, ntot); \
            pg8::MoeSched S; S.T.init(ntot, 8, F.G, (int)blockIdx.x); S.A = (const char*)(ws + WS_ACT); S.Bt = (const char*)(ws + WS_W2 + (size_t)(l) * 17 * W2_E); S.tstepB = W2_E / 8; S.estride = W2_E; \
            S.rowmap = nullptr; S.tile_e = tile_e; \
            EpiBf E{(bf16*)(ws + WS_Y), DM}; \
            pg8::gemm_phase<EpiBf, pg8::MoeSched, MOE_FP8 != 0>(F.lds, ACT_LD * ACT_ES, S, E); \
            if ((l) == 0) { REFRESH(); TAIL_FILL(ntot * 8, 1, TQ_P11); } \
        } SEAM(pb + 3); \
        if (IN(pb + 4)) REP(pb + 4) { REFRESH(); \
            int ntot; const int ntr = moe_tiles(F, (l), nsh, tile_e, ntot); \
            p12_combine(F, p, (l), (const bf16*)(ws + WS_XA), (l) ? (void*)p.out : (void*)(ws + WS_XB), rbase, ntr * 256); \
        } SEAM(pb + 4); \
    } while (0)
    MOE_PHASES(0);
    if (IN(13)) REP(13) {   REFRESH();
        pg8::DenseSched S; S.T.init(NTOK / 256, 6144 / 256, F.G, (int)blockIdx.x); S.A = (const char*)(ws + WS_H); S.Bt = (const char*)(ws + WS_WQKV); S.tstepB = DFP8_QKV ? TS2048 / 2 : TS2048; S.row0 = 0;
        EpiBf E{(bf16*)(ws + WS_QKV), 6144};
        pg8::gemm_phase<EpiBf, pg8::DenseSched, DFP8_QKV != 0>(F.lds, DFP8_QKV ? DM : 2 * DM, S, E);
        REFRESH(); TAIL_FILL((NTOK / 256) * (6144 / 256), 1, TQ_P13);
    } SEAM(13);
    if (IN(14)) REP(14) { REFRESH(); p15_na_finalize(F, p); } SEAM(14);
    if (IN(15)) REP(15) { REFRESH(); p16_na_attention(F, p); } SEAM(15);
    if (IN(16)) REP(16) {   REFRESH();
        pg8::DenseSched S; S.T.init(NLAT / 256, DM / 256, F.G, (int)blockIdx.x); S.A = (const char*)(ws + WS_ATT2); S.Bt = (const char*)(ws + WS_WOUT1); S.tstepB = DFP8_OUT1 ? TS2048 / 2 : TS2048; S.row0 = NCTX;
        EpiRes<false> E{(const void*)(ws + WS_XB), (const void*)(ws + WS_XB), (bf16*)(ws + WS_XA), (const float*)(ws + WS_MOD) + (size_t)5 * 12288 + 2 * DM, NCTX};
        pg8::gemm_phase<EpiRes<false>, pg8::DenseSched, DFP8_OUT1 != 0>(F.lds, DFP8_OUT1 ? DM : 2 * DM, S, E, 0x7c7c7c7cu);
    } SEAM(16);
    MOE_PHASES(1);
#undef MOE_PHASES
#undef IN
#undef SEAM
}

extern "C" void kernel_launch(void* const* d_in, const int* in_sizes, int n_in, void* d_out, int out_size, void* d_ws, size_t ws_size, hipStream_t stream) {
    static int grid = 0;
    if (grid == 0) {
        if (n_in != 36 || in_sizes[0] != NLAT * DM || out_size != NLAT * DM || ws_size < WS_END) {
            fprintf(stderr, "kernel_launch: shape mismatch: n_in %d in0 %d out %d ws %zu (need %zu)\n", n_in, n_in > 0 ? in_sizes[0] : -1, out_size, ws_size, (size_t)WS_END); grid = -1; return; }
        int dev = 0, cus = 0, per_cu = 0;
        if (hipGetDevice(&dev) != hipSuccess || hipDeviceGetAttribute(&cus, hipDeviceAttributeMultiprocessorCount, dev) != hipSuccess) { grid = -1; return; }
        if (hipFuncSetAttribute((const void*)mega_fwd, hipFuncAttributeMaxDynamicSharedMemorySize, LDS_BYTES) != hipSuccess) { fprintf(stderr, "kernel_launch: hipFuncSetAttribute failed\n"); grid = -1; return; }
        if (hipOccupancyMaxActiveBlocksPerMultiprocessor(&per_cu, (const void*)mega_fwd, NTHR, LDS_BYTES) != hipSuccess || per_cu < 1) { fprintf(stderr, "kernel_launch: occupancy query says %d\n", per_cu); }
        (void)hipGetLastError();
        grid = cus;
    }
    if (grid < 0) return;
    if (hipMemsetAsync((char*)d_ws + WS_CTL, 0, CTL_BYTES, stream) != hipSuccess) return;
    Params P{};
    for (int i = 0; i < 36; ++i) P.in[i] = (const float*)d_in[i];
    P.out = (float*)d_out; P.ws = (unsigned char*)d_ws;
#if MK_N_LAUNCHES == 1
    P.ph_lo = 0; P.ph_hi = NPHASE;
    hipLaunchKernelGGL(mega_fwd, dim3(grid), dim3(NTHR), LDS_BYTES, stream, P);
#else
    for (int k = 0; k < NPHASE; ++k) { P.ph_lo = k; P.ph_hi = k + 1; hipLaunchKernelGGL(mega_fwd, dim3(grid), dim3(NTHR), LDS_BYTES, stream, P); }
#endif
    const hipError_t le = hipPeekAtLastError();
    if (le != hipSuccess) fprintf(stderr, "kernel_launch: launch failed: %s\n", hipGetErrorName(le));
}
```
